# Optimizing an MI355X kernel written in HIP

```python
import math
import jax, jax.numpy as jnp
from jax import lax
import numpy as np

D_MODEL = 2048
BATCH = 2
SEQ = 4096
DEPTH = 2
DEC_BATCH = 8
DEC_SEQ = 4
PAST_LEN = 16384
PAGE_SIZE = 128

HEAD_DIM = 128
ATTN_WIDTH = D_MODEL // 2
ATTN_HEADS = ATTN_WIDTH // HEAD_DIM
CONV_CH = D_MODEL - ATTN_WIDTH
CONV_K = 3
CONV_HIST = CONV_K - 1
IN_WIDTH = 3 * ATTN_WIDTH + 3 * CONV_CH
MOBA_BLOCK = 256
MOBA_TOPK = 3
QUERY_CHUNK = 16
ROPE_THETA = 10000.0
POOL_WINDOWS = (2, 4, 8, 16)
POOL_GROUP = D_MODEL // len(POOL_WINDOWS)
POOL_HIST = max(POOL_WINDOWS) - 1
D_FF = -(-(8 * D_MODEL) // (3 * 256)) * 256
N_EVEN = (DEPTH + 1) // 2
N_ODD = DEPTH // 2
RMS_EPS = 1e-6
NEG_INF = -1e30

kernel_name = 'moba_shortconv_pool_hybrid_step'


def rmsnorm(x, g):
    xf = x.astype(jnp.float32)
    y = xf * lax.rsqrt(jnp.mean(xf * xf, axis=-1, keepdims=True) + RMS_EPS)
    return (y * g.astype(jnp.float32)).astype(x.dtype)


def rope(x, pos):
    half = HEAD_DIM // 2
    inv = ROPE_THETA ** (-jnp.arange(half, dtype=jnp.float32) / half)
    ang = pos.astype(jnp.float32)[:, None] * inv[None, :]
    cos = jnp.cos(ang)[None, :, None, :]
    sin = jnp.sin(ang)[None, :, None, :]
    xf = x.astype(jnp.float32)
    x1, x2 = xf[..., :half], xf[..., half:]
    return jnp.concatenate([x1 * cos - x2 * sin, x2 * cos + x1 * sin], axis=-1).astype(x.dtype)


def moba_attention(q, k, v, q_pos):
    B, Tq, H, Dh = q.shape
    L = k.shape[1]
    nb = -(-L // MOBA_BLOCK)
    padw = ((0, 0), (0, nb * MOBA_BLOCK - L), (0, 0), (0, 0))
    kb = jnp.pad(k, padw).reshape(B, nb, MOBA_BLOCK, H, Dh)
    vb = jnp.pad(v, padw).reshape(B, nb, MOBA_BLOCK, H, Dh)
    k_mean = jnp.mean(kb.astype(jnp.float32), axis=2)
    n_sel = min(MOBA_TOPK, nb)
    n_slots = n_sel + 1
    scale = HEAD_DIM ** -0.5
    b_idx = jnp.arange(B)[:, None, None, None]
    h_idx = jnp.arange(H)[None, :, None, None]
    blk = jnp.arange(nb)
    off = jnp.arange(MOBA_BLOCK)

    def attend_chunk(args):
        qc, pc = args
        qn = pc.shape[0]
        own = pc // MOBA_BLOCK
        gate = jnp.einsum('bqhd,bnhd->bhqn', qc.astype(jnp.float32), k_mean)
        gate = jnp.where(blk[None, :] < own[:, None], gate, NEG_INF)
        _, top = lax.top_k(gate, n_sel)
        own_b = jnp.broadcast_to(own[None, None, :, None], (B, H, qn, 1))
        idx = jnp.concatenate([top.astype(jnp.int32), own_b.astype(jnp.int32)], axis=-1)
        slot_ok = jnp.concatenate([jnp.arange(n_sel)[None, :] < own[:, None],
                                   jnp.ones((qn, 1), dtype=bool)], axis=-1)
        kg = kb[b_idx, idx, :, h_idx, :]
        vg = vb[b_idx, idx, :, h_idx, :]
        key_pos = idx[..., None] * MOBA_BLOCK + off
        mask = slot_ok[None, None, :, :, None] & (key_pos <= pc[None, None, :, None, None])
        logits = jnp.einsum('bqhd,bhqsjd->bhqsj', qc, kg).astype(jnp.float32) * scale
        logits = jnp.where(mask, logits, NEG_INF)
        p = jax.nn.softmax(logits.reshape(B, H, qn, n_slots * MOBA_BLOCK), axis=-1)
        p = p.reshape(B, H, qn, n_slots, MOBA_BLOCK).astype(vg.dtype)
        return jnp.einsum('bhqsj,bhqsjd->bqhd', p, vg)

    qc_size = math.gcd(Tq, QUERY_CHUNK)
    nc = Tq // qc_size
    q_chunks = q.reshape(B, nc, qc_size, H, Dh).transpose(1, 0, 2, 3, 4)
    p_chunks = q_pos.reshape(nc, qc_size)
    out = lax.map(attend_chunk, (q_chunks, p_chunks))
    return out.transpose(1, 0, 2, 3, 4).reshape(B, Tq, H * Dh)


def even_mixer(h, pos, k_past, v_past, conv_hist, w_in, conv_w, w_o):
    B, T, _ = h.shape
    proj = h @ w_in
    cuts = [ATTN_WIDTH, 2 * ATTN_WIDTH, 3 * ATTN_WIDTH,
            3 * ATTN_WIDTH + CONV_CH, 3 * ATTN_WIDTH + 2 * CONV_CH]
    q, k, v, gate_b, gate_c, x_conv = jnp.split(proj, cuts, axis=-1)
    q = rope(q.reshape(B, T, ATTN_HEADS, HEAD_DIM), pos)
    k = rope(k.reshape(B, T, ATTN_HEADS, HEAD_DIM), pos)
    v = v.reshape(B, T, ATTN_HEADS, HEAD_DIM)
    k_all = jnp.concatenate([k_past.astype(k.dtype), k], axis=1)
    v_all = jnp.concatenate([v_past.astype(v.dtype), v], axis=1)
    attn = moba_attention(q, k_all, v_all, pos)
    u = gate_c * x_conv
    ext = jnp.concatenate([conv_hist.astype(u.dtype), u], axis=1)
    conv = ext[:, 0:T] * conv_w[0]
    for j in range(1, CONV_K):
        conv = conv + ext[:, j:j + T] * conv_w[j]
    y_conv = gate_b * conv
    out = jnp.concatenate([attn, y_conv], axis=-1) @ w_o
    return out, k, v, ext[:, -CONV_HIST:]


def odd_mixer(h, pos, pool_hist, w_pool, pool_scale):
    B, T, D = h.shape
    ext = jnp.concatenate([pool_hist.astype(h.dtype), h], axis=1)
    cs = jnp.cumsum(ext.astype(jnp.float32), axis=1)
    cs = jnp.concatenate([jnp.zeros((B, 1, D), jnp.float32), cs], axis=1)
    end = cs[:, POOL_HIST + 1:]
    hf = h.astype(jnp.float32)
    outs = []
    for g, w in enumerate(POOL_WINDOWS):
        sl = slice(g * POOL_GROUP, (g + 1) * POOL_GROUP)
        start = cs[:, POOL_HIST + 1 - w:POOL_HIST + 1 - w + T, sl]
        cnt = jnp.minimum(pos + 1, w).astype(jnp.float32)[None, :, None]
        d = (end[..., sl] - start) / cnt - hf[..., sl]
        outs.append(d.astype(h.dtype) @ w_pool[g])
    out = jnp.concatenate(outs, axis=-1) * pool_scale
    return out, ext[:, -POOL_HIST:]


def swiglu(h, w_gate, w_up, w_down):
    return (jax.nn.silu(h @ w_gate) * (h @ w_up)) @ w_down


def trunk(x, pos, past_kv, conv_hist, pool_hist, norm_mix, norm_ffn, norm_final,
          w_in, conv_w, w_o, w_pool, pool_scale, w_gate, w_up, w_down):
    new_k, new_v, new_conv, new_pool = [], [], [], []
    for layer in range(DEPTH):
        h = rmsnorm(x, norm_mix[layer])
        if layer % 2 == 0:
            e = layer // 2
            k_past, v_past = past_kv(e)
            mix, k, v, conv_state = even_mixer(h, pos, k_past, v_past, conv_hist[e],
                                               w_in[e], conv_w[e], w_o[e])
            new_k.append(k)
            new_v.append(v)
            new_conv.append(conv_state)
        else:
            o = layer // 2
            mix, pool_state = odd_mixer(h, pos, pool_hist[o], w_pool[o], pool_scale[o])
            new_pool.append(pool_state)
        x = x + mix
        x = x + swiglu(rmsnorm(x, norm_ffn[layer]), w_gate[layer], w_up[layer], w_down[layer])
    y = rmsnorm(x, norm_final)
    return y, jnp.stack(new_k), jnp.stack(new_v), jnp.stack(new_conv), jnp.stack(new_pool)


def _normal(key, shape, scale):
    return jax.random.normal(key, shape, jnp.float32) * scale


def setup_inputs(seed: int = 0) -> dict:
    key = jax.random.key(seed)
    ks = jax.random.split(key, 18)
    n_pages = PAST_LEN // PAGE_SIZE
    n_pool = (5 * DEC_BATCH * n_pages + 3) // 4
    perm = jax.random.permutation(ks[4], n_pool)
    page_table = perm[:DEC_BATCH * n_pages].reshape(DEC_BATCH, n_pages).astype(jnp.int32)
    return {
        'x_prompt': _normal(ks[0], (BATCH, SEQ, D_MODEL), 1.0),
        'x_sample': _normal(ks[1], (DEC_BATCH, DEC_SEQ, D_MODEL), 1.0),
        'cache_k': _normal(ks[2], (N_EVEN, n_pool, PAGE_SIZE, ATTN_HEADS, HEAD_DIM), 1.0),
        'cache_v': _normal(ks[3], (N_EVEN, n_pool, PAGE_SIZE, ATTN_HEADS, HEAD_DIM), 1.0),
        'page_table': page_table,
        'state_conv': _normal(ks[5], (N_EVEN, DEC_BATCH, CONV_HIST, CONV_CH), 1.0),
        'state_pool': _normal(ks[6], (N_ODD, DEC_BATCH, POOL_HIST, D_MODEL), 1.0),
        'norm_mix': 1.0 + _normal(ks[7], (DEPTH, D_MODEL), 0.1),
        'norm_ffn': 1.0 + _normal(ks[8], (DEPTH, D_MODEL), 0.1),
        'norm_final': 1.0 + _normal(ks[9], (D_MODEL,), 0.1),
        'w_in': _normal(ks[10], (N_EVEN, D_MODEL, IN_WIDTH), D_MODEL ** -0.5),
        'conv_w': _normal(ks[11], (N_EVEN, CONV_K, CONV_CH), CONV_K ** -0.5),
        'w_o': _normal(ks[12], (N_EVEN, ATTN_WIDTH + CONV_CH, D_MODEL), (ATTN_WIDTH + CONV_CH) ** -0.5),
        'w_pool': _normal(ks[13], (N_ODD, len(POOL_WINDOWS), POOL_GROUP, POOL_GROUP), POOL_GROUP ** -0.5),
        'pool_scale': 1.0 + _normal(ks[14], (N_ODD, D_MODEL), 0.1),
        'w_gate': _normal(ks[15], (DEPTH, D_MODEL, D_FF), D_MODEL ** -0.5),
        'w_up': _normal(ks[16], (DEPTH, D_MODEL, D_FF), D_MODEL ** -0.5),
        'w_down': _normal(ks[17], (DEPTH, D_FF, D_MODEL), D_FF ** -0.5),
    }


def reference(x_prompt, x_sample, cache_k, cache_v, page_table, state_conv, state_pool,
              norm_mix, norm_ffn, norm_final, w_in, conv_w, w_o, w_pool, pool_scale,
              w_gate, w_up, w_down):
    n_batch, n_seq, d = x_prompt.shape
    n_dec, n_new, _ = x_sample.shape
    past_len = page_table.shape[1] * cache_k.shape[2]

    empty = jnp.zeros((n_batch, 0, ATTN_HEADS, HEAD_DIM), x_prompt.dtype)

    def prompt_past(e):
        return empty, empty

    def sample_past(e):
        k_past = cache_k[e][page_table].reshape(n_dec, past_len, ATTN_HEADS, HEAD_DIM)
        v_past = cache_v[e][page_table].reshape(n_dec, past_len, ATTN_HEADS, HEAD_DIM)
        return k_past, v_past

    pos_prompt = jnp.arange(n_seq, dtype=jnp.int32)
    pos_sample = past_len + jnp.arange(n_new, dtype=jnp.int32)
    conv_zero = jnp.zeros((N_EVEN, n_batch, CONV_HIST, CONV_CH), x_prompt.dtype)
    pool_zero = jnp.zeros((N_ODD, n_batch, POOL_HIST, d), x_prompt.dtype)

    y_prompt, k_prompt, v_prompt, conv_prompt, pool_prompt = trunk(
        x_prompt, pos_prompt, prompt_past, conv_zero, pool_zero, norm_mix, norm_ffn, norm_final,
        w_in, conv_w, w_o, w_pool, pool_scale, w_gate, w_up, w_down)
    y_sample, k_sample, v_sample, conv_sample, pool_sample = trunk(
        x_sample, pos_sample, sample_past, state_conv, state_pool, norm_mix, norm_ffn, norm_final,
        w_in, conv_w, w_o, w_pool, pool_scale, w_gate, w_up, w_down)
    return (y_prompt, y_sample, k_prompt, v_prompt, k_sample, v_sample,
            conv_prompt, conv_sample, pool_prompt, pool_sample)
```

```cpp
#include <hip/hip_runtime.h>
#include <cstdio>
#include <cstdint>
namespace nv {
constexpr int D_ = 2048, SEQ_ = 4096, NB_ = 2, DB_ = 8, DS_ = 4, PAST_ = 16384, PAGE_ = 128;
constexpr int MP_ = NB_ * SEQ_, MS_ = DB_ * DS_, M_ = MP_ + MS_;
constexpr int INW_ = 6144, FF_ = 5632, HD_ = 128, NH_ = 8, CC_ = 1024;
constexpr int NPG_ = PAST_ / PAGE_;

__device__ __forceinline__ float wsum(float v) {
#pragma unroll
    for (int o = 1; o < 64; o <<= 1) v += __shfl_xor(v, o);
    return v;
}
__device__ __forceinline__ float wmax(float v) {
#pragma unroll
    for (int o = 1; o < 64; o <<= 1) v = fmaxf(v, __shfl_xor(v, o));
    return v;
}
__device__ __forceinline__ int row_pos(int row) { return row < MP_ ? (row % SEQ_) : (PAST_ + (row - MP_) % DS_); }

__global__ void k_concat_x(const float* xp, const float* xs, float* X) {
    size_t i = (size_t)blockIdx.x * blockDim.x + threadIdx.x;
    const size_t n = (size_t)M_ * D_ / 4, np = (size_t)MP_ * D_ / 4;
    for (; i < n; i += (size_t)gridDim.x * blockDim.x)
        ((float4*)X)[i] = i < np ? ((const float4*)xp)[i] : ((const float4*)xs)[i - np];
}
__global__ void k_rmsnorm(const float* X, const float* g, float* H, int M) {
    const int lane = threadIdx.x & 63, w = (blockIdx.x * blockDim.x + threadIdx.x) >> 6, nw = (gridDim.x * blockDim.x) >> 6;
    for (int r = w; r < M; r += nw) {
        const float4* x = (const float4*)(X + (size_t)r * D_);
        float4 v[8]; float s = 0.f;
#pragma unroll
        for (int j = 0; j < 8; ++j) { v[j] = x[lane + 64 * j]; s += v[j].x * v[j].x + v[j].y * v[j].y + v[j].z * v[j].z + v[j].w * v[j].w; }
        const float rs = rsqrtf(wsum(s) * (1.f / D_) + 1e-6f);
#pragma unroll
        for (int j = 0; j < 8; ++j) { const float4 gg = ((const float4*)g)[lane + 64 * j];
            ((float4*)(H + (size_t)r * D_))[lane + 64 * j] = make_float4(v[j].x * rs * gg.x, v[j].y * rs * gg.y, v[j].z * rs * gg.z, v[j].w * rs * gg.w); }
    }
}
template <int MODE>
__global__ void __launch_bounds__(256) k_sgemm(const float* __restrict__ A, int lda, const float* __restrict__ B, int ldb, float* C, int ldc, int M, int N, int K, const float* colscale) {
    __shared__ float As[8][132];
    __shared__ float Bs[8][132];
    const int tid = threadIdx.x, tx = tid & 15, ty = tid >> 4;
    const int m0 = blockIdx.y * 128, n0 = blockIdx.x * 128;
    float acc[8][8];
#pragma unroll
    for (int i = 0; i < 8; ++i)
#pragma unroll
        for (int j = 0; j < 8; ++j) acc[i][j] = 0.f;
    const int am = tid >> 1, ak = (tid & 1) * 4;
    int arow = m0 + am; if (arow > M - 1) arow = M - 1;
    const int bk = tid >> 5, bn = (tid & 31) * 4;
    for (int k0 = 0; k0 < K; k0 += 8) {
        const float4 a4 = *(const float4*)(A + (size_t)arow * lda + k0 + ak);
        const float4 b4 = *(const float4*)(B + (size_t)(k0 + bk) * ldb + n0 + bn);
        __syncthreads();
        As[ak + 0][am] = a4.x; As[ak + 1][am] = a4.y; As[ak + 2][am] = a4.z; As[ak + 3][am] = a4.w;
        *(float4*)&Bs[bk][bn] = b4;
        __syncthreads();
#pragma unroll
        for (int kk = 0; kk < 8; ++kk) {
            float a[8], b[8];
            const float4 a0 = *(const float4*)&As[kk][ty * 8], a1 = *(const float4*)&As[kk][ty * 8 + 4];
            const float4 b0 = *(const float4*)&Bs[kk][tx * 8], b1 = *(const float4*)&Bs[kk][tx * 8 + 4];
            a[0] = a0.x; a[1] = a0.y; a[2] = a0.z; a[3] = a0.w; a[4] = a1.x; a[5] = a1.y; a[6] = a1.z; a[7] = a1.w;
            b[0] = b0.x; b[1] = b0.y; b[2] = b0.z; b[3] = b0.w; b[4] = b1.x; b[5] = b1.y; b[6] = b1.z; b[7] = b1.w;
#pragma unroll
            for (int i = 0; i < 8; ++i)
#pragma unroll
                for (int j = 0; j < 8; ++j) acc[i][j] = fmaf(a[i], b[j], acc[i][j]);
        }
    }
#pragma unroll
    for (int i = 0; i < 8; ++i) {
        const int r = m0 + ty * 8 + i;
        if (r < M) {
#pragma unroll
            for (int j = 0; j < 8; ++j) {
                const int c = n0 + tx * 8 + j; float* p = C + (size_t)r * ldc + c;
                if (MODE == 0) *p = acc[i][j]; else if (MODE == 1) *p += acc[i][j]; else *p += acc[i][j] * colscale[c];
            }
        }
    }
}
__global__ void k_rope(float* P, float* out_kp, float* out_vp, float* out_ks, float* out_vs) {
    const size_t n = (size_t)M_ * 1024;
    for (size_t i = (size_t)blockIdx.x * blockDim.x + threadIdx.x; i < n; i += (size_t)gridDim.x * blockDim.x) {
        const int row = (int)(i >> 10), j = (int)(i & 1023);
        float* pr = P + (size_t)row * INW_;
        const int pos = row_pos(row);
        { const float v = pr[2048 + j]; if (row < MP_) out_vp[(size_t)row * 1024 + j] = v; else out_vs[(size_t)(row - MP_) * 1024 + j] = v; }
        const int which = j >> 9, hh = (j >> 6) & 7, ii = j & 63;
        const float inv = powf(10000.f, -(float)ii / 64.f);
        const float ang = (float)pos * inv;
        const float c = cosf(ang), s = sinf(ang);
        float* b = pr + which * 1024 + hh * 128;
        const float x1 = b[ii], x2 = b[64 + ii];
        const float o1 = x1 * c - x2 * s, o2 = x2 * c + x1 * s;
        b[ii] = o1; b[64 + ii] = o2;
        if (which == 1) {
            float* o = row < MP_ ? out_kp + (size_t)row * 1024 : out_ks + (size_t)(row - MP_) * 1024;
            o[hh * 128 + ii] = o1; o[hh * 128 + 64 + ii] = o2;
        }
    }
}
__global__ void k_conv(const float* P, const float* conv_w, const float* state_conv, float* ATT, float* out_cp, float* out_cs) {
    const size_t n = (size_t)M_ * CC_;
    for (size_t i = (size_t)blockIdx.x * blockDim.x + threadIdx.x; i < n; i += (size_t)gridDim.x * blockDim.x) {
        const int row = (int)(i >> 10), c = (int)(i & 1023);
        const bool smp = row >= MP_;
        const int t = smp ? (row - MP_) % DS_ : row % SEQ_, b = smp ? (row - MP_) / DS_ : row / SEQ_;
        const float* pr = P + (size_t)row * INW_;
        const float u0 = pr[4096 + c] * pr[5120 + c];
        float um1, um2;
        if (t >= 1) um1 = (pr - INW_)[4096 + c] * (pr - INW_)[5120 + c]; else um1 = smp ? state_conv[((size_t)b * 2 + 1) * CC_ + c] : 0.f;
        if (t >= 2) um2 = (pr - 2 * INW_)[4096 + c] * (pr - 2 * INW_)[5120 + c];
        else if (t == 1) um2 = smp ? state_conv[((size_t)b * 2 + 1) * CC_ + c] : 0.f;
        else um2 = smp ? state_conv[((size_t)b * 2 + 0) * CC_ + c] : 0.f;
        const float cv = conv_w[c] * um2 + conv_w[CC_ + c] * um1 + conv_w[2 * CC_ + c] * u0;
        ATT[(size_t)row * D_ + 1024 + c] = pr[3072 + c] * cv;
        if (!smp) { if (t >= SEQ_ - 2) out_cp[((size_t)b * 2 + (t - (SEQ_ - 2))) * CC_ + c] = u0; }
        else { if (t >= DS_ - 2) out_cs[((size_t)b * 2 + (t - (DS_ - 2))) * CC_ + c] = u0; }
    }
}
__global__ void k_kmean_prompt(const float* P, float* KM) {
    const int i = blockIdx.x * blockDim.x + threadIdx.x;
    if (i >= NB_ * 16 * 1024) return;
    const int hd = i & 1023, n = (i >> 10) & 15, b = i >> 14;
    float s = 0.f;
    for (int j = 0; j < 256; ++j) s += P[(size_t)(b * SEQ_ + n * 256 + j) * INW_ + 1024 + hd];
    KM[i] = s * (1.f / 256.f);
}
__global__ void k_kmean_sample(const float* cache_k, const int* page_table, float* KMS) {
    const int i = blockIdx.x * blockDim.x + threadIdx.x;
    if (i >= DB_ * 64 * 1024) return;
    const int hd = i & 1023, n = (i >> 10) & 63, b = i >> 16;
    float s = 0.f;
    for (int pg = 0; pg < 2; ++pg) {
        const size_t base = (size_t)page_table[b * NPG_ + 2 * n + pg] * PAGE_ * 1024;
        for (int j = 0; j < 128; ++j) s += cache_k[base + (size_t)j * 1024 + hd];
    }
    KMS[i] = s * (1.f / 256.f);
}
__global__ void __launch_bounds__(256) k_attn_prompt(const float* P, const float* KM, float* ATT) {
    __shared__ float qs[4][128];
    __shared__ float ps[4][1024];
    const int lane = threadIdx.x & 63, wv = threadIdx.x >> 6;
    const int item = blockIdx.x * 4 + wv;
    const int row = item >> 3, h = item & 7;
    const int b = row / SEQ_, t = row % SEQ_, own = t >> 8;
    const float* qp = P + (size_t)row * INW_ + h * 128;
    qs[wv][lane] = qp[lane]; qs[wv][lane + 64] = qp[lane + 64];
    __syncthreads();
    float gate = -1e30f;
    if (lane < own) { const float* km = KM + ((size_t)(b * 16 + lane) * 8 + h) * 128; float s = 0.f; for (int d = 0; d < 128; ++d) s += qs[wv][d] * km[d]; gate = s; }
    int sel[4]; int nsel = own < 3 ? own : 3;
    {
        float g[16];
#pragma unroll
        for (int n = 0; n < 16; ++n) g[n] = __shfl(gate, n);
#pragma unroll
        for (int s = 0; s < 3; ++s) { int bi = 0; float bv = g[0];
#pragma unroll
            for (int n = 1; n < 16; ++n) if (g[n] > bv) { bv = g[n]; bi = n; }
            sel[s] = bi;
#pragma unroll
            for (int n = 0; n < 16; ++n) if (n == bi) g[n] = -3e38f; }
    }
    sel[3] = own;
    float lg[4][4]; float mx = -3e38f;
#pragma unroll
    for (int s = 0; s < 4; ++s) {
        const bool ok = (s == 3) || (s < nsel);
#pragma unroll
        for (int jj = 0; jj < 4; ++jj) {
            const int j = lane + 64 * jj, kpos = sel[s] * 256 + j;
            float v = -1e30f;
            if (ok && kpos <= t) { const float* kp = P + (size_t)(b * SEQ_ + kpos) * INW_ + 1024 + h * 128; float a = 0.f;
                for (int d = 0; d < 128; d += 4) { const float4 k4 = *(const float4*)(kp + d); a += qs[wv][d] * k4.x + qs[wv][d + 1] * k4.y + qs[wv][d + 2] * k4.z + qs[wv][d + 3] * k4.w; }
                v = a * 0.08838834764831845f; }
            lg[s][jj] = v; mx = fmaxf(mx, v);
        }
    }
    mx = wmax(mx);
    float sum = 0.f;
#pragma unroll
    for (int s = 0; s < 4; ++s)
#pragma unroll
        for (int jj = 0; jj < 4; ++jj) { const float e = lg[s][jj] > -1e29f ? __expf(lg[s][jj] - mx) : 0.f; lg[s][jj] = e; sum += e; }
    sum = wsum(sum);
    const float rinv = 1.f / sum;
#pragma unroll
    for (int s = 0; s < 4; ++s)
#pragma unroll
        for (int jj = 0; jj < 4; ++jj) ps[wv][s * 256 + lane + 64 * jj] = lg[s][jj] * rinv;
    __syncthreads();
    float o0 = 0.f, o1 = 0.f;
    for (int s = 0; s < 4; ++s) {
        const bool ok = (s == 3) || (s < nsel);
        if (!ok) continue;
        const int nk = (s == 3) ? (t - own * 256 + 1) : 256;
        const float* vp = P + (size_t)(b * SEQ_ + sel[s] * 256) * INW_ + 2048 + h * 128;
        for (int j = 0; j < nk; ++j) { const float p = ps[wv][s * 256 + j]; o0 += p * vp[(size_t)j * INW_ + lane]; o1 += p * vp[(size_t)j * INW_ + lane + 64]; }
    }
    ATT[(size_t)row * D_ + h * 128 + lane] = o0; ATT[(size_t)row * D_ + h * 128 + lane + 64] = o1;
}
__global__ void __launch_bounds__(256) k_attn_sample(const float* P, const float* KMS, const float* cache_k, const float* cache_v, const int* page_table, float* ATT) {
    __shared__ float qs[4][128];
    __shared__ float ps[4][1024];
    const int lane = threadIdx.x & 63, wv = threadIdx.x >> 6;
    const int item = blockIdx.x * 4 + wv;
    const int h = item & 7, t = (item >> 3) & 3, b = item >> 5;
    const int row = MP_ + b * DS_ + t;
    const float* qp = P + (size_t)row * INW_ + h * 128;
    qs[wv][lane] = qp[lane]; qs[wv][lane + 64] = qp[lane + 64];
    __syncthreads();
    float gate;
    { const float* km = KMS + ((size_t)(b * 64 + lane) * 8 + h) * 128; float s = 0.f; for (int d = 0; d < 128; ++d) s += qs[wv][d] * km[d]; gate = s; }
    int sel[3];
#pragma unroll
    for (int s = 0; s < 3; ++s) {
        const float bv = wmax(gate);
        const unsigned long long m = __ballot(gate == bv);
        const int bi = __ffsll((long long)m) - 1;
        sel[s] = bi; if (lane == bi) gate = -3e38f;
    }
    float mx = -3e38f;
    for (int s = 0; s < 3; ++s)
        for (int jj = 0; jj < 4; ++jj) {
            const int j = lane + 64 * jj;
            const size_t base = ((size_t)page_table[b * NPG_ + 2 * sel[s] + (j >> 7)] * PAGE_ + (j & 127)) * 1024 + h * 128;
            const float* kp = cache_k + base; float a = 0.f;
#pragma unroll 2
            for (int d = 0; d < 128; d += 4) { const float4 k4 = *(const float4*)(kp + d); a += qs[wv][d] * k4.x + qs[wv][d + 1] * k4.y + qs[wv][d + 2] * k4.z + qs[wv][d + 3] * k4.w; }
            const float v = a * 0.08838834764831845f; ps[wv][s * 256 + j] = v; mx = fmaxf(mx, v);
        }
    for (int jj = 0; jj < 4; ++jj) {
        const int j = lane + 64 * jj; float v = -1e30f;
        if (j <= t) { const float* kp = P + (size_t)(MP_ + b * DS_ + j) * INW_ + 1024 + h * 128; float a = 0.f;
#pragma unroll 2
            for (int d = 0; d < 128; ++d) a += qs[wv][d] * kp[d];
            v = a * 0.08838834764831845f; }
        ps[wv][768 + j] = v; mx = fmaxf(mx, v);
    }
    mx = wmax(mx);
    float sum = 0.f;
    for (int i = lane; i < 1024; i += 64) { const float l = ps[wv][i]; const float e = l > -1e29f ? __expf(l - mx) : 0.f; ps[wv][i] = e; sum += e; }
    sum = wsum(sum);
    const float rinv = 1.f / sum;
    for (int i = lane; i < 1024; i += 64) ps[wv][i] *= rinv;
    __syncthreads();
    float o0 = 0.f, o1 = 0.f;
    for (int s = 0; s < 3; ++s)
        for (int j = 0; j < 256; ++j) {
            const size_t base = ((size_t)page_table[b * NPG_ + 2 * sel[s] + (j >> 7)] * PAGE_ + (j & 127)) * 1024 + h * 128;
            const float p = ps[wv][s * 256 + j]; o0 += p * cache_v[base + lane]; o1 += p * cache_v[base + lane + 64];
        }
    for (int j = 0; j <= t; ++j) { const float* vp = P + (size_t)(MP_ + b * DS_ + j) * INW_ + 2048 + h * 128; const float p = ps[wv][768 + j]; o0 += p * vp[lane]; o1 += p * vp[lane + 64]; }
    ATT[(size_t)row * D_ + h * 128 + lane] = o0; ATT[(size_t)row * D_ + h * 128 + lane + 64] = o1;
}
__global__ void k_silu_mul(const float* G, const float* U, float* O, size_t n) {
    for (size_t i = (size_t)blockIdx.x * blockDim.x + threadIdx.x; i < n; i += (size_t)gridDim.x * blockDim.x) { const float g = G[i]; O[i] = g / (1.f + __expf(-g)) * U[i]; }
}
__global__ void k_pool(const float* H, const float* state_pool, float* Dd, float* out_pp, float* out_ps) {
    const size_t n = (size_t)M_ * D_;
    for (size_t i = (size_t)blockIdx.x * blockDim.x + threadIdx.x; i < n; i += (size_t)gridDim.x * blockDim.x) {
        const int row = (int)(i >> 11), c = (int)(i & 2047);
        const bool smp = row >= MP_;
        const int t = smp ? (row - MP_) % DS_ : row % SEQ_, b = smp ? (row - MP_) / DS_ : row / SEQ_;
        const int w = 2 << (c >> 9);
        float s = 0.f;
        for (int j = 0; j < w; ++j) { const int tt = t - j;
            if (tt >= 0) s += H[(size_t)(row - j) * D_ + c]; else if (smp) s += state_pool[((size_t)b * 15 + (15 + tt)) * D_ + c]; }
        const float cnt = smp ? (float)w : (float)((t + 1) < w ? (t + 1) : w);
        const float hv = H[i];
        Dd[i] = s / cnt - hv;
        if (!smp) { if (t >= SEQ_ - 15) out_pp[((size_t)b * 15 + (t - (SEQ_ - 15))) * D_ + c] = hv; }
        else { out_ps[((size_t)b * 15 + 11 + t) * D_ + c] = hv;
               for (int j = t; j < 11; j += DS_) out_ps[((size_t)b * 15 + j) * D_ + c] = state_pool[((size_t)b * 15 + j + 4) * D_ + c]; }
    }
}
}

static void naive_forward(void* const* d_in, float* out, unsigned char* ws, hipStream_t st) {
    using namespace nv;
    const float* xp = (const float*)d_in[0]; const float* xs = (const float*)d_in[1];
    const float* cache_k = (const float*)d_in[2]; const float* cache_v = (const float*)d_in[3];
    const int* page_table = (const int*)d_in[4];
    const float* state_conv = (const float*)d_in[5]; const float* state_pool = (const float*)d_in[6];
    const float* norm_mix = (const float*)d_in[7]; const float* norm_ffn = (const float*)d_in[8]; const float* norm_final = (const float*)d_in[9];
    const float* w_in = (const float*)d_in[10]; const float* conv_w = (const float*)d_in[11]; const float* w_o = (const float*)d_in[12];
    const float* w_pool = (const float*)d_in[13]; const float* pool_scale = (const float*)d_in[14];
    const float* w_gate = (const float*)d_in[15]; const float* w_up = (const float*)d_in[16]; const float* w_down = (const float*)d_in[17];
    float* o_y = out;
    float* o_kp = o_y + (size_t)M_ * D_;
    float* o_vp = o_kp + (size_t)MP_ * 1024;
    float* o_ks = o_vp + (size_t)MP_ * 1024;
    float* o_vs = o_ks + (size_t)MS_ * 1024;
    float* o_cp = o_vs + (size_t)MS_ * 1024;
    float* o_cs = o_cp + (size_t)NB_ * 2 * CC_;
    float* o_pp = o_cs + (size_t)DB_ * 2 * CC_;
    float* o_ps = o_pp + (size_t)NB_ * 15 * D_;
    float* X = (float*)ws;
    float* H = X + (size_t)M_ * D_;
    float* P = H + (size_t)M_ * D_;
    float* ATT = P + (size_t)M_ * INW_;
    float* G = ATT + (size_t)M_ * D_;
    float* U = G + (size_t)M_ * FF_;
    float* KM = U + (size_t)M_ * FF_;
    float* KMS = KM + NB_ * 16 * 1024;
    float* Dd = KMS + DB_ * 64 * 1024;
    const dim3 blk(256);
    const int mt = (M_ + 127) / 128;
    k_concat_x<<<2048, blk, 0, st>>>(xp, xs, X);
    k_rmsnorm<<<1024, blk, 0, st>>>(X, norm_mix, H, M_);
    k_sgemm<0><<<dim3(INW_ / 128, mt), blk, 0, st>>>(H, D_, w_in, INW_, P, INW_, M_, INW_, D_, nullptr);
    k_rope<<<4096, blk, 0, st>>>(P, o_kp, o_vp, o_ks, o_vs);
    k_conv<<<4096, blk, 0, st>>>(P, conv_w, state_conv, ATT, o_cp, o_cs);
    k_kmean_prompt<<<NB_ * 16 * 1024 / 256, blk, 0, st>>>(P, KM);
    k_kmean_sample<<<DB_ * 64 * 1024 / 256, blk, 0, st>>>(cache_k, page_table, KMS);
    k_attn_prompt<<<MP_ * 8 / 4, blk, 0, st>>>(P, KM, ATT);
    k_attn_sample<<<MS_ * 8 / 4, blk, 0, st>>>(P, KMS, cache_k, cache_v, page_table, ATT);
    k_sgemm<1><<<dim3(D_ / 128, mt), blk, 0, st>>>(ATT, D_, w_o, D_, X, D_, M_, D_, D_, nullptr);
    for (int layer = 0; layer < 2; ++layer) {
        if (layer == 1) {
            k_rmsnorm<<<1024, blk, 0, st>>>(X, norm_mix + D_, H, M_);
            k_pool<<<4096, blk, 0, st>>>(H, state_pool, Dd, o_pp, o_ps);
            for (int g = 0; g < 4; ++g)
                k_sgemm<2><<<dim3(512 / 128, mt), blk, 0, st>>>(Dd + 512 * g, D_, w_pool + (size_t)g * 512 * 512, 512, X + 512 * g, D_, M_, 512, 512, pool_scale + 512 * g);
        }
        k_rmsnorm<<<1024, blk, 0, st>>>(X, norm_ffn + (size_t)layer * D_, H, M_);
        k_sgemm<0><<<dim3(FF_ / 128, mt), blk, 0, st>>>(H, D_, w_gate + (size_t)layer * D_ * FF_, FF_, G, FF_, M_, FF_, D_, nullptr);
        k_sgemm<0><<<dim3(FF_ / 128, mt), blk, 0, st>>>(H, D_, w_up + (size_t)layer * D_ * FF_, FF_, U, FF_, M_, FF_, D_, nullptr);
        k_silu_mul<<<4096, blk, 0, st>>>(G, U, G, (size_t)M_ * FF_);
        k_sgemm<1><<<dim3(D_ / 128, mt), blk, 0, st>>>(G, FF_, w_down + (size_t)layer * FF_ * D_, D_, X, D_, M_, D_, FF_, nullptr);
    }
    k_rmsnorm<<<1024, blk, 0, st>>>(X, norm_final, o_y, M_);
}
extern "C" void kernel_launch(void* const* d_in, const int* in_sizes, int n_in,
                              void* d_out, int out_size, void* d_ws, size_t ws_size,
                              hipStream_t stream) {
    naive_forward(d_in, (float*)d_out, (unsigned char*)d_ws, stream);
}
```

```cpp
#include <hip/hip_runtime.h>
#include <hip/hip_bf16.h>
#include <cstdio>
#include <cstdint>
#include <cmath>
#ifndef MK_ATTN_EXTERNAL
#define MK_ATTN_EXTERNAL 0
#endif
#ifndef PROBE_REP
#define PROBE_REP -1
#endif
#ifndef CONV_IN_SLOTS
#define CONV_IN_SLOTS 1
#endif
#ifndef GU1_IN_P0
#define GU1_IN_P0 0
#endif
#ifndef HALF_UNITS
#define HALF_UNITS 0
#endif
#ifndef XB_NT_STORE
#define XB_NT_STORE 0
#endif
#ifndef GEMM_A_AUX
#define GEMM_A_AUX 0
#endif
#ifndef GEMM_B_AUX
#define GEMM_B_AUX 0
#endif
#ifndef CONV_BATCH
#define CONV_BATCH 4
#endif
#ifndef KV_NT_STORE
#define KV_NT_STORE 0
#endif
#ifndef XB_WT_STORE
#define XB_WT_STORE 0
#endif
#ifndef GU1_END_P3
#define GU1_END_P3 0
#define GU1_END_P4 (1 << 30)
#define GU1_END_P5 (1 << 30)
#endif
constexpr int DM = 2048, SEQ = 4096, NB = 2, DB = 8, DS = 4, PAST = 16384, PAGE = 128, NPG = PAST / PAGE;
constexpr int MP = NB * SEQ, MS = DB * DS, MV = MP + MS, MPAD = 8448;
constexpr int INW = 6144, FF = 5632, HD = 128, NH = 8, CC = 1024;
constexpr float RMS_EPS = 1e-6f;
constexpr float SS_SCALE = 1048576.f;
namespace pg8 {
#define PG8_LAS __attribute__((address_space(3)))
typedef unsigned short bf16_t;
typedef short bf16x8 __attribute__((ext_vector_type(8)));
typedef float f32x4 __attribute__((ext_vector_type(4)));
typedef unsigned u32x4 __attribute__((ext_vector_type(4)));
constexpr int BM = 256, BK = 64, HALF = 128, HTB = HALF * BK * 2  , STAGE_BYTES = 8 * HTB, NXCD = 8, WGM = 8;

__host__ __device__ __forceinline__ int lds_byte(int r, int c) { const int st = (r >> 4) * 2 + (c >> 5), rr = r & 15, cc = c & 31, ob = rr * 64 + cc * 2; return st * 1024 + (ob ^ (((ob >> 9) & 1) << 5)); }
__host__ __device__ __forceinline__ void stage_rc(int b, int& R, int& C) { const int st = b / 1024, sb = b % 1024, swz = sb ^ (((sb >> 9) & 1) << 5); R = (st >> 1) * 16 + swz / 64; C = (st & 1) * 32 + (swz % 64) / 2; }
__host__ __device__ __forceinline__ int perm32(int rho) { const int n = rho >> 4, i = rho & 15; return 8 * (i >> 2) + 4 * n + (i & 3); }

struct Unit { int pm, pn, half; };
struct Gemm { const bf16_t* A; const bf16_t* Bt; int M, N, K, lda, ldb, gshift, gstride; size_t kstepA, kstepB; };

struct StaticOrder {
    int nM, nN, nwg, G, c, lim;
    __host__ __device__ void init(int M, int N, int G_, int c_) { nM = M / BM; nN = N / BM; nwg = nM * nN; G = G_; c = c_; lim = nwg; }
    __host__ __device__ bool next(int i, Unit& u) const { const long L = (long)i * G + c; if (L >= lim) return false; map(L, u); return true; }
    __host__ __device__ void map(long L, Unit& u) const {
        int wgid = (int)L; { const int q = nwg / NXCD, r = nwg % NXCD, xcd = wgid % NXCD, off = wgid / NXCD; wgid = (xcd < r ? xcd * (q + 1) : r * (q + 1) + (xcd - r) * q) + off; }
        const int nig = WGM * nN, gid = wgid / nig, fm = gid * WGM, gsz = (nM - fm) < WGM ? (nM - fm) : WGM;
        u.pm = fm + ((wgid % nig) % gsz); u.pn = (wgid % nig) / gsz; u.half = 0;
    }
    __device__ __forceinline__ void a_ready(const Unit&) const {}
    __device__ __forceinline__ void done(const Unit&) const {}
};

__device__ __forceinline__ unsigned cvt_pk_bf16(float lo, float hi) { unsigned r; asm volatile("v_cvt_pk_bf16_f32 %0, %1, %2" : "=v"(r) : "v"(lo), "v"(hi)); return r; }
typedef unsigned u32x2 __attribute__((ext_vector_type(2)));
__device__ __forceinline__ void store16_wt(void* p, const u32x4 v) { asm volatile("global_store_dwordx4 %0, %1, off sc1" :: "v"(p), "v"(v) : "memory"); }
__device__ __forceinline__ float ss_to_rstd(unsigned long long s) { return rsqrtf((float)s * (1.0f / (SS_SCALE * (float)DM)) + RMS_EPS); }
__device__ __forceinline__ u32x4 pack8f(const f32x4 a, const f32x4 b) { u32x4 w; w.x = cvt_pk_bf16(a[0], a[1]); w.y = cvt_pk_bf16(a[2], a[3]); w.z = cvt_pk_bf16(b[0], b[1]); w.w = cvt_pk_bf16(b[2], b[3]); return w; }
__device__ __forceinline__ u32x2 pack4f(const f32x4 a) { u32x2 w; w.x = cvt_pk_bf16(a[0], a[1]); w.y = cvt_pk_bf16(a[2], a[3]); return w; }
template <bool GUARD>
__device__ __forceinline__ void load_rstd8(const unsigned long long* ss, int rbase, float (&rs)[2][4]) {
    unsigned long long s[2][4];
#pragma unroll
    for (int ai = 0; ai < 2; ++ai)
#pragma unroll
        for (int m = 0; m < 4; ++m) { const int row = rbase + ai * HALF + m * 16; s[ai][m] = (!GUARD || row < MV) ? ss[row] : 0ull; }
#pragma unroll
    for (int ai = 0; ai < 2; ++ai)
#pragma unroll
        for (int m = 0; m < 4; ++m) rs[ai][m] = ss_to_rstd(s[ai][m]);
}

struct EpiInProj {
    static constexpr bool PERM = true, AFTER_DRAIN = false, ACC_INIT = false;
    const unsigned long long* ss; const float* cosT; const float* sinT;
    bf16_t *Qb, *Kb, *Vb, *Gb, *Ub;
    float *o_kp, *o_vp, *o_ks, *o_vs, *o_cp, *o_cs; float* kmean;
    template <bool GUARD>
    __device__ __forceinline__ void run(const f32x4 (&acc)[2][2][4][2], const Unit& u, int wr, int wc, int fr, int fq) const {
        const int pn = u.pn, typ = pn >> 2, rbase = u.pm * BM + wr * 64 + fr;
        float rs[2][4]; load_rstd8<GUARD>(ss, rbase, rs);
        if (typ <= 1) {
            const int head = 2 * (pn & 3) + (wc >> 1), i0 = 32 * (wc & 1) + 8 * fq, colb = head * HD + i0;
            f32x4 cs[2][2];
#pragma unroll
            for (int bj = 0; bj < 2; ++bj) { cs[bj][0] = (f32x4){0.f, 0.f, 0.f, 0.f}; cs[bj][1] = (f32x4){0.f, 0.f, 0.f, 0.f}; }
#pragma unroll
            for (int am = 0; am < 4; ++am) {
                const int ai = am >> 1;
                f32x4 c4[2][2], s4[2][2];
#pragma unroll
                for (int mm = 0; mm < 2; ++mm) { const int m = (am & 1) * 2 + mm, row = rbase + ai * HALF + m * 16;
                    const int pidx = row < MP ? (row & (SEQ - 1)) : SEQ + ((row - MP) & (DS - 1));
#pragma unroll
                    for (int n = 0; n < 2; ++n) { c4[mm][n] = *(const f32x4*)(cosT + pidx * 64 + i0 + 4 * n); s4[mm][n] = *(const f32x4*)(sinT + pidx * 64 + i0 + 4 * n); } }
#pragma unroll
                for (int mm = 0; mm < 2; ++mm) {
                    const int m = (am & 1) * 2 + mm, row = rbase + ai * HALF + m * 16;
                    if (!GUARD || row < MV) {
                        const float rstd = rs[ai][m];
                        f32x4 o1[2], o2[2];
#pragma unroll
                        for (int n = 0; n < 2; ++n) { const f32x4 x1 = acc[ai][0][m][n] * rstd, x2 = acc[ai][1][m][n] * rstd;
                            o1[n] = x1 * c4[mm][n] - x2 * s4[mm][n]; o2[n] = x2 * c4[mm][n] + x1 * s4[mm][n]; }
                        bf16_t* dst = (typ == 0 ? Qb : Kb) + (size_t)row * 1024 + colb;
                        *(u32x4*)dst = pack8f(o1[0], o1[1]); *(u32x4*)(dst + 64) = pack8f(o2[0], o2[1]);
                        if (typ == 1) {
                            float* od = ((!GUARD || row < MP) ? o_kp + (size_t)row * 1024 : o_ks + (size_t)(row - MP) * 1024) + colb;
                            if (KV_NT_STORE) { __builtin_nontemporal_store(o1[0], (f32x4*)od); __builtin_nontemporal_store(o1[1], (f32x4*)(od + 4)); __builtin_nontemporal_store(o2[0], (f32x4*)(od + 64)); __builtin_nontemporal_store(o2[1], (f32x4*)(od + 68)); }
                            else { *(f32x4*)od = o1[0]; *(f32x4*)(od + 4) = o1[1]; *(f32x4*)(od + 64) = o2[0]; *(f32x4*)(od + 68) = o2[1]; }
                            cs[0][0] += o1[0]; cs[0][1] += o1[1]; cs[1][0] += o2[0]; cs[1][1] += o2[1];
                        }
                    }
                }
                asm volatile("" ::: "memory");
            }
            if (!GUARD && typ == 1) {
#pragma unroll
                for (int hf = 0; hf < 2; ++hf)
#pragma unroll
                    for (int n = 0; n < 2; ++n)
#pragma unroll
                        for (int e = 0; e < 4; ++e) {
                            float v = cs[hf][n][e];
                            v += __shfl_xor(v, 1); v += __shfl_xor(v, 2); v += __shfl_xor(v, 4); v += __shfl_xor(v, 8);
                            if (fr == 0) atomicAdd(kmean + ((size_t)u.pm * NH + head) * HD + 64 * hf + i0 + 4 * n + e, v);
                        }
            }
        } else if (typ <= 3) {
            const int colb = (pn & 3) * 256 + 32 * wc + 8 * fq;
#pragma unroll
            for (int ai = 0; ai < 2; ++ai)
#pragma unroll
                for (int m = 0; m < 4; ++m) {
                    const int row = rbase + ai * HALF + m * 16;
                    if (!GUARD || row < MV) {
                        const float rstd = rs[ai][m];
#pragma unroll
                        for (int bj = 0; bj < 2; ++bj) {
                            const f32x4 v0 = acc[ai][bj][m][0] * rstd, v1 = acc[ai][bj][m][1] * rstd;
                            *(u32x4*)((typ == 2 ? Vb : Gb) + (size_t)row * 1024 + colb + bj * HALF) = pack8f(v0, v1);
                            if (typ == 2) {
                                float* od = ((!GUARD || row < MP) ? o_vp + (size_t)row * 1024 : o_vs + (size_t)(row - MP) * 1024) + colb + bj * HALF;
                                if (KV_NT_STORE) { __builtin_nontemporal_store(v0, (f32x4*)od); __builtin_nontemporal_store(v1, (f32x4*)(od + 4)); } else { *(f32x4*)od = v0; *(f32x4*)(od + 4) = v1; }
                            }
                        }
                    }
                }
        } else {
            const int ch = (pn - 16) * 128 + 32 * wc + 8 * fq;
#pragma unroll
            for (int ai = 0; ai < 2; ++ai)
#pragma unroll
                for (int m = 0; m < 4; ++m) {
                    const int row = rbase + ai * HALF + m * 16;
                    if (!GUARD || row < MV) {
                        const float rstd = rs[ai][m], r2 = rstd * rstd;
                        const f32x4 u0 = acc[ai][0][m][0] * acc[ai][1][m][0] * r2, u1 = acc[ai][0][m][1] * acc[ai][1][m][1] * r2;
                        *(u32x4*)(Ub + (size_t)row * 1024 + ch) = pack8f(u0, u1);
                        if (!GUARD) { const int t = row & (SEQ - 1);
                            if (t >= SEQ - 2) { float* od = o_cp + ((size_t)(row >> 12) * 2 + (t - (SEQ - 2))) * CC + ch; *(f32x4*)od = u0; *(f32x4*)(od + 4) = u1; } }
                        else { const int t = (row - MP) & (DS - 1);
                            if (t >= DS - 2) { float* od = o_cs + ((size_t)((row - MP) >> 2) * 2 + (t - (DS - 2))) * CC + ch; *(f32x4*)od = u0; *(f32x4*)(od + 4) = u1; } }
                    }
                }
        }
    }
};

__device__ __forceinline__ int rcol(int pn, int wc, int bj, int fq) { return pn * BM + 64 * wc + 32 * bj + 8 * fq; }
__device__ __forceinline__ f32x4 bflo4(const u32x4 w) { return (f32x4){__uint_as_float(w.x << 16), __uint_as_float(w.x & 0xffff0000u), __uint_as_float(w.y << 16), __uint_as_float(w.y & 0xffff0000u)}; }
__device__ __forceinline__ f32x4 bfhi4(const u32x4 w) { return (f32x4){__uint_as_float(w.z << 16), __uint_as_float(w.z & 0xffff0000u), __uint_as_float(w.w << 16), __uint_as_float(w.w & 0xffff0000u)}; }
struct EpiResid {
    static constexpr bool PERM = true, AFTER_DRAIN = false, ACC_INIT = true;
    bf16_t* XB; unsigned long long* ss; int noat;
    __device__ __forceinline__ void init_load(u32x4 (&raw)[2][4][2], const Unit& u, int wr, int wc, int fr, int fq) const {
        const int rbase = u.pm * BM + wr * 64 + fr;
#pragma unroll
        for (int ai = 0; ai < 2; ++ai)
#pragma unroll
            for (int m = 0; m < 4; ++m)
#pragma unroll
                for (int bj = 0; bj < 2; ++bj) raw[ai][m][bj] = *(const u32x4*)(XB + (size_t)(rbase + ai * HALF + m * 16) * DM + rcol(u.pn, wc, bj, fq));
    }
    __device__ __forceinline__ void init_acc(f32x4 (&acc)[2][2][4][2], const u32x4 (&raw)[2][4][2]) const {
#pragma unroll
        for (int ai = 0; ai < 2; ++ai)
#pragma unroll
            for (int m = 0; m < 4; ++m)
#pragma unroll
                for (int bj = 0; bj < 2; ++bj) { acc[ai][bj][m][0] = bflo4(raw[ai][m][bj]); acc[ai][bj][m][1] = bfhi4(raw[ai][m][bj]); }
    }
    __device__ __forceinline__ void run_narrow(const f32x4 (&v)[2], int pn, int wc, int bj, int n, int fr, int fq) const {
        const int col0 = rcol(pn, wc, bj, fq) + 4 * n;
        u32x2 xo[2];
#pragma unroll
        for (int m = 0; m < 2; ++m) xo[m] = *(const u32x2*)(XB + (size_t)(MP + 16 * m + fr) * DM + col0);
#pragma unroll
        for (int m = 0; m < 2; ++m) {
            const int row = MP + 16 * m + fr;
            const f32x4 a0 = (f32x4){__uint_as_float(xo[m].x << 16), __uint_as_float(xo[m].x & 0xffff0000u), __uint_as_float(xo[m].y << 16), __uint_as_float(xo[m].y & 0xffff0000u)} + v[m];
            float part = (a0[0] * a0[0] + a0[1] * a0[1]) + (a0[2] * a0[2] + a0[3] * a0[3]);
            *(u32x2*)(XB + (size_t)row * DM + col0) = pack4f(a0);
            part += __shfl_xor(part, 16); part += __shfl_xor(part, 32);
            if (fq == 0) atomicAdd(ss + row, (unsigned long long)(part * SS_SCALE + 0.5f));
        }
    }
    template <bool GUARD>
    __device__ __forceinline__ void run(const f32x4 (&acc)[2][2][4][2], const Unit& u, int wr, int wc, int fr, int fq) const {
        const int rbase = u.pm * BM + wr * 64 + fr;
        u32x4 xo[2][4][2];
#pragma unroll
        for (int ai = 0; ai < 2; ++ai)
#pragma unroll
            for (int m = 0; m < 4; ++m) {
                const int row = rbase + ai * HALF + m * 16;
#pragma unroll
                for (int bj = 0; bj < 2; ++bj) xo[ai][m][bj] = (GUARD && row < MV) ? *(const u32x4*)(XB + (size_t)row * DM + rcol(u.pn, wc, bj, fq)) : (u32x4){0u, 0u, 0u, 0u};
            }
        asm volatile("" ::: "memory");
#pragma unroll
        for (int ai = 0; ai < 2; ++ai)
#pragma unroll
            for (int m = 0; m < 4; ++m) {
                const int row = rbase + ai * HALF + m * 16;
                float part = 0.f;
                if (!GUARD || row < MV) {
#pragma unroll
                    for (int bj = 0; bj < 2; ++bj) {
                        const f32x4 a0 = GUARD ? bflo4(xo[ai][m][bj]) + acc[ai][bj][m][0] : acc[ai][bj][m][0];
                        const f32x4 a1 = GUARD ? bfhi4(xo[ai][m][bj]) + acc[ai][bj][m][1] : acc[ai][bj][m][1];
                        part += (a0[0] * a0[0] + a0[1] * a0[1]) + (a0[2] * a0[2] + a0[3] * a0[3]) + (a1[0] * a1[0] + a1[1] * a1[1]) + (a1[2] * a1[2] + a1[3] * a1[3]);
                        if (XB_WT_STORE) store16_wt(XB + (size_t)row * DM + rcol(u.pn, wc, bj, fq), pack8f(a0, a1)); else *(u32x4*)(XB + (size_t)row * DM + rcol(u.pn, wc, bj, fq)) = pack8f(a0, a1);
                    }
                }
                part += __shfl_xor(part, 16); part += __shfl_xor(part, 32);
                if (fq == 0 && (!GUARD || row < MV)) { if (!noat) atomicAdd(ss + row, (unsigned long long)(part * SS_SCALE + 0.5f)); else if (part < 0.f) ss[row] = 1ull; }
            }
    }
};

struct EpiSwiGLU {
    static constexpr bool PERM = true, AFTER_DRAIN = false, ACC_INIT = false;
    const unsigned long long* ss; bf16_t* H;
    template <bool GUARD>
    __device__ __forceinline__ void run_half(const f32x4 (&acc)[2][2][4][2], const Unit& u, int wr, int wc, int fr, int fq) const {
        const int rbase = u.pm * BM + u.half * HALF + wr * 64 + fr, col0 = u.pn * HALF + 32 * wc + 8 * fq;
        unsigned long long s[4];
#pragma unroll
        for (int m = 0; m < 4; ++m) s[m] = ss[rbase + m * 16];
#pragma unroll
        for (int m = 0; m < 4; ++m) {
            const int row = rbase + m * 16; const float rstd = ss_to_rstd(s[m]);
            f32x4 h[2];
#pragma unroll
            for (int n = 0; n < 2; ++n)
#pragma unroll
                for (int e = 0; e < 4; ++e) { const float g = acc[0][0][m][n][e] * rstd, up = acc[0][1][m][n][e] * rstd;
                    h[n][e] = g * up * __builtin_amdgcn_rcpf(1.0f + __expf(-g)); }
            *(u32x4*)(H + ((size_t)(col0 >> 6) * MPAD + row) * 64 + (col0 & 63)) = pack8f(h[0], h[1]);
        }
    }
    template <bool GUARD>
    __device__ __forceinline__ void run(const f32x4 (&acc)[2][2][4][2], const Unit& u, int wr, int wc, int fr, int fq) const {
        const int rbase = u.pm * BM + wr * 64 + fr, col0 = u.pn * HALF + 32 * wc + 8 * fq;
        float rs[2][4]; load_rstd8<GUARD>(ss, rbase, rs);
#pragma unroll
        for (int ai = 0; ai < 2; ++ai)
#pragma unroll
            for (int m = 0; m < 4; ++m) {
                const int row = rbase + ai * HALF + m * 16;
                if (!GUARD || row < MV) {
                    const float rstd = rs[ai][m];
                    f32x4 h[2];
#pragma unroll
                    for (int n = 0; n < 2; ++n)
#pragma unroll
                        for (int e = 0; e < 4; ++e) { const float g = acc[ai][0][m][n][e] * rstd, up = acc[ai][1][m][n][e] * rstd;
                            h[n][e] = g * up * __builtin_amdgcn_rcpf(1.0f + __expf(-g)); }
                    *(u32x4*)(H + ((size_t)(col0 >> 6) * MPAD + row) * 64 + (col0 & 63)) = pack8f(h[0], h[1]);
                }
            }
    }
};

struct EpiFinal {
    static constexpr bool PERM = true, AFTER_DRAIN = true, ACC_INIT = true;
    const bf16_t* XB; unsigned long long* ss; const float* gfin; float* out; unsigned* cnt; unsigned* tmo;
    __device__ __forceinline__ bool wait_count(unsigned* c, unsigned want, int lane) const {
        unsigned sp = 0;
        while ((unsigned)__builtin_amdgcn_readfirstlane(__hip_atomic_load(c, __ATOMIC_RELAXED, __HIP_MEMORY_SCOPE_AGENT)) < want) {
            __builtin_amdgcn_s_sleep(1);
            if ((++sp & 255u) == 0u) { if (__hip_atomic_load(tmo, __ATOMIC_RELAXED, __HIP_MEMORY_SCOPE_AGENT)) return false;
                if (sp > (1u << 22)) { if (lane == 0) __hip_atomic_store(tmo, 1u, __ATOMIC_RELAXED, __HIP_MEMORY_SCOPE_AGENT); return false; } }
        }
        return true;
    }
    __device__ __forceinline__ void init_load(u32x4 (&raw)[2][4][2], const Unit& u, int wr, int wc, int fr, int fq) const {
        const int rbase = u.pm * BM + wr * 64 + fr;
#pragma unroll
        for (int ai = 0; ai < 2; ++ai)
#pragma unroll
            for (int m = 0; m < 4; ++m)
#pragma unroll
                for (int bj = 0; bj < 2; ++bj) raw[ai][m][bj] = *(const u32x4*)(XB + (size_t)(rbase + ai * HALF + m * 16) * DM + rcol(u.pn, wc, bj, fq));
    }
    __device__ __forceinline__ void init_acc(f32x4 (&acc)[2][2][4][2], const u32x4 (&raw)[2][4][2]) const {
#pragma unroll
        for (int ai = 0; ai < 2; ++ai)
#pragma unroll
            for (int m = 0; m < 4; ++m)
#pragma unroll
                for (int bj = 0; bj < 2; ++bj) { acc[ai][bj][m][0] = bflo4(raw[ai][m][bj]); acc[ai][bj][m][1] = bfhi4(raw[ai][m][bj]); }
    }
    __device__ __forceinline__ void sumsq4(const f32x4 (&v)[2][4][2], int rbase, int fq) const {
#pragma unroll
        for (int m = 0; m < 4; ++m) {
            float part = 0.f;
#pragma unroll
            for (int bj = 0; bj < 2; ++bj) { const f32x4 a0 = v[bj][m][0], a1 = v[bj][m][1];
                part += (a0[0] * a0[0] + a0[1] * a0[1]) + (a0[2] * a0[2] + a0[3] * a0[3]) + (a1[0] * a1[0] + a1[1] * a1[1]) + (a1[2] * a1[2] + a1[3] * a1[3]); }
            part += __shfl_xor(part, 16); part += __shfl_xor(part, 32);
            if (fq == 0) atomicAdd(ss + rbase + m * 16, (unsigned long long)(part * SS_SCALE + 0.5f));
        }
    }
    template <int NM>
    __device__ __forceinline__ void write_y(const f32x4 (&v)[2][4][2], int rbase, int pn, int wc, int fq, bool bad) const {
        unsigned long long s[NM];
#pragma unroll
        for (int m = 0; m < NM; ++m) s[m] = __hip_atomic_load(ss + rbase + m * 16, __ATOMIC_RELAXED, __HIP_MEMORY_SCOPE_AGENT);
        f32x4 g[2][2];
#pragma unroll
        for (int bj = 0; bj < 2; ++bj)
#pragma unroll
            for (int n = 0; n < 2; ++n) g[bj][n] = *(const f32x4*)(gfin + rcol(pn, wc, bj, fq) + 4 * n);
        const float qnan = __builtin_nanf("");
#pragma unroll
        for (int m = 0; m < NM; ++m) {
            const float rstd = bad ? qnan : ss_to_rstd(s[m]);
            float* dst = out + (size_t)(rbase + m * 16) * DM;
#pragma unroll
            for (int bj = 0; bj < 2; ++bj)
#pragma unroll
                for (int n = 0; n < 2; ++n) *(f32x4*)(dst + rcol(pn, wc, bj, fq) + 4 * n) = v[bj][m][n] * rstd * g[bj][n];
        }
    }
    __device__ __forceinline__ void fused(f32x4 (&acc)[2][2][4][2], const Unit& u, int wr, int wc, int fr, int fq, PG8_LAS unsigned char* lds, int wid, int lane) const {
        const int rbase = u.pm * BM + wr * 64 + fr;
        sumsq4(acc[0], rbase, fq);
        sumsq4(acc[1], rbase + HALF, fq);
        asm volatile("s_waitcnt vmcnt(0)" ::: "memory");
        if (lane == 0) __hip_atomic_fetch_add(cnt + 64 * u.pm, 1u, __ATOMIC_RELAXED, __HIP_MEMORY_SCOPE_AGENT);
        PG8_LAS unsigned* flag = (PG8_LAS unsigned*)lds;
        if (wid == 0) { const bool ok = wait_count(cnt + 64 * u.pm, 64u, lane); __builtin_amdgcn_fence(__ATOMIC_ACQUIRE, "agent"); if (lane == 0) flag[0] = ok ? 0u : 1u; }
        asm volatile("s_waitcnt vmcnt(0) lgkmcnt(0)" ::: "memory"); __builtin_amdgcn_s_barrier(); asm volatile("" ::: "memory");
        const bool bad = flag[0] != 0u;
        write_y<4>(acc[0], rbase, u.pn, wc, fq, bad);
        write_y<4>(acc[1], rbase + HALF, u.pn, wc, fq, bad);
    }
    __device__ __forceinline__ void run_narrow(const f32x4 (&v)[2], int pn, int wc, int bj, int n, int fr, int fq) const {
        const int col0 = rcol(pn, wc, bj, fq) + 4 * n, lane = fq * 16 + fr;
        u32x2 xo[2]; f32x4 x[2];
#pragma unroll
        for (int m = 0; m < 2; ++m) xo[m] = *(const u32x2*)(XB + (size_t)(MP + 16 * m + fr) * DM + col0);
#pragma unroll
        for (int m = 0; m < 2; ++m) {
            x[m] = (f32x4){__uint_as_float(xo[m].x << 16), __uint_as_float(xo[m].x & 0xffff0000u), __uint_as_float(xo[m].y << 16), __uint_as_float(xo[m].y & 0xffff0000u)} + v[m];
            float part = (x[m][0] * x[m][0] + x[m][1] * x[m][1]) + (x[m][2] * x[m][2] + x[m][3] * x[m][3]);
            part += __shfl_xor(part, 16); part += __shfl_xor(part, 32);
            if (fq == 0) atomicAdd(ss + MP + 16 * m + fr, (unsigned long long)(part * SS_SCALE + 0.5f));
        }
        asm volatile("s_waitcnt vmcnt(0)" ::: "memory");
        if (lane == 0) __hip_atomic_fetch_add(cnt + 64 * (MP / BM), 1u, __ATOMIC_RELAXED, __HIP_MEMORY_SCOPE_AGENT);
        const bool ok = wait_count(cnt + 64 * (MP / BM), (unsigned)(DM / BM * 16), lane);
        __builtin_amdgcn_fence(__ATOMIC_ACQUIRE, "agent");
        asm volatile("s_waitcnt vmcnt(0)" ::: "memory");
        const f32x4 g4 = *(const f32x4*)(gfin + col0); const float qnan = __builtin_nanf("");
#pragma unroll
        for (int m = 0; m < 2; ++m) {
            const unsigned long long sv = __hip_atomic_load(ss + MP + 16 * m + fr, __ATOMIC_RELAXED, __HIP_MEMORY_SCOPE_AGENT);
            const float rstd = ok ? ss_to_rstd(sv) : qnan;
            *(f32x4*)(out + (size_t)(MP + 16 * m + fr) * DM + col0) = x[m] * rstd * g4;
        }
    }
};
template <class Epi, class Sched, bool ALIGN_EPI = false, bool SP2 = false>
__device__ __forceinline__ void gemm_phase(PG8_LAS unsigned char* lds, const Gemm g, const Sched& S, const Epi& E, const int wv  ) {
    int tid = wv * 64 + (int)__builtin_amdgcn_mbcnt_hi(~0u, __builtin_amdgcn_mbcnt_lo(~0u, 0u)); asm volatile("" : "+v"(tid));
    const int wid = wv, lane = tid & 63, wr = wid >> 2, wc = wid & 3, fr = lane & 15, fq = lane >> 4;
    static_assert(SP2 || !Epi::ACC_INIT, "accumulator initialisation from the epilogue's addend is wired into the SP2 prologue only");
    const int K = g.K, nt = K / BK;
    unsigned voffA[2], voffB[2];
#pragma unroll
    for (int i = 0; i < 2; ++i) { int R, C; stage_rc(tid * 16 + i * 8192, R, C); const int Rb = Epi::PERM ? ((R & ~31) + perm32(R & 31)) : R;
        voffA[i] = (unsigned)(R * g.lda + C) * 2u; voffB[i] = (unsigned)(Rb * g.ldb + C) * 2u; }
    const size_t kstepA = g.kstepA, kstepB = g.kstepB;
    const size_t hstepA = (size_t)HALF * g.lda * 2, hstepB = (size_t)HALF * g.ldb * 2;
    const size_t tstepA = 2 * hstepA, tstepB = 2 * hstepB;
    const unsigned ldsw = (unsigned)wid * 1024u;
    const int aoff = lds_byte(wr * 64 + fr, fq * 8), boff = lds_byte(wc * 32 + fr, fq * 8);
#define PG8_SA(b, h) (((b) * 2 + (h)) * HTB)
#define PG8_SB(b, h) ((4 + (b) * 2 + (h)) * HTB)
#define PG8_STAGE_AUX(bufoff, gbase, voff, aux) do { _Pragma("unroll") for (int _i = 0; _i < 2; ++_i) \
        __builtin_amdgcn_global_load_lds((const unsigned*)((const char*)(gbase) + (voff)[_i]), (PG8_LAS unsigned*)(lds + (bufoff) + ldsw + _i * 8192), 16, 0, aux); } while (0)
#define PG8_STAGE(bufoff, gbase, voff) PG8_STAGE_AUX(bufoff, gbase, voff, GEMM_A_AUX)
#define PG8_STAGEB(bufoff, gbase, voff) PG8_STAGE_AUX(bufoff, gbase, voff, GEMM_B_AUX)
#define PG8_LDA(dst, b, h) do { _Pragma("unroll") for (int m = 0; m < 4; ++m) _Pragma("unroll") for (int k = 0; k < 2; ++k) dst[m][k] = *(const PG8_LAS bf16x8*)(lds + PG8_SA(b, h) + aoff + m * 2048 + k * 1024); } while (0)
#define PG8_LDB(dst, b, h) do { _Pragma("unroll") for (int n = 0; n < 2; ++n) _Pragma("unroll") for (int k = 0; k < 2; ++k) dst[n][k] = *(const PG8_LAS bf16x8*)(lds + PG8_SB(b, h) + boff + n * 2048 + k * 1024); } while (0)
#define PG8_MMA(ai, bj, At, Bt) do { __builtin_amdgcn_s_setprio(1); _Pragma("unroll") for (int m = 0; m < 4; ++m) _Pragma("unroll") for (int n = 0; n < 2; ++n) _Pragma("unroll") for (int k = 0; k < 2; ++k) \
        acc[ai][bj][m][n] = __builtin_amdgcn_mfma_f32_16x16x32_bf16(Bt[n][k], At[m][k], acc[ai][bj][m][n], 0, 0, 0); __builtin_amdgcn_s_setprio(0); } while (0)
#define PG8_WAIT_V(n) asm volatile("s_waitcnt vmcnt(" #n ")" ::: "memory")
#define PG8_WAIT_L(n) asm volatile("s_waitcnt lgkmcnt(" #n ")" ::: "memory")
#define PG8_BAR __builtin_amdgcn_s_barrier()
#define PG8_SCHED __builtin_amdgcn_sched_barrier(0)
    Unit cur, nxt; int ui = 0;
    if (!S.next(0, cur)) return;
    f32x4 acc[2][2][4][2];
#pragma unroll
    for (int a = 0; a < 2; ++a)
#pragma unroll
        for (int b = 0; b < 2; ++b)
#pragma unroll
            for (int m = 0; m < 4; ++m)
#pragma unroll
                for (int n = 0; n < 2; ++n) acc[a][b][m][n] = (f32x4){0.f, 0.f, 0.f, 0.f};
    bf16x8 At[4][2], B0[2][2], B1[2][2];
    const char* cA = (const char*)g.A + (size_t)cur.pm * tstepA + (size_t)(cur.pn >> g.gshift) * g.gstride; const char* cB = (const char*)g.Bt + (size_t)cur.pn * tstepB;
    S.a_ready(cur);
    if constexpr (SP2) {
        PG8_STAGEB(PG8_SB(0, 0), cB, voffB); PG8_STAGEB(PG8_SB(0, 1), cB + hstepB, voffB); PG8_STAGE(PG8_SA(0, 0), cA, voffA); PG8_STAGE(PG8_SA(0, 1), cA + hstepA, voffA);
        if constexpr (Epi::ACC_INIT) {
            u32x4 raw[2][4][2];
            E.init_load(raw, cur, wr, wc, fr, fq);
            if (wr == 1) PG8_BAR;
            PG8_WAIT_V(18); PG8_BAR;
            PG8_STAGEB(PG8_SB(1, 0), cB + kstepB, voffB); PG8_STAGE(PG8_SA(1, 0), cA + kstepA, voffA); PG8_STAGEB(PG8_SB(1, 1), cB + hstepB + kstepB, voffB);
            PG8_WAIT_V(6); PG8_BAR;
            E.init_acc(acc, raw);
        } else {
        if (wr == 1) PG8_BAR;
        PG8_WAIT_V(2); PG8_BAR;
        PG8_STAGEB(PG8_SB(1, 0), cB + kstepB, voffB); PG8_STAGE(PG8_SA(1, 0), cA + kstepA, voffA); PG8_STAGEB(PG8_SB(1, 1), cB + hstepB + kstepB, voffB);
        PG8_WAIT_V(6); PG8_BAR;
        }
    } else {
        PG8_STAGEB(PG8_SB(0, 0), cB, voffB); PG8_STAGE(PG8_SA(0, 0), cA, voffA); PG8_STAGEB(PG8_SB(0, 1), cB + hstepB, voffB); PG8_STAGE(PG8_SA(0, 1), cA + hstepA, voffA);
        if (wr == 1) PG8_BAR;
        PG8_WAIT_V(4); PG8_BAR;
        PG8_STAGEB(PG8_SB(1, 0), cB + kstepB, voffB); PG8_STAGE(PG8_SA(1, 0), cA + kstepA, voffA); PG8_STAGEB(PG8_SB(1, 1), cB + hstepB + kstepB, voffB);
        PG8_WAIT_V(6); PG8_BAR;
    }
    for (;;) {
        const bool has_next = S.next(ui + 1, nxt);
        const char* nA = has_next ? (const char*)g.A + (size_t)nxt.pm * tstepA + (size_t)(nxt.pn >> g.gshift) * g.gstride : cA; const char* nB = has_next ? (const char*)g.Bt + (size_t)nxt.pn * tstepB : cB;
        for (int t = 0; t < nt; t += 2) {
            const bool last = (t == nt - 2);
            const char* a1 = cA + (size_t)(t + 1) * kstepA;
            const char* a2 = last ? nA : cA + (size_t)(t + 2) * kstepA; const char* b2 = last ? nB : cB + (size_t)(t + 2) * kstepB;
            const char* a3 = a2 + kstepA; const char* b3 = b2 + kstepB;
            if (last && has_next) S.a_ready(nxt);
            if constexpr (SP2) {
            PG8_LDB(B0, 0, 0); PG8_LDB(B1, 0, 1); PG8_SCHED; PG8_LDA(At, 0, 0); PG8_STAGE(PG8_SA(1, 1), a1 + hstepA, voffA);
            PG8_WAIT_V(8); PG8_WAIT_L(0); PG8_BAR; PG8_MMA(0, 0, At, B0); PG8_MMA(0, 1, At, B1); PG8_BAR; PG8_SCHED;
            PG8_LDA(At, 0, 1); PG8_STAGEB(PG8_SB(0, 0), b2, voffB); PG8_STAGEB(PG8_SB(0, 1), b2 + hstepB, voffB); PG8_STAGE(PG8_SA(0, 0), a2, voffA);
            PG8_WAIT_V(8); PG8_WAIT_L(0); PG8_BAR; PG8_MMA(1, 0, At, B0); PG8_MMA(1, 1, At, B1); PG8_BAR; PG8_SCHED;
            PG8_LDB(B0, 1, 0); PG8_LDB(B1, 1, 1); PG8_SCHED; PG8_LDA(At, 1, 0); PG8_STAGE(PG8_SA(0, 1), a2 + hstepA, voffA);
            PG8_WAIT_V(8); PG8_WAIT_L(0); PG8_BAR; PG8_MMA(0, 0, At, B0); PG8_MMA(0, 1, At, B1); PG8_BAR; PG8_SCHED;
            PG8_LDA(At, 1, 1); PG8_STAGEB(PG8_SB(1, 0), b3, voffB); PG8_STAGEB(PG8_SB(1, 1), b3 + hstepB, voffB); PG8_STAGE(PG8_SA(1, 0), a3, voffA);
            PG8_WAIT_V(8); PG8_WAIT_L(0); PG8_BAR; PG8_MMA(1, 0, At, B0); PG8_MMA(1, 1, At, B1); PG8_BAR; PG8_SCHED;
            } else {
            PG8_LDB(B0, 0, 0); PG8_SCHED; PG8_LDA(At, 0, 0); PG8_STAGE(PG8_SA(1, 1), a1 + hstepA, voffA);
            PG8_WAIT_L(8); PG8_BAR; PG8_WAIT_L(0); PG8_MMA(0, 0, At, B0); PG8_BAR; PG8_SCHED;
            PG8_LDB(B1, 0, 1); PG8_STAGEB(PG8_SB(0, 0), b2, voffB);
            PG8_BAR; PG8_WAIT_L(0); PG8_MMA(0, 1, At, B1); PG8_BAR;
            PG8_LDA(At, 0, 1); PG8_STAGE(PG8_SA(0, 0), a2, voffA);
            PG8_BAR; PG8_WAIT_L(0); PG8_MMA(1, 0, At, B0); PG8_BAR; PG8_SCHED;
            PG8_STAGEB(PG8_SB(0, 1), b2 + hstepB, voffB);
            PG8_WAIT_V(6); PG8_BAR; PG8_MMA(1, 1, At, B1); PG8_BAR;
            PG8_LDB(B0, 1, 0); PG8_SCHED; PG8_LDA(At, 1, 0); PG8_STAGE(PG8_SA(0, 1), a2 + hstepA, voffA);
            PG8_WAIT_L(8); PG8_BAR; PG8_WAIT_L(0); PG8_MMA(0, 0, At, B0); PG8_BAR; PG8_SCHED;
            PG8_LDB(B1, 1, 1); PG8_STAGEB(PG8_SB(1, 0), b3, voffB);
            PG8_BAR; PG8_WAIT_L(0); PG8_MMA(0, 1, At, B1); PG8_BAR;
            PG8_LDA(At, 1, 1); PG8_STAGE(PG8_SA(1, 0), a3, voffA);
            PG8_BAR; PG8_WAIT_L(0); PG8_MMA(1, 0, At, B0); PG8_BAR; PG8_SCHED;
            PG8_STAGEB(PG8_SB(1, 1), b3 + hstepB, voffB);
            PG8_WAIT_V(6); PG8_BAR; PG8_MMA(1, 1, At, B1); PG8_BAR;
            }
        }
        if constexpr (ALIGN_EPI) { if (wr == 0) PG8_BAR; }
        if constexpr (!Epi::AFTER_DRAIN) { E.template run<false>(acc, cur, wr, wc, fr, fq); S.done(cur); }
        if (!has_next) break;
#pragma unroll
        for (int a = 0; a < 2; ++a)
#pragma unroll
            for (int b = 0; b < 2; ++b)
#pragma unroll
                for (int m = 0; m < 4; ++m)
#pragma unroll
                    for (int n = 0; n < 2; ++n) acc[a][b][m][n] = (f32x4){0.f, 0.f, 0.f, 0.f};
        cur = nxt; cA = nA; cB = nB; ++ui;
        if constexpr (Epi::ACC_INIT) { u32x4 raw[2][4][2]; E.init_load(raw, cur, wr, wc, fr, fq); E.init_acc(acc, raw); }
        if constexpr (ALIGN_EPI) { if (wr == 1) PG8_BAR; }
    }
    PG8_WAIT_V(0);
    if constexpr (!ALIGN_EPI) { if (wr == 0) PG8_BAR; }
    PG8_BAR;
    if constexpr (Epi::AFTER_DRAIN) { E.fused(acc, cur, wr, wc, fr, fq, lds, wid, lane); S.done(cur); }
#undef PG8_SA
#undef PG8_SB
#undef PG8_STAGE
#undef PG8_STAGEB
#undef PG8_STAGE_AUX
#undef PG8_LDA
#undef PG8_LDB
#undef PG8_MMA
#undef PG8_WAIT_V
#undef PG8_WAIT_L
#undef PG8_BAR
#undef PG8_SCHED
}

struct HalfOrder {
    StaticOrder so; long L; int half;
    __device__ __forceinline__ bool next(int i, Unit& u) const { if (i > 0) return false; so.map(L, u); u.half = half; return true; }
    __device__ __forceinline__ void a_ready(const Unit&) const {}
    __device__ __forceinline__ void done(const Unit&) const {}
};
template <class Epi, class Sched>
__device__ __forceinline__ void gemm_phase_hm(PG8_LAS unsigned char* lds, const Gemm g, const Sched& S, const Epi& E, const int wv) {
    int tid = wv * 64 + (int)__builtin_amdgcn_mbcnt_hi(~0u, __builtin_amdgcn_mbcnt_lo(~0u, 0u)); asm volatile("" : "+v"(tid));
    const int wid = wv, lane = tid & 63, wr = wid >> 2, wc = wid & 3, fr = lane & 15, fq = lane >> 4;
    const int K = g.K, nt = K / BK;
    unsigned voffA[2], voffB[2];
#pragma unroll
    for (int i = 0; i < 2; ++i) { int R, C; stage_rc(tid * 16 + i * 8192, R, C); const int Rb = Epi::PERM ? ((R & ~31) + perm32(R & 31)) : R;
        voffA[i] = (unsigned)(R * g.lda + C) * 2u; voffB[i] = (unsigned)(Rb * g.ldb + C) * 2u; }
    const size_t kstepA = g.kstepA, kstepB = g.kstepB;
    const size_t hstepA = (size_t)HALF * g.lda * 2, hstepB = (size_t)HALF * g.ldb * 2;
    const size_t tstepA = 2 * hstepA, tstepB = 2 * hstepB;
    const unsigned ldsw = (unsigned)wid * 1024u;
    const int aoff = lds_byte(wr * 64 + fr, fq * 8), boff = lds_byte(wc * 32 + fr, fq * 8);
#define PG8_SA(b, h) (((b) * 2 + (h)) * HTB)
#define PG8_SB(b, h) ((4 + (b) * 2 + (h)) * HTB)
#define PG8_STAGE(bufoff, gbase, voff) do { _Pragma("unroll") for (int _i = 0; _i < 2; ++_i) \
        __builtin_amdgcn_global_load_lds((const unsigned*)((const char*)(gbase) + (voff)[_i]), (PG8_LAS unsigned*)(lds + (bufoff) + ldsw + _i * 8192), 16, 0, 0); } while (0)
#define PG8_LDA(dst, b, h) do { _Pragma("unroll") for (int m = 0; m < 4; ++m) _Pragma("unroll") for (int k = 0; k < 2; ++k) dst[m][k] = *(const PG8_LAS bf16x8*)(lds + PG8_SA(b, h) + aoff + m * 2048 + k * 1024); } while (0)
#define PG8_LDB(dst, b, h) do { _Pragma("unroll") for (int n = 0; n < 2; ++n) _Pragma("unroll") for (int k = 0; k < 2; ++k) dst[n][k] = *(const PG8_LAS bf16x8*)(lds + PG8_SB(b, h) + boff + n * 2048 + k * 1024); } while (0)
#define PG8_MMA(ai, bj, At, Bt) do { __builtin_amdgcn_s_setprio(1); _Pragma("unroll") for (int m = 0; m < 4; ++m) _Pragma("unroll") for (int n = 0; n < 2; ++n) _Pragma("unroll") for (int k = 0; k < 2; ++k) \
        acc[ai][bj][m][n] = __builtin_amdgcn_mfma_f32_16x16x32_bf16(Bt[n][k], At[m][k], acc[ai][bj][m][n], 0, 0, 0); __builtin_amdgcn_s_setprio(0); } while (0)
#define PG8_WAIT_V(n) asm volatile("s_waitcnt vmcnt(" #n ")" ::: "memory")
#define PG8_WAIT_L(n) asm volatile("s_waitcnt lgkmcnt(" #n ")" ::: "memory")
#define PG8_BAR __builtin_amdgcn_s_barrier()
#define PG8_SCHED __builtin_amdgcn_sched_barrier(0)
    Unit cur, nxt; int ui = 0;
    if (!S.next(0, cur)) return;
    f32x4 acc[2][2][4][2];
#pragma unroll
    for (int a = 0; a < 2; ++a)
#pragma unroll
        for (int b = 0; b < 2; ++b)
#pragma unroll
            for (int m = 0; m < 4; ++m)
#pragma unroll
                for (int n = 0; n < 2; ++n) acc[a][b][m][n] = (f32x4){0.f, 0.f, 0.f, 0.f};
    bf16x8 At[4][2], B0[2][2], B1[2][2];
    const char* cA = (const char*)g.A + (size_t)cur.pm * tstepA + (size_t)cur.half * hstepA + (size_t)(cur.pn >> g.gshift) * g.gstride; const char* cB = (const char*)g.Bt + (size_t)cur.pn * tstepB;
    PG8_STAGE(PG8_SB(0, 0), cB, voffB); PG8_STAGE(PG8_SB(0, 1), cB + hstepB, voffB); PG8_STAGE(PG8_SA(0, 0), cA, voffA);
    if (wr == 1) PG8_BAR;
    PG8_WAIT_V(0); PG8_BAR;
    PG8_STAGE(PG8_SB(1, 0), cB + kstepB, voffB); PG8_STAGE(PG8_SA(1, 0), cA + kstepA, voffA); PG8_STAGE(PG8_SB(1, 1), cB + hstepB + kstepB, voffB);
    PG8_WAIT_V(6); PG8_BAR;
    for (;;) {
        const bool has_next = S.next(ui + 1, nxt);
        const char* nA = has_next ? (const char*)g.A + (size_t)nxt.pm * tstepA + (size_t)nxt.half * hstepA + (size_t)(nxt.pn >> g.gshift) * g.gstride : cA; const char* nB = has_next ? (const char*)g.Bt + (size_t)nxt.pn * tstepB : cB;
        for (int t = 0; t < nt; t += 2) {
            const bool last = (t == nt - 2);
            const char* a2 = last ? nA : cA + (size_t)(t + 2) * kstepA; const char* b2 = last ? nB : cB + (size_t)(t + 2) * kstepB;
            const char* a3 = a2 + kstepA; const char* b3 = b2 + kstepB;
            PG8_LDB(B0, 0, 0); PG8_LDB(B1, 0, 1); PG8_SCHED; PG8_LDA(At, 0, 0);
            PG8_WAIT_V(6); PG8_WAIT_L(0); PG8_BAR; PG8_MMA(0, 0, At, B0); PG8_MMA(0, 1, At, B1); PG8_BAR; PG8_SCHED;
            PG8_STAGE(PG8_SB(0, 0), b2, voffB); PG8_STAGE(PG8_SB(0, 1), b2 + hstepB, voffB); PG8_STAGE(PG8_SA(0, 0), a2, voffA);
            PG8_WAIT_V(6); PG8_WAIT_L(0); PG8_BAR; PG8_BAR; PG8_SCHED;
            PG8_LDB(B0, 1, 0); PG8_LDB(B1, 1, 1); PG8_SCHED; PG8_LDA(At, 1, 0);
            PG8_WAIT_V(6); PG8_WAIT_L(0); PG8_BAR; PG8_MMA(0, 0, At, B0); PG8_MMA(0, 1, At, B1); PG8_BAR; PG8_SCHED;
            PG8_STAGE(PG8_SB(1, 0), b3, voffB); PG8_STAGE(PG8_SB(1, 1), b3 + hstepB, voffB); PG8_STAGE(PG8_SA(1, 0), a3, voffA);
            PG8_WAIT_V(6); PG8_WAIT_L(0); PG8_BAR; PG8_BAR; PG8_SCHED;
        }
        if (wr == 0) PG8_BAR;
        E.template run_half<false>(acc, cur, wr, wc, fr, fq); S.done(cur);
        if (!has_next) break;
#pragma unroll
        for (int b = 0; b < 2; ++b)
#pragma unroll
            for (int m = 0; m < 4; ++m)
#pragma unroll
                for (int n = 0; n < 2; ++n) acc[0][b][m][n] = (f32x4){0.f, 0.f, 0.f, 0.f};
        cur = nxt; cA = nA; cB = nB; ++ui;
        if (wr == 1) PG8_BAR;
    }
    PG8_WAIT_V(0);
    PG8_BAR;
#undef PG8_SA
#undef PG8_SB
#undef PG8_STAGE
#undef PG8_LDA
#undef PG8_LDB
#undef PG8_MMA
#undef PG8_WAIT_V
#undef PG8_WAIT_L
#undef PG8_BAR
#undef PG8_SCHED
}

__device__ __forceinline__ size_t skinny_koff(int k, size_t kstep) { return kstep == 128 ? (size_t)k * 2 : (size_t)(k >> 6) * kstep + (size_t)(k & 63) * 2; }
template <int NS>
__device__ __forceinline__ void skinny_steps(const char* Ab, const char* Bb, int k0, size_t kstepA, size_t kstepB, size_t a16, size_t b4, size_t b128, f32x4 (&acc)[2][2][2]) {
    bf16x8 a[NS][2], b[NS][2][2];
#pragma unroll
    for (int s = 0; s < NS; ++s) {
        const size_t ka = skinny_koff(k0 + 32 * s, kstepA), kb = skinny_koff(k0 + 32 * s, kstepB);
        a[s][0] = *(const bf16x8*)(Ab + ka); a[s][1] = *(const bf16x8*)(Ab + a16 + ka);
#pragma unroll
        for (int bj = 0; bj < 2; ++bj)
#pragma unroll
            for (int n = 0; n < 2; ++n) b[s][bj][n] = *(const bf16x8*)(Bb + bj * b128 + n * b4 + kb);
    }
#pragma unroll
    for (int s = 0; s < NS; ++s)
#pragma unroll
        for (int bj = 0; bj < 2; ++bj)
#pragma unroll
            for (int m = 0; m < 2; ++m)
#pragma unroll
                for (int n = 0; n < 2; ++n) acc[bj][m][n] = __builtin_amdgcn_mfma_f32_16x16x32_bf16(b[s][bj][n], a[s][m], acc[bj][m][n], 0, 0, 0);
}
template <class Epi>
__device__ __forceinline__ void skinny_phase(PG8_LAS unsigned char* lds, const Gemm g, const Epi& E, int first, int step, const int wv) {
    int tid = wv * 64 + (int)__builtin_amdgcn_mbcnt_hi(~0u, __builtin_amdgcn_mbcnt_lo(~0u, 0u)); asm volatile("" : "+v"(tid));
    const int wid = wv, lane = tid & 63, fr = lane & 15, fq = lane >> 4;
    const int nit = (g.N / BM) * 4, Kw = g.K / 8;
    PG8_LAS f32x4* R = (PG8_LAS f32x4*)lds;
    for (int it = first; it < nit; it += step) {
        const int pn = it >> 2, wc = it & 3;
        const int kw0 = wid * Kw;
        const char* Ab = (const char*)g.A + (size_t)(pn >> g.gshift) * g.gstride + ((size_t)(MP + fr) * g.lda + fq * 8) * 2;
        const char* Bb = (const char*)g.Bt + ((size_t)(pn * BM + 32 * wc + 8 * (fr >> 2) + (fr & 3)) * g.ldb + fq * 8) * 2;
        const size_t a16 = (size_t)16 * g.lda * 2, b4 = (size_t)4 * g.ldb * 2, b128 = (size_t)HALF * g.ldb * 2;
        f32x4 acc[2][2][2];
#pragma unroll
        for (int bj = 0; bj < 2; ++bj)
#pragma unroll
            for (int m = 0; m < 2; ++m)
#pragma unroll
                for (int n = 0; n < 2; ++n) acc[bj][m][n] = (f32x4){0.f, 0.f, 0.f, 0.f};
        int k = 0;
        for (; k + 128 <= Kw; k += 128) skinny_steps<4>(Ab, Bb, kw0 + k, g.kstepA, g.kstepB, a16, b4, b128, acc);
        for (; k + 64 <= Kw; k += 64) skinny_steps<2>(Ab, Bb, kw0 + k, g.kstepA, g.kstepB, a16, b4, b128, acc);
        for (; k < Kw; k += 32) skinny_steps<1>(Ab, Bb, kw0 + k, g.kstepA, g.kstepB, a16, b4, b128, acc);
#pragma unroll
        for (int bj = 0; bj < 2; ++bj)
#pragma unroll
            for (int m = 0; m < 2; ++m)
#pragma unroll
                for (int n = 0; n < 2; ++n) R[(wid * 8 + bj * 4 + m * 2 + n) * 64 + lane] = acc[bj][m][n];
        __syncthreads();
        if (wid == 0) {
            f32x4 accF[2][2][4][2];
#pragma unroll
            for (int ai = 0; ai < 2; ++ai)
#pragma unroll
                for (int bj = 0; bj < 2; ++bj)
#pragma unroll
                    for (int m = 0; m < 4; ++m)
#pragma unroll
                        for (int n = 0; n < 2; ++n) accF[ai][bj][m][n] = (f32x4){0.f, 0.f, 0.f, 0.f};
            f32x4 s8[8];
#pragma unroll
            for (int i = 0; i < 8; ++i) s8[i] = R[i * 64 + lane];
#pragma unroll 1
            for (int w = 1; w < 8; ++w) {
#pragma unroll
                for (int i = 0; i < 8; ++i) s8[i] += R[(w * 8 + i) * 64 + lane];
            }
#pragma unroll
            for (int bj = 0; bj < 2; ++bj)
#pragma unroll
                for (int m = 0; m < 2; ++m)
#pragma unroll
                    for (int n = 0; n < 2; ++n) accF[0][bj][m][n] = s8[bj * 4 + m * 2 + n];
            const Unit u{MP / BM, pn};
            E.template run<true>(accF, u, 0, wc, fr, fq);
        }
        __syncthreads();
    }
}

template <int NS>
__device__ __forceinline__ void narrow_steps(const char* Ab, const char* Bb, int k0, size_t kstepA, size_t kstepB, size_t a16, f32x4 (&acc)[2]) {
    bf16x8 a[NS][2], b[NS];
#pragma unroll
    for (int s = 0; s < NS; ++s) {
        const size_t ka = skinny_koff(k0 + 32 * s, kstepA), kb = skinny_koff(k0 + 32 * s, kstepB);
        a[s][0] = *(const bf16x8*)(Ab + ka); a[s][1] = *(const bf16x8*)(Ab + a16 + ka); b[s] = *(const bf16x8*)(Bb + kb);
    }
#pragma unroll
    for (int s = 0; s < NS; ++s)
#pragma unroll
        for (int m = 0; m < 2; ++m) acc[m] = __builtin_amdgcn_mfma_f32_16x16x32_bf16(b[s], a[s][m], acc[m], 0, 0, 0);
}
template <class Epi>
__device__ __forceinline__ void skinny_phase_narrow(PG8_LAS unsigned char* lds, const Gemm g, const Epi& E, int first, int step, const int wv) {
    int tid = wv * 64 + (int)__builtin_amdgcn_mbcnt_hi(~0u, __builtin_amdgcn_mbcnt_lo(~0u, 0u)); asm volatile("" : "+v"(tid));
    const int wid = wv, lane = tid & 63, fr = lane & 15, fq = lane >> 4;
    const int nit = (g.N / BM) * 16, Kw = g.K / 8;
    PG8_LAS f32x4* R = (PG8_LAS f32x4*)lds;
    for (int it = first; it < nit; it += step) {
        const int pn = it >> 4, wc = (it >> 2) & 3, bj = (it >> 1) & 1, n = it & 1;
        const int kw0 = wid * Kw;
        const char* Ab = (const char*)g.A + (size_t)(pn >> g.gshift) * g.gstride + ((size_t)(MP + fr) * g.lda + fq * 8) * 2;
        const char* Bb = (const char*)g.Bt + ((size_t)(pn * BM + bj * HALF + 32 * wc + 8 * (fr >> 2) + 4 * n + (fr & 3)) * g.ldb + fq * 8) * 2;
        const size_t a16 = (size_t)16 * g.lda * 2;
        f32x4 acc[2] = {(f32x4){0.f, 0.f, 0.f, 0.f}, (f32x4){0.f, 0.f, 0.f, 0.f}};
        int k = 0;
        for (; k + 256 <= Kw; k += 256) narrow_steps<8>(Ab, Bb, kw0 + k, g.kstepA, g.kstepB, a16, acc);
        for (; k + 128 <= Kw; k += 128) narrow_steps<4>(Ab, Bb, kw0 + k, g.kstepA, g.kstepB, a16, acc);
        for (; k + 64 <= Kw; k += 64) narrow_steps<2>(Ab, Bb, kw0 + k, g.kstepA, g.kstepB, a16, acc);
        for (; k < Kw; k += 32) narrow_steps<1>(Ab, Bb, kw0 + k, g.kstepA, g.kstepB, a16, acc);
        R[(wid * 2 + 0) * 64 + lane] = acc[0]; R[(wid * 2 + 1) * 64 + lane] = acc[1];
        __syncthreads();
        if (wid == 0) {
            f32x4 v[2] = {R[lane], R[64 + lane]};
#pragma unroll
            for (int w = 1; w < 8; ++w) { v[0] += R[(w * 2 + 0) * 64 + lane]; v[1] += R[(w * 2 + 1) * 64 + lane]; }
            E.run_narrow(v, pn, wc, bj, n, fr, fq);
        }
        __syncthreads();
    }
}
}
#define GAS __attribute__((address_space(1)))
#define LAS __attribute__((address_space(3)))
typedef unsigned short bf16;
typedef unsigned v4u __attribute__((ext_vector_type(4)));
typedef float f32x4 __attribute__((ext_vector_type(4)));
typedef short bf16x8 __attribute__((ext_vector_type(8)));
typedef GAS unsigned gu32;
typedef GAS unsigned long long gu64;
#define RLX_AGENT __ATOMIC_RELAXED, __HIP_MEMORY_SCOPE_AGENT
#define LDS_WAIT() asm volatile("s_waitcnt lgkmcnt(0)" ::: "memory")
#define VM_WAIT() asm volatile("s_waitcnt vmcnt(0)" ::: "memory")
__device__ __forceinline__ unsigned long long rt() { return __builtin_amdgcn_s_memrealtime(); }
__device__ __forceinline__ int lane_id() { return (int)__builtin_amdgcn_mbcnt_hi(~0u, __builtin_amdgcn_mbcnt_lo(~0u, 0u)); }
__device__ __forceinline__ unsigned f2bf(float f) { unsigned u = __builtin_bit_cast(unsigned, f); return (u + 0x7fffu + ((u >> 16) & 1u)) >> 16; }
__device__ __forceinline__ unsigned pk2(float lo, float hi) { return f2bf(lo) | (f2bf(hi) << 16); }

#define XB_TMO      128
#define XB_XCNT(j)  (256  + 64 * (j))
#define XB_XSUB(j)  (1280 + 64 * (j))
#define XB_XGEN(j)  (2304 + 64 * (j))
#define XB_TOP      3328
#define XB_TOPGEN   3392
#define XCD_BAR_WORDS 3456
#define XB_SPIN_CAP (1u << 18)

__device__ __forceinline__ unsigned xb_ld(unsigned* p)              { return __hip_atomic_load(p, __ATOMIC_RELAXED, __HIP_MEMORY_SCOPE_AGENT); }
__device__ __forceinline__ unsigned xb_add(unsigned* p, unsigned v) { return __hip_atomic_fetch_add(p, v, __ATOMIC_RELAXED, __HIP_MEMORY_SCOPE_AGENT); }
__device__ __forceinline__ unsigned xb_xcc_id() { return (unsigned)__builtin_amdgcn_s_getreg((3 << 11) | 20) & 0xFu; }
#define XB_SPIN(cond, bar) do { unsigned _sp = 0; while (cond) { __builtin_amdgcn_s_sleep(1); \
    if ((++_sp & 255u) == 0u) { if (xb_ld(&(bar)[XB_TMO])) break; if (_sp > XB_SPIN_CAP) { atomicAdd(&(bar)[XB_TMO], 1u); break; } } } } while (0)

struct XcdBarrier {
    unsigned* bar; unsigned x; int wv;
    volatile LAS unsigned* st;
};

__device__ __forceinline__ XcdBarrier xcd_barrier_post(unsigned* bar, volatile LAS unsigned* st, int wv) {
    XcdBarrier b; b.bar = bar; b.x = xb_xcc_id(); b.st = st; b.wv = wv;
    if (wv == 0 && lane_id() == 0) (void)xb_add(&bar[XB_XCNT(b.x)], 1u);
    return b;
}
__device__ __forceinline__ void xcd_barrier_complete(unsigned* bar, unsigned x, unsigned& nloc, unsigned& nx) {
    const unsigned G = gridDim.x * gridDim.y * gridDim.z;
    unsigned sum, cnt, mine, sp = 0u;
    for (;;) {
        sum = 0u; cnt = 0u; mine = 0u;
#pragma unroll
        for (unsigned j = 0; j < 16; ++j) { const unsigned c = xb_ld(&bar[XB_XCNT(j)]); sum += c; cnt += (c > 0u) ? 1u : 0u; mine = (j == x) ? c : mine; }
        if (sum == G) break;
        __builtin_amdgcn_s_sleep(1);
        if ((++sp & 255u) == 0u) { if (xb_ld(&bar[XB_TMO])) break; if (sp > XB_SPIN_CAP) { atomicAdd(&bar[XB_TMO], 1u); break; } }
    }
    nloc = mine > 0u ? mine : 1u; nx = cnt > 0u ? cnt : 1u;
}

__device__ __forceinline__ void xcd_barrier(const XcdBarrier& b) {
    asm volatile("s_waitcnt vmcnt(0)" ::: "memory");
    __syncthreads();
    if (b.wv == 0 && lane_id() == 0) {
        unsigned* bar = b.bar;
        __builtin_amdgcn_s_waitcnt(0);
        unsigned nloc = b.st[0], nx = b.st[1];
        if (nloc == 0u) { xcd_barrier_complete(bar, b.x, nloc, nx); b.st[0] = nloc; b.st[1] = nx; }
        const unsigned old = xb_add(&bar[XB_XSUB(b.x)], 1u);
        const unsigned gen = old / nloc;
        if (old + 1u == (gen + 1u) * nloc) {
            __builtin_amdgcn_fence(__ATOMIC_RELEASE, "agent");
            asm volatile("s_waitcnt vmcnt(0)" ::: "memory");
            const unsigned og = xb_add(&bar[XB_TOP], 1u);
            const unsigned tg = og / nx;
            if (og + 1u == (tg + 1u) * nx) xb_add(&bar[XB_TOPGEN], 1u);
            else XB_SPIN(xb_ld(&bar[XB_TOPGEN]) == tg, bar);
            __builtin_amdgcn_fence(__ATOMIC_ACQUIRE, "agent");
            xb_add(&bar[XB_XGEN(b.x)], 1u);
            asm volatile("s_waitcnt vmcnt(0)" ::: "memory");
        } else {
            XB_SPIN(xb_ld(&bar[XB_XGEN(b.x)]) == gen, bar);
            __builtin_amdgcn_fence(__ATOMIC_ACQUIRE, "agent");
            asm volatile("s_waitcnt vmcnt(0)" ::: "memory");
        }
    }
    __syncthreads();
}
constexpr size_t MiB = 1u << 20;
constexpr size_t WS_CTL = 0, CTL_ZERO_BYTES = 2 * MiB;
constexpr int CW_TMO = 0, CW_CODE = 1, CW_BAR = 1024;
constexpr size_t CTL_SS = 128 * 1024;
constexpr size_t CTL_KMP = 512 * 1024;
constexpr size_t CTL_SMP = 768 * 1024;
constexpr size_t CTL_CONVQ = 960 * 1024;
constexpr size_t CTL_FIN = 896 * 1024;
constexpr size_t WS_COS = 2 * MiB, WS_SIN = 4 * MiB;
constexpr size_t WS_WIN = 6 * MiB;
constexpr size_t WS_WO = WS_WIN + (size_t)INW * DM * 2;
constexpr size_t WS_WGU = WS_WO + (size_t)DM * DM * 2;
constexpr size_t WS_WDN = WS_WGU + (size_t)2 * 2 * FF * DM * 2;
constexpr size_t WS_WPL = WS_WDN + (size_t)2 * DM * FF * 2;
constexpr size_t WS_XB = WS_WPL + (size_t)DM * 512 * 2;
constexpr size_t WS_X = WS_XB + (size_t)MPAD * DM * 2;
constexpr size_t WS_Q = WS_X + (size_t)MPAD * DM * 4;
constexpr size_t WS_K = WS_Q + (size_t)MPAD * 1024 * 2, WS_V = WS_K + (size_t)MPAD * 1024 * 2, WS_G = WS_V + (size_t)MPAD * 1024 * 2, WS_U = WS_G + (size_t)MPAD * 1024 * 2;
constexpr size_t WS_ATT = WS_U + (size_t)MPAD * 1024 * 2;
constexpr size_t WS_H = WS_ATT + (size_t)MPAD * DM * 2;
constexpr size_t WS_D = WS_H + (size_t)MPAD * FF * 2;
constexpr size_t WS_KMS = WS_D + (size_t)MPAD * DM * 2;
constexpr size_t WS_END = WS_KMS + (size_t)DB * 64 * 1024 * 4;
static_assert(CTL_SS + 5 * MPAD * 8 <= CTL_KMP && CTL_KMP + 32 * 1024 * 4 <= CTL_SMP && (CW_BAR + 3 * 3456) * 4 <= (int)CTL_SS, "control region map");

constexpr int NWAVES = 8;
constexpr int RING_OFF = 0, RING_BYTES = 131072;
constexpr int LDSCTL_OFF = RING_BYTES, MISC_OFF = LDSCTL_OFF + 320;
constexpr int LDS_BYTES = 147456;
static_assert(MISC_OFF + 128 <= LDS_BYTES, "LDS map");
__device__ __forceinline__ float bf2f(unsigned short h) { return __uint_as_float(((unsigned)h) << 16); }
__device__ __forceinline__ float wave_sum(float v) {
#pragma unroll
    for (int o = 1; o < 64; o <<= 1) v += __shfl_xor(v, o);
    return v;
}
struct Args {
    const float* in[18]; float* out; unsigned char* ws;
    int ph_lo, ph_hi, li, pad;
};

__device__ __forceinline__ int inproj_src_col(int r) {
    const int pn = r >> 8, bj = (r >> 7) & 1, jj = r & 127;
    if (pn < 8) return (pn >> 2) * 1024 + (2 * (pn & 3) + (jj >> 6)) * 128 + 64 * bj + (jj & 63);
    if (pn < 16) return r;
    return 4096 + 1024 * bj + 128 * (pn - 16) + jj;
}
__device__ __forceinline__ int resid_src_col(int r) { const int rho = r & 255; return (r & ~255) + 64 * ((rho >> 5) & 3) + 32 * (rho >> 7) + (rho & 31); }
struct TItem { const float* W; const float* gain; const float* cscale; bf16* WT; int ldw, scol4, ldk, drow0, k0, kblk; };
__device__ __forceinline__ void titem_load(const TItem& t, int lane, f32x4 (&v)[8], float (&g)[8]) {
    const int kr = lane >> 3;
#pragma unroll
    for (int i = 0; i < 8; ++i) v[i] = __builtin_nontemporal_load((const GAS f32x4*)(t.W + (size_t)(t.k0 + 8 * i + kr) * t.ldw + t.scol4));
#pragma unroll
    for (int i = 0; i < 8; ++i) g[i] = t.gain ? t.gain[t.k0 + 8 * i + kr] : 1.0f;
}
__device__ __forceinline__ void titem_store(const TItem& t, int lane, const f32x4 (&v)[8], const float (&g)[8], LAS float* scr) {
    const int kr = lane >> 3, n4 = lane & 7;
#pragma unroll
    for (int i = 0; i < 8; ++i) { LAS float* d = scr + (8 * i + kr) * 33 + 4 * n4; d[0] = v[i].x * g[i]; d[1] = v[i].y * g[i]; d[2] = v[i].z * g[i]; d[3] = v[i].w * g[i]; }
    LDS_WAIT(); asm volatile("" ::: "memory");
    const int c = lane & 7;
#pragma unroll
    for (int j = 0; j < 4; ++j) { const int n = (lane >> 3) + 8 * j; const LAS float* s = scr + (8 * c) * 33 + n; const float cs = t.cscale ? t.cscale[resid_src_col(t.drow0 + n)] : 1.0f;
        v4u o; o.x = pk2(s[0 * 33] * cs, s[1 * 33] * cs); o.y = pk2(s[2 * 33] * cs, s[3 * 33] * cs); o.z = pk2(s[4 * 33] * cs, s[5 * 33] * cs); o.w = pk2(s[6 * 33] * cs, s[7 * 33] * cs);
        bf16* d = t.kblk ? t.WT + ((size_t)(t.k0 >> 6) * t.kblk + t.drow0 + n) * 64 + 8 * c : t.WT + (size_t)(t.drow0 + n) * t.ldk + t.k0 + 8 * c;
        *(GAS v4u*)d = o; }
    LDS_WAIT(); asm volatile("" ::: "memory");
}

__device__ __forceinline__ TItem titem_decode(const Args& a, int set, int it, int lane) {
    unsigned char* ws = a.ws;
    constexpr int I_IN = (DM / 64) * (INW / 32), I_O = (DM / 64) * (DM / 32), I_GU = (DM / 64) * (2 * FF / 32), I_DN = (FF / 64) * (DM / 32);
    TItem t; int r = it; const int l = set == 0 ? 0 : 1; const int l4 = 4 * (lane & 7);
    if (set == 0) {
        if (r < I_IN) { const int nb = r % (INW / 32), kb = r / (INW / 32);
            t.W = a.in[10]; t.gain = a.in[7]; t.cscale = nullptr; t.WT = (bf16*)(ws + WS_WIN); t.ldw = INW; t.scol4 = inproj_src_col(nb * 32 + l4); t.ldk = DM; t.drow0 = nb * 32; t.k0 = kb * 64; t.kblk = 0; return t; }
        r -= I_IN;
        if (r < I_O) { const int nb = r % (DM / 32), kb = r / (DM / 32);
            t.W = a.in[12]; t.gain = nullptr; t.cscale = nullptr; t.WT = (bf16*)(ws + WS_WO); t.ldw = DM; t.scol4 = resid_src_col(nb * 32 + l4); t.ldk = DM; t.drow0 = nb * 32; t.k0 = kb * 64; t.kblk = 0; return t; }
        r -= I_O;
    }
    if (set == 2) r += I_GU;
    if (r < I_GU) { const int nb = r % (2 * FF / 32), kb = r / (2 * FF / 32);
        const int drow = nb * 32, pn = drow >> 8, bj = (drow >> 7) & 1, jj = drow & 127;
        t.W = (bj ? a.in[16] : a.in[15]) + (size_t)l * DM * FF; t.gain = a.in[8] + l * DM; t.cscale = nullptr; t.WT = (bf16*)(ws + WS_WGU) + (size_t)l * 2 * FF * DM;
        t.ldw = FF; t.scol4 = pn * 128 + jj + l4; t.ldk = DM; t.drow0 = drow; t.k0 = kb * 64; t.kblk = 0; return t; }
    r -= I_GU;
    if (r < I_DN) { const int nb = r % (DM / 32), kb = r / (DM / 32);
        t.W = a.in[17] + (size_t)l * FF * DM; t.gain = nullptr; t.cscale = nullptr; t.WT = (bf16*)(ws + WS_WDN) + (size_t)l * DM * FF; t.ldw = DM; t.scol4 = resid_src_col(nb * 32 + l4); t.ldk = FF; t.drow0 = nb * 32; t.k0 = kb * 64; t.kblk = DM; return t; }
    r -= I_DN;
    { const int g = r / 128; r -= g * 128; const int nb = r % 16, kb = r / 16;
        t.W = a.in[13] + (size_t)g * 512 * 512; t.gain = nullptr; t.cscale = a.in[14]; t.WT = (bf16*)(ws + WS_WPL); t.ldw = 512; t.scol4 = resid_src_col(g * 512 + nb * 32 + l4) - g * 512; t.ldk = 512; t.drow0 = g * 512 + nb * 32; t.k0 = kb * 64; t.kblk = 0; return t; }
}
__device__ __forceinline__ void convert_weights(const Args& a, LAS float* scr, int set, int gw, int NGW, int lane, int lo = 0, int hi = 1 << 30) {
    constexpr int I_IN = (DM / 64) * (INW / 32), I_O = (DM / 64) * (DM / 32), I_GU = (DM / 64) * (2 * FF / 32), I_DN = (FF / 64) * (DM / 32), I_PL = 4 * (512 / 64) * (512 / 32);
    int nitems = set == 0 ? I_IN + I_O + I_GU + I_DN + I_PL : (set == 1 ? I_GU : I_DN); if (hi < nitems) nitems = hi;
    constexpr int CVB = CONV_BATCH;
    for (int base = lo + gw; base < nitems; base += CVB * NGW) {
        TItem t[CVB]; f32x4 v[CVB][8]; float g[CVB][8];
#pragma unroll
        for (int j = 0; j < CVB; ++j) { const int it = base + j * NGW; if (it < nitems) { t[j] = titem_decode(a, set, it, lane); titem_load(t[j], lane, v[j], g[j]); } }
#pragma unroll
        for (int j = 0; j < CVB; ++j) { const int it = base + j * NGW; if (it < nitems) titem_store(t[j], lane, v[j], g[j], scr); }
    }
}
__device__ __forceinline__ void convert_weights_queue(const Args& a, LAS float* scr, int set, unsigned* ctr, int lane) {
    constexpr int I_GU = (DM / 64) * (2 * FF / 32), I_DN = (FF / 64) * (DM / 32);
    const int nitems = set == 1 ? I_GU : I_DN;
    for (;;) {
        unsigned b0 = 0; if (lane == 0) b0 = __hip_atomic_fetch_add(ctr, 4u, RLX_AGENT);
        const int base = (int)__builtin_amdgcn_readfirstlane(b0);
        if (base >= nitems) break;
        TItem t[4]; f32x4 v[4][8]; float g[4][8];
#pragma unroll
        for (int j = 0; j < 4; ++j) { const int it = base + j; if (it < nitems) { t[j] = titem_decode(a, set, it, lane); titem_load(t[j], lane, v[j], g[j]); } }
#pragma unroll
        for (int j = 0; j < 4; ++j) { const int it = base + j; if (it < nitems) titem_store(t[j], lane, v[j], g[j], scr); }
    }
}
__device__ __forceinline__ void p0_prologue(const Args& a, LAS unsigned char* lds, int vcu, int G, int wave, int lane) {
    unsigned char* ws = a.ws;
    LAS float* scr = (LAS float*)(lds + RING_OFF + wave * 16384);
    const int gw = vcu * NWAVES + wave, NGW = G * NWAVES;
    convert_weights(a, scr, 0, gw, NGW, lane);
    if (!CONV_IN_SLOTS) { convert_weights(a, scr, 1, gw, NGW, lane); convert_weights(a, scr, 2, gw, NGW, lane); }
    else convert_weights(a, scr, 1, gw, NGW, lane, 0, GU1_IN_P0);
    bf16* XB = (bf16*)(ws + WS_XB); unsigned long long* SS0 = (unsigned long long*)(ws + CTL_SS);
    {
        constexpr int NRW = (MV + 2047) / 2048 + 1;
        for (int m0 = gw; m0 < MV; m0 += NRW * NGW) {
            f32x4 v[NRW][8];
#pragma unroll
            for (int r = 0; r < NRW; ++r) { const int m = m0 + r * NGW;
                if (m < MV) { const float* xrow = m < MP ? a.in[0] + (size_t)m * DM : a.in[1] + (size_t)(m - MP) * DM;
                    const GAS f32x4* xr = (const GAS f32x4*)xrow + lane;
#pragma unroll
                    for (int j = 0; j < 8; ++j) v[r][j] = __builtin_nontemporal_load(xr + 64 * j); } }
#pragma unroll
            for (int r = 0; r < NRW; ++r) { const int m = m0 + r * NGW;
                if (m < MV) { float s = 0.f;
#pragma unroll
                    for (int j = 0; j < 8; ++j) s += (v[r][j].x * v[r][j].x + v[r][j].y * v[r][j].y) + (v[r][j].z * v[r][j].z + v[r][j].w * v[r][j].w);
                    s = wave_sum(s);
                    GAS unsigned long long* o8 = (GAS unsigned long long*)(XB + (size_t)m * DM) + lane;
#pragma unroll
                    for (int j = 0; j < 8; ++j) o8[64 * j] = (unsigned long long)pk2(v[r][j].x, v[r][j].y) | ((unsigned long long)pk2(v[r][j].z, v[r][j].w) << 32);
                    if (lane == 0) SS0[m] = (unsigned long long)(s * SS_SCALE + 0.5f); } }
        }
    }
    float* cosT = (float*)(ws + WS_COS); float* sinT = (float*)(ws + WS_SIN);
    for (int i = gw * 64 + lane; i < (SEQ + DS) * 64; i += NGW * 64) {
        const int p = i >> 6, ii = i & 63; const int pos = p < SEQ ? p : PAST + (p - SEQ);
        const float inv = powf(10000.f, -(float)ii / 64.f); const float ang = (float)pos * inv;
        cosT[i] = cosf(ang); sinT[i] = sinf(ang);
    }
}

__device__ __forceinline__ void unpack8(const v4u w, float (&f)[8]) {
#pragma unroll
    for (int e = 0; e < 4; ++e) { f[2 * e] = __uint_as_float(w[e] << 16); f[2 * e + 1] = __uint_as_float(w[e] & 0xffff0000u); }
}
__device__ __forceinline__ void conv_pass(const Args& a, int vcu, int G, int tid) {
    unsigned char* ws = a.ws;
    const bf16* Ub = (const bf16*)(ws + WS_U); const bf16* Gb = (const bf16*)(ws + WS_G); bf16* ATT = (bf16*)(ws + WS_ATT);
    const float* conv_w = a.in[11]; const float* state_conv = a.in[5];
    const int nthr = G * NWAVES * 64;
    for (int it = vcu * NWAVES * 64 + tid; it < (MV / 4) * 128; it += nthr) {
        const int r0 = (it >> 7) * 4, ch = (it & 127) * 8;
        const bool smp = r0 >= MP;
        const int t0 = smp ? 0 : r0 & (SEQ - 1), b = smp ? (r0 - MP) >> 2 : r0 >> 12;
        v4u up[6], gp[4];
#pragma unroll
        for (int j = 0; j < 4; ++j) { up[j + 2] = *(const GAS v4u*)(Ub + (size_t)(r0 + j) * 1024 + ch); gp[j] = *(const GAS v4u*)(Gb + (size_t)(r0 + j) * 1024 + ch); }
        float u[6][8];
        if (t0 >= 2) { up[0] = *(const GAS v4u*)(Ub + (size_t)(r0 - 2) * 1024 + ch); up[1] = *(const GAS v4u*)(Ub + (size_t)(r0 - 1) * 1024 + ch); unpack8(up[0], u[0]); unpack8(up[1], u[1]); }
        else if (smp) { const float* s0 = state_conv + ((size_t)b * 2) * CC + ch;
#pragma unroll
            for (int e = 0; e < 8; ++e) { u[0][e] = s0[e]; u[1][e] = s0[CC + e]; } }
        else {
#pragma unroll
            for (int e = 0; e < 8; ++e) { u[0][e] = 0.f; u[1][e] = 0.f; } }
#pragma unroll
        for (int j = 2; j < 6; ++j) unpack8(up[j], u[j]);
        float w0[8], w1[8], w2[8];
#pragma unroll
        for (int e = 0; e < 8; ++e) { w0[e] = conv_w[ch + e]; w1[e] = conv_w[CC + ch + e]; w2[e] = conv_w[2 * CC + ch + e]; }
#pragma unroll
        for (int j = 0; j < 4; ++j) {
            float gb[8], y[8]; unpack8(gp[j], gb);
#pragma unroll
            for (int e = 0; e < 8; ++e) y[e] = gb[e] * (w0[e] * u[j][e] + w1[e] * u[j + 1][e] + w2[e] * u[j + 2][e]);
            v4u o; o.x = pk2(y[0], y[1]); o.y = pk2(y[2], y[3]); o.z = pk2(y[4], y[5]); o.w = pk2(y[6], y[7]);
            *(GAS v4u*)(ATT + (size_t)(r0 + j) * DM + 1024 + ch) = o;
        }
    }
}

__device__ __forceinline__ f32x4 pool_h(const bf16* XBp, const unsigned long long* ss, int row, int c, const f32x4 g) {
    const float rstd = rsqrtf((float)ss[row] * (1.0f / (SS_SCALE * (float)DM)) + RMS_EPS);
    const unsigned long long w = *(const GAS unsigned long long*)(XBp + (size_t)row * DM + c);
    const f32x4 x = (f32x4){__uint_as_float((unsigned)w << 16), __uint_as_float((unsigned)w & 0xffff0000u), __uint_as_float((unsigned)(w >> 32) << 16), __uint_as_float((unsigned)(w >> 32) & 0xffff0000u)};
    return x * rstd * g;
}
__device__ __forceinline__ f32x4 pool_unpack(unsigned long long w) {
    return (f32x4){__uint_as_float((unsigned)w << 16), __uint_as_float((unsigned)w & 0xffff0000u), __uint_as_float((unsigned)(w >> 32) << 16), __uint_as_float((unsigned)(w >> 32) & 0xffff0000u)};
}
template <int W, int NRW>
__device__ __forceinline__ void pool_rows(const bf16* XBp, const unsigned long long* ss, bf16* Dd, float* o_pp, int r0, int t0, int bb, int c, const f32x4 g) {
    constexpr int NR = W - 1 + NRW;
    unsigned long long raw[NR]; float rs[NR];
#pragma unroll
    for (int i = 0; i < NR; ++i) { const int dr = i - (W - 1); const bool ok = t0 + dr >= 0;
        raw[i] = ok ? *(const GAS unsigned long long*)(XBp + (size_t)(r0 + dr) * DM + c) : 0ull;
        rs[i] = ok ? rsqrtf((float)ss[r0 + dr] * (1.0f / (SS_SCALE * (float)DM)) + RMS_EPS) : 0.f; }
    f32x4 S = (f32x4){0.f, 0.f, 0.f, 0.f};
#pragma unroll
    for (int i = 0; i < W - 1; ++i) S += pool_unpack(raw[i]) * rs[i] * g;
#pragma unroll
    for (int j = 0; j < NRW; ++j) {
        const int t = t0 + j; const f32x4 hv = pool_unpack(raw[W - 1 + j]) * rs[W - 1 + j] * g;
        S += hv;
        const float cnt = (float)((t + 1) < W ? (t + 1) : W);
        const f32x4 d = S * (1.0f / cnt) - hv;
        *(GAS unsigned long long*)(Dd + (size_t)(r0 + j) * DM + c) = (unsigned long long)pk2(d.x, d.y) | ((unsigned long long)pk2(d.z, d.w) << 32);
        S -= pool_unpack(raw[j]) * rs[j] * g;
        if (t >= SEQ - 15) *(GAS f32x4*)(o_pp + ((size_t)bb * 15 + (t - (SEQ - 15))) * DM + c) = hv;
    }
}
template <int W>
__device__ __forceinline__ void pool_sample(const bf16* XBp, const unsigned long long* ss, bf16* Dd, const float* hist, float* o_ps, int b, int c, const f32x4 g) {
    const int r0 = MP + b * DS;
    f32x4 hs[15]; unsigned long long raw[DS]; float rs[DS];
#pragma unroll
    for (int j = 0; j < 15; ++j) hs[j] = *(const f32x4*)(hist + (size_t)j * DM);
#pragma unroll
    for (int t = 0; t < DS; ++t) { raw[t] = *(const GAS unsigned long long*)(XBp + (size_t)(r0 + t) * DM + c); rs[t] = rsqrtf((float)ss[r0 + t] * (1.0f / (SS_SCALE * (float)DM)) + RMS_EPS); }
    f32x4 h[DS];
#pragma unroll
    for (int t = 0; t < DS; ++t) h[t] = pool_unpack(raw[t]) * rs[t] * g;
    f32x4 S = (f32x4){0.f, 0.f, 0.f, 0.f};
#pragma unroll
    for (int j = 1; j <= W - 1; ++j) S += hs[15 - j];
#pragma unroll
    for (int t = 0; t < DS; ++t) {
        S += h[t];
        const f32x4 d = S * (1.0f / (float)W) - h[t];
        *(GAS unsigned long long*)(Dd + (size_t)(r0 + t) * DM + c) = (unsigned long long)pk2(d.x, d.y) | ((unsigned long long)pk2(d.z, d.w) << 32);
        const int to = t - (W - 1);
        if (to >= 0) S -= h[to >= 0 ? to : 0]; else S -= hs[15 + to >= 0 ? 15 + to : 0];
        *(GAS f32x4*)(o_ps + ((size_t)b * 15 + 11 + t) * DM + c) = h[t];
    }
#pragma unroll
    for (int j = 0; j < 11; ++j) *(GAS f32x4*)(o_ps + ((size_t)b * 15 + j) * DM + c) = hs[j + 4];
}
__device__ __forceinline__ void pool_pass(const Args& a, int vcu, int G, int tid) {
    unsigned char* ws = a.ws;
    const bf16* X = (const bf16*)(ws + WS_XB); const unsigned long long* ss = (const unsigned long long*)(ws + CTL_SS) + 2 * MPAD;
    bf16* Dd = (bf16*)(ws + WS_D);
    const float* state_pool = a.in[6]; const float* gmix = a.in[7] + DM;
    float* o_pp = a.out + (size_t)MV * DM + 2 * (size_t)MP * 1024 + 2 * (size_t)MS * 1024 + (size_t)NB * 2 * CC + (size_t)DB * 2 * CC;
    float* o_ps = o_pp + (size_t)NB * 15 * DM;
    const int c = tid * 4, grp = __builtin_amdgcn_readfirstlane(c >> 9);
    const f32x4 g = *(const f32x4*)(gmix + c);
    if (vcu >= G - DB) { const int b = vcu - (G - DB); const float* hist = state_pool + (size_t)b * 15 * DM + c;
        if (grp == 0) pool_sample<2>(X, ss, Dd, hist, o_ps, b, c, g); else if (grp == 1) pool_sample<4>(X, ss, Dd, hist, o_ps, b, c, g);
        else if (grp == 2) pool_sample<8>(X, ss, Dd, hist, o_ps, b, c, g); else pool_sample<16>(X, ss, Dd, hist, o_ps, b, c, g); }
    for (int it = vcu; it < MP / 32; it += G) {
        const int r0 = it * 32, t0 = r0 & (SEQ - 1), bb = r0 >> 12;
#pragma unroll 1
        for (int q = 0; q < 2; ++q) {
            if (grp == 0) pool_rows<2, 16>(X, ss, Dd, o_pp, r0 + 16 * q, t0 + 16 * q, bb, c, g);
            else if (grp == 1) pool_rows<4, 16>(X, ss, Dd, o_pp, r0 + 16 * q, t0 + 16 * q, bb, c, g);
            else if (grp == 2) pool_rows<8, 16>(X, ss, Dd, o_pp, r0 + 16 * q, t0 + 16 * q, bb, c, g);
            else pool_rows<16, 16>(X, ss, Dd, o_pp, r0 + 16 * q, t0 + 16 * q, bb, c, g);
        }
    }
}

__device__ __forceinline__ void final_norm(const Args& a, int vcu, int G, int wave, int lane) {
    unsigned char* ws = a.ws;
    const bf16* X = (const bf16*)(ws + WS_XB); const unsigned long long* ss = (const unsigned long long*)(ws + CTL_SS) + 4 * MPAD;
    const float* gf = a.in[9];
    const int gw = vcu * NWAVES + wave, NGW = G * NWAVES;
    f32x4 g[8];
#pragma unroll
    for (int j = 0; j < 8; ++j) g[j] = *(const f32x4*)(gf + 4 * (lane + 64 * j));
    for (int m = gw; m < MV; m += NGW) {
        const float rstd = rsqrtf((float)ss[m] * (1.0f / (SS_SCALE * (float)DM)) + RMS_EPS);
        const GAS unsigned long long* xr = (const GAS unsigned long long*)(X + (size_t)m * DM) + lane;
        GAS f32x4* yr = (GAS f32x4*)(a.out + (size_t)m * DM) + lane;
        unsigned long long w[8];
#pragma unroll
        for (int j = 0; j < 8; ++j) w[j] = xr[64 * j];
#pragma unroll
        for (int j = 0; j < 8; ++j) { const f32x4 x = (f32x4){__uint_as_float((unsigned)w[j] << 16), __uint_as_float((unsigned)w[j] & 0xffff0000u), __uint_as_float((unsigned)(w[j] >> 32) << 16), __uint_as_float((unsigned)(w[j] >> 32) & 0xffff0000u)};
            yr[64 * j] = x * rstd * g[j]; }
    }
}

namespace mb {
constexpr int D = 128, QPITCH = 1024, KPITCH = 1024, OPITCH = 2048;
constexpr float THR = 8.f;
constexpr bool WSKIP = false;
constexpr float SCALE = 0.08838834764831845f;
constexpr int NW = 8, QBLK = 32, KVBLK = 64, QB = NW * QBLK;
constexpr int SHM_V = KVBLK * D * 2, SHM_K = KVBLK * D * 2;
constexpr int ATT_LDS_BYTES = 2 * SHM_V + 2 * SHM_K + NW * 64 * 4;

using bf16 = __hip_bfloat16;
typedef short bf16x8 __attribute__((ext_vector_type(8)));
typedef short s16x4 __attribute__((ext_vector_type(4)));
typedef float f32x16 __attribute__((ext_vector_type(16)));
typedef float f32x4 __attribute__((ext_vector_type(4)));
typedef unsigned u32x4 __attribute__((ext_vector_type(4)));
template <class A, class Bt> struct same_t { static constexpr bool v = false; };
template <class A> struct same_t<A, A> { static constexpr bool v = true; };

#define KSWZ(row, colB) ((row) * 256 + ((colB) ^ (((row) & 7) << 4)))
#define SBAR() __builtin_amdgcn_sched_barrier(0)
__device__ __forceinline__ int v_st(int k, int c) { const int kk = (k & ~0xC) | ((k & 4) << 1) | ((k & 8) >> 1); return ((kk >> 3) * 4 + (c >> 5)) * 512 + ((kk & 7) * 32 + (c & 31)) * 2; }
__device__ __forceinline__ int v_rd_base(int lane) { return ((lane & 3) << 3) | (((lane >> 2) & 3) << 6) | (((lane >> 4) & 1) << 5) | (((lane >> 5) & 1) << 8); }
constexpr int v_rd_off(int d0, int ks, int half) { return d0 * 512 + ks * 4096 + half * 2048; }
__device__ __forceinline__ int crow(int r, int hi) { return (r & 3) + 8 * (r >> 2) + 4 * hi; }
__device__ __forceinline__ unsigned cvtpk(float lo, float hi) {
    unsigned r; asm volatile("v_cvt_pk_bf16_f32 %0, %1, %2" : "=v"(r) : "v"(lo), "v"(hi)); return r;
}
__device__ __forceinline__ bf16x8 pack8(f32x4 a, f32x4 b) {
    u32x4 w = {cvtpk(a[0], a[1]), cvtpk(a[2], a[3]), cvtpk(b[0], b[1]), cvtpk(b[2], b[3])};
    return *reinterpret_cast<bf16x8*>(&w);
}
template <class T> __device__ __forceinline__ bf16x8 load8(const T* p) {
    if constexpr (same_t<T, float>::v) { return pack8(*(const f32x4*)p, *(const f32x4*)(p + 4)); }
    else { return *reinterpret_cast<const bf16x8*>(p); }
}
__device__ __forceinline__ void mask_tile(f32x16& p0, f32x16& p1, int dq, unsigned W) {
    const float NEG = -__builtin_inff();
#pragma unroll
    for (int r = 0; r < 16; ++r) {
        const int c = (r & 3) + 8 * (r >> 2);
        if ((unsigned)(dq - c) >= W) p0[r] = NEG;
        if ((unsigned)(dq - c - 32) >= W) p1[r] = NEG;
    }
}
__device__ __forceinline__ void partialSM(f32x16& p0, f32x16& p1, float& m_reg, float& mn, float& alpha, const bool rowoff) {
    float pmax = p0[0]; for (int r = 1; r < 16; ++r) pmax = fmaxf(pmax, p0[r]); for (int r = 0; r < 16; ++r) pmax = fmaxf(pmax, p1[r]);
    { auto rr = __builtin_amdgcn_permlane32_swap(__float_as_uint(pmax), __float_as_uint(pmax), false, false);
      pmax = fmaxf(__uint_as_float(rr[0]), __uint_as_float(rr[1])); }
    if (rowoff) pmax = -__builtin_inff();
    constexpr float C2 = 1.4426950408889634f * SCALE;
    if (__builtin_expect(__all((pmax - m_reg) * SCALE <= THR), 1)) { mn = m_reg; alpha = 1.f; }
    else { mn = fmaxf(m_reg, pmax); alpha = __builtin_amdgcn_exp2f((m_reg - mn) * C2); m_reg = mn; }
    const float mnL = rowoff ? -__builtin_inff() : -mn * C2;
    for (int r = 0; r < 16; ++r) p0[r] = fmaf(p0[r], C2, mnL); for (int r = 0; r < 16; ++r) p1[r] = fmaf(p1[r], C2, mnL);
    for (int r = 0; r < 16; ++r) p0[r] = __builtin_amdgcn_exp2f(p0[r]);
}
__device__ __forceinline__ void finishSM(f32x16& p0, f32x16& p1, float alpha, float& l_reg, bf16x8& pa0, bf16x8& pa1, bf16x8& pa2, bf16x8& pa3) {
    for (int r = 0; r < 16; ++r) p1[r] = __builtin_amdgcn_exp2f(p1[r]);
    float ps = 0; for (int r = 0; r < 16; ++r) ps += p0[r]; for (int r = 0; r < 16; ++r) ps += p1[r];
    { auto rr = __builtin_amdgcn_permlane32_swap(__float_as_uint(ps), __float_as_uint(ps), false, false);
      ps = __uint_as_float(rr[0]) + __uint_as_float(rr[1]); }
    l_reg = l_reg * alpha + ps;
#define PK4(P, B_, OUT) do { unsigned a0 = cvtpk(P[B_+0], P[B_+1]), a1 = cvtpk(P[B_+2], P[B_+3]);                          \
        unsigned b0 = cvtpk(P[B_+4], P[B_+5]), b1 = cvtpk(P[B_+6], P[B_+7]);                                             \
        auto r0 = __builtin_amdgcn_permlane32_swap(a0, b0, false, false); auto r1 = __builtin_amdgcn_permlane32_swap(a1, b1, false, false); \
        u32x4 w = {r0[0], r1[0], r0[1], r1[1]}; OUT = *reinterpret_cast<bf16x8*>(&w); } while (0)
    PK4(p0, 0, pa0); PK4(p0, 8, pa1); PK4(p1, 0, pa2); PK4(p1, 8, pa3);
#undef PK4
}
template <int KB, bool SK>
__device__ __forceinline__ void qkt(f32x16& p0, f32x16& p1, const char* K_lds, int r32, int hi, const bf16x8* qr, bool act) {
    if (SK && !act) { const float NEG = -__builtin_inff();
#pragma unroll
        for (int r = 0; r < 16; ++r) { p0[r] = NEG; p1[r] = NEG; } return; }
    p0 = f32x16{}; p1 = f32x16{};
    const char* kb[4];
#pragma unroll
    for (int dd = 0; dd < 4; ++dd) kb[dd] = K_lds + KB * SHM_K + KSWZ(r32, (dd * 16 + hi * 8) * 2);
#pragma unroll
    for (int d0 = 0; d0 < 8; ++d0) { const char* a = kb[d0 & 3] + (d0 >> 2) * 128;
        bf16x8 b0 = *reinterpret_cast<const bf16x8*>(a);
        bf16x8 b1 = *reinterpret_cast<const bf16x8*>(a + 32 * 256);
        p0 = __builtin_amdgcn_mfma_f32_32x32x16_bf16(b0, qr[d0], p0, 0, 0, 0);
        p1 = __builtin_amdgcn_mfma_f32_32x32x16_bf16(b1, qr[d0], p1, 0, 0, 0); }
}
template <int VB, bool SK>
__device__ __forceinline__ void pv_tile(f32x16* o, int vb0, bf16x8 pa0, bf16x8 pa1, bf16x8 pa2, bf16x8 pa3, bool act) {
    if (SK && !act) return;
#define TRRD(dst, off) asm volatile("ds_read_b64_tr_b16 %0, %1 offset:%2" : "=&v"(dst) : "v"(vb0), "i"(off) : "memory")
#define PV_D0(d0) do { s16x4 l0, l1, l2, l3, h0, h1, h2, h3; constexpr int b_ = VB * SHM_V + v_rd_off(d0, 0, 0);     \
        TRRD(l0, b_); TRRD(h0, b_ + 2048); TRRD(l1, b_ + 4096); TRRD(h1, b_ + 6144); TRRD(l2, b_ + 8192); TRRD(h2, b_ + 10240); TRRD(l3, b_ + 12288); TRRD(h3, b_ + 14336); \
        asm volatile("s_waitcnt lgkmcnt(0)" ::: "memory"); SBAR();                 \
        o[d0] = __builtin_amdgcn_mfma_f32_32x32x16_bf16(pa0, (bf16x8){l0[0], l0[1], l0[2], l0[3], h0[0], h0[1], h0[2], h0[3]}, o[d0], 0, 0, 0);   \
        o[d0] = __builtin_amdgcn_mfma_f32_32x32x16_bf16(pa1, (bf16x8){l1[0], l1[1], l1[2], l1[3], h1[0], h1[1], h1[2], h1[3]}, o[d0], 0, 0, 0);   \
        o[d0] = __builtin_amdgcn_mfma_f32_32x32x16_bf16(pa2, (bf16x8){l2[0], l2[1], l2[2], l2[3], h2[0], h2[1], h2[2], h2[3]}, o[d0], 0, 0, 0);   \
        o[d0] = __builtin_amdgcn_mfma_f32_32x32x16_bf16(pa3, (bf16x8){l3[0], l3[1], l3[2], l3[3], h3[0], h3[1], h3[2], h3[3]}, o[d0], 0, 0, 0); } while (0)
    PV_D0(0); PV_D0(1); PV_D0(2); PV_D0(3);
#undef PV_D0
#undef TRRD
}

template <class TIn, class TOut> struct BlockRef { const TIn* Q; const TIn* K; const TIn* V; TOut* O; int P0; };
template <class TIn> struct Seam {
    bf16x8 qr[8];
    bf16x8 st_v0, st_v1, st_k0, st_k1; f32x4 sf0, sf1, sf2, sf3;
    f32x4 tq[16];
};
__device__ __forceinline__ int swa_jlo(int P0, int W) { const int lowk = P0 - W + 1; return lowk > 0 ? lowk / KVBLK : 0; }
#define ROW(p, k0, rr) ((p) + (size_t)((k0) + (rr)) * KPITCH + sc)
#define VMW() asm volatile("s_waitcnt vmcnt(0)" ::: "memory")
#define VMWN(n) asm volatile("s_waitcnt vmcnt(%0)" :: "i"(n) : "memory")
#define SLOAD_H(Kp, Vp, k0) do { S.st_v0 = load8<TIn>(ROW(Vp, k0, sr)); S.st_v1 = load8<TIn>(ROW(Vp, k0, 32 + sr));              \
                         S.st_k0 = load8<TIn>(ROW(Kp, k0, sr)); S.st_k1 = load8<TIn>(ROW(Kp, k0, 32 + sr)); } while (0)
#define SWRITE_HK(bf) do { *(bf16x8*)(K_lds + (bf) * SHM_K + kws) = S.st_k0; *(bf16x8*)(K_lds + (bf) * SHM_K + kws + 32 * 256) = S.st_k1; } while (0)
#define SWRITE_HV(bf) do { *(bf16x8*)(V_lds + (bf) * SHM_V + vst0) = S.st_v0; *(bf16x8*)(V_lds + (bf) * SHM_V + vst1) = S.st_v1; } while (0)
#define SWRITE_H(bf) do { SWRITE_HV(bf); SWRITE_HK(bf); } while (0)
#define SLOAD_F(p, k0) do { S.sf0 = *(const f32x4*)ROW(p, k0, sr); S.sf1 = *(const f32x4*)(ROW(p, k0, sr) + 4);                \
                            S.sf2 = *(const f32x4*)ROW(p, k0, 32 + sr); S.sf3 = *(const f32x4*)(ROW(p, k0, 32 + sr) + 4); } while (0)
#define SWRITE_KF(bf) do { *(bf16x8*)(K_lds + (bf) * SHM_K + kws) = pack8(S.sf0, S.sf1); *(bf16x8*)(K_lds + (bf) * SHM_K + kws + 32 * 256) = pack8(S.sf2, S.sf3); } while (0)
#define SWRITE_VF(bf) do { *(bf16x8*)(V_lds + (bf) * SHM_V + vst0) = pack8(S.sf0, S.sf1); *(bf16x8*)(V_lds + (bf) * SHM_V + vst1) = pack8(S.sf2, S.sf3); } while (0)
template <class TIn, class TOut>
__device__ __forceinline__ void causal_swa_prime(const BlockRef<TIn, TOut>& cur, int W, char* lds, Seam<TIn>& S, const int wv) {
    constexpr bool F32 = same_t<TIn, float>::v;
    const int tid = wv * 64 + (int)__builtin_amdgcn_mbcnt_hi(~0u, __builtin_amdgcn_mbcnt_lo(~0u, 0u)), wid = wv, lane = tid & 63, r32 = lane & 31, hi = lane >> 5;
    const int sr = tid >> 4, sc = (tid & 15) * 8, kws = KSWZ(sr, sc * 2); char* K_lds = lds + 2 * SHM_V;
    const int kb0 = swa_jlo(cur.P0, W) * KVBLK;
    for (int d0 = 0; d0 < 8; ++d0) S.qr[d0] = load8<TIn>(cur.Q + (size_t)(wid * QBLK + r32) * QPITCH + d0 * 16 + hi * 8);
    if constexpr (F32) { SLOAD_F((const float*)cur.K, kb0); VMW(); SWRITE_KF(0); SBAR(); SLOAD_F((const float*)cur.V, kb0); }
    else { SLOAD_H(cur.K, cur.V, kb0); VMW(); SWRITE_HK(0); }
    __syncthreads();
}
template <class TIn, class TOut>
__device__ __forceinline__ void causal_swa_block(const BlockRef<TIn, TOut>& cur, const BlockRef<TIn, TOut>& nxt, int skv, int W, char* lds, Seam<TIn>& S, const unsigned selmask, const int wv) {
    constexpr bool F32 = same_t<TIn, float>::v;
    int tid = wv * 64 + (int)__builtin_amdgcn_mbcnt_hi(~0u, __builtin_amdgcn_mbcnt_lo(~0u, 0u)); asm volatile("" : "+v"(tid));
    const int wid = wv, lane = tid & 63, r32 = lane & 31, hi = lane >> 5;
    const int j_lo = swa_jlo(cur.P0, W);
    int j_hi = (cur.P0 + QB - 1) / KVBLK + 1; if (j_hi > skv / KVBLK) j_hi = skv / KVBLK;
    const int NT = j_hi - j_lo;
    const int kbn = swa_jlo(nxt.P0, W) * KVBLK;
    const int own = cur.P0 >> 8;
    const int qlo = cur.P0 + wid * QBLK, qm = qlo + r32 - 4 * hi;
    char* V_lds = lds; char* K_lds = lds + 2 * SHM_V;
    float* ws = (float*)(lds + 2 * SHM_V + 2 * SHM_K) + wid * 64; float* li_l = ws, * al_l = ws + 32;
    float m_reg = -1e30f, l_reg = 0; f32x16 o[4] = {};
    const int sr = tid >> 4, sc = (tid & 15) * 8, vst0 = v_st(sr, sc), vst1 = v_st(32 + sr, sc), kws = KSWZ(sr, sc * 2);
    const int vb0 = (int)(uintptr_t)V_lds + v_rd_base(lane);
    const TIn* Kh = cur.K; const TIn* Vh = cur.V;
#define RESC(a) do { if (__any((a) < 1.f)) { if (hi == 0) al_l[r32] = (a); asm volatile("s_waitcnt lgkmcnt(0)" ::: "memory");              \
                     for (int d_ = 0; d_ < 4; ++d_) for (int r = 0; r < 16; ++r) o[d_][r] *= al_l[crow(r, hi)]; } } while (0)
#define KBASE(t) ((j_lo + (t)) * KVBLK)
#define ACT(t) (KBASE(t) <= qlo + QBLK - 1 && KBASE(t) + KVBLK - 1 >= qlo - W + 1)
#define MASKT(P0_, P1_, t) do { const int kb_ = KBASE(t); if ((kb_ >> 8) == own && kb_ + KVBLK - 1 > qlo) mask_tile(P0_, P1_, qm - kb_, 0x40000000u); } while (0)
#define ROWOFF(t) (own > 3 && (KBASE(t) >> 8) != own && ((selmask >> (KBASE(t) >> 8)) & 1u) == 0u)
    constexpr int NQL = F32 ? 16 : 8;
    constexpr bool SK = WSKIP && !F32;
#define SEAM_K0() do { VMWN(NQL); if constexpr (F32) { SWRITE_KF(0); SBAR(); SLOAD_F((const float*)nxt.V, kbn); } else { SWRITE_HK(0); } SBAR(); } while (0)
    f32x16 pA0, pA1, pB0, pB1; float mnA, mnB, alA, alB; bf16x8 pa0, pa1, pa2, pa3;
    if constexpr (F32) { VMW(); SWRITE_VF(0); SBAR(); } else { SWRITE_HV(0); SBAR(); }
    if (NT > 1) { if constexpr (F32) SLOAD_F((const float*)Kh, KBASE(1)); else SLOAD_H(Kh, Vh, KBASE(1)); }
    SBAR(); qkt<0, SK>(pA0, pA1, K_lds, r32, hi, S.qr, ACT(0));
    if constexpr (F32) { if (NT > 1) { VMW(); SWRITE_KF(1); SBAR(); SLOAD_F((const float*)Vh, KBASE(1)); } }
    MASKT(pA0, pA1, 0); partialSM(pA0, pA1, m_reg, mnA, alA, ROWOFF(0));
    if (NT > 1) { VMW(); if constexpr (F32) { SWRITE_VF(1); SBAR(); if (NT > 2) SLOAD_F((const float*)Kh, KBASE(2)); } else SWRITE_H(1); }
    __syncthreads();
#define HALF_STEP(PX0, PX1, mnX, alX, PY0, PY1, alY, t, KB, VB, SB) do {                                                      \
        SBAR(); qkt<KB, SK>(PX0, PX1, K_lds, r32, hi, S.qr, ACT(t));                                             \
        finishSM(PY0, PY1, alY, l_reg, pa0, pa1, pa2, pa3); SBAR();                                                           \
        if ((t) + 1 < NT) { if constexpr (F32) { VMW(); SWRITE_KF(SB); SBAR(); SLOAD_F((const float*)Vh, KBASE((t) + 1)); }  \
                            else { SLOAD_H(Kh, Vh, KBASE((t) + 1)); } SBAR(); }                                               \
        pv_tile<VB, SK>(o, vb0, pa0, pa1, pa2, pa3, ACT((t) - 1)); MASKT(PX0, PX1, (t)); partialSM(PX0, PX1, m_reg, mnX, alX, ROWOFF(t));                                        \
        __syncthreads();                                                                                                      \
        if ((t) + 1 < NT) { VMW(); if constexpr (F32) { SWRITE_VF(SB); SBAR(); if ((t) + 2 < NT) SLOAD_F((const float*)Kh, KBASE((t) + 2)); } \
                            else { SWRITE_H(SB); } }                                                                          \
        RESC(alX); __syncthreads(); } while (0)
    for (int t = 1; t + 1 < NT; t += 2) {
        HALF_STEP(pB0, pB1, mnB, alB, pA0, pA1, alA, t, 1, 0, 0);
        HALF_STEP(pA0, pA1, mnA, alA, pB0, pB1, alB, t + 1, 0, 1, 1);
    }
    const bool even = (NT & 1) == 0;
    if (even) { SBAR(); qkt<1, SK>(pB0, pB1, K_lds, r32, hi, S.qr, ACT(NT - 1)); SBAR(); }
#define QROW(e) (nxt.Q + (size_t)(wid * QBLK + r32) * QPITCH + ((e) >> 1) * 16 + hi * 8 + ((e) & 1) * 4)
    if constexpr (F32) { SLOAD_F((const float*)nxt.K, kbn); SBAR();
#pragma unroll
        for (int e = 0; e < 8; ++e) S.tq[e] = *(const f32x4*)QROW(e); }
    else { SLOAD_H(nxt.K, nxt.V, kbn); SBAR();
#pragma unroll
        for (int d0 = 0; d0 < 8; ++d0) S.qr[d0] = load8<TIn>(nxt.Q + (size_t)(wid * QBLK + r32) * QPITCH + d0 * 16 + hi * 8); }
    SBAR();
    finishSM(pA0, pA1, alA, l_reg, pa0, pa1, pa2, pa3); SBAR();
    if constexpr (F32) {
#pragma unroll
        for (int e = 8; e < 16; ++e) S.tq[e] = *(const f32x4*)QROW(e); SBAR(); }
#undef QROW
    pv_tile<0, SK>(o, vb0, pa0, pa1, pa2, pa3, ACT(even ? NT - 2 : NT - 1));
    if (even) { MASKT(pB0, pB1, NT - 1); partialSM(pB0, pB1, m_reg, mnB, alB, ROWOFF(NT - 1)); __syncthreads(); RESC(alB);
        finishSM(pB0, pB1, alB, l_reg, pa0, pa1, pa2, pa3); SBAR(); pv_tile<1, SK>(o, vb0, pa0, pa1, pa2, pa3, ACT(NT - 1)); }
    SBAR(); SEAM_K0();
    if (hi == 0) li_l[r32] = l_reg; asm volatile("s_waitcnt lgkmcnt(0)" ::: "memory");
    float rli[16];
#pragma unroll
    for (int r = 0; r < 16; ++r) rli[r] = __builtin_amdgcn_rcpf(li_l[crow(r, hi)]);
    TOut* Ow = cur.O + (size_t)(wid * QBLK) * OPITCH;
#pragma unroll
    for (int r = 0; r < 16; ++r) { const int orow = crow(r, hi);
#pragma unroll
        for (int d0 = 0; d0 < 4; ++d0) { const float v = o[d0][r] * rli[r];
            if constexpr (same_t<TOut, float>::v) { Ow[(size_t)orow * OPITCH + d0 * 32 + r32] = v; }
            else { const float vn = __shfl_xor(v, 1);
                   if ((r32 & 1) == 0) *(unsigned*)(Ow + (size_t)orow * OPITCH + d0 * 32 + r32) = cvtpk(v, vn); } } }
    if constexpr (F32) {
#pragma unroll
        for (int d0 = 0; d0 < 8; ++d0) S.qr[d0] = pack8(S.tq[2 * d0], S.tq[2 * d0 + 1]); }
    __syncthreads();
#undef RESC
#undef KBASE
#undef ACT
#undef MASKT
#undef ROWOFF
#undef SEAM_K0
#undef HALF_STEP
}
#undef ROW
#undef VMW
#undef VMWN
#undef SLOAD_H
#undef SWRITE_HK
#undef SWRITE_HV
#undef SWRITE_H
#undef SLOAD_F
#undef SWRITE_KF
#undef SWRITE_VF
#undef KSWZ
#undef SBAR
}
namespace mb {
__device__ __forceinline__ float bfx(short s) { return __uint_as_float(((unsigned)(unsigned short)s) << 16); }
#define MOBA_INS(g, n, TIE) do { const float g_ = (g); const int n_ = (n); \
    const bool b0_ = g_ > v0 || (TIE && g_ == v0 && n_ < i0), b1_ = g_ > v1 || (TIE && g_ == v1 && n_ < i1), b2_ = g_ > v2 || (TIE && g_ == v2 && n_ < i2); \
    v2 = b1_ ? v1 : (b2_ ? g_ : v2); i2 = b1_ ? i1 : (b2_ ? n_ : i2); \
    v1 = b0_ ? v0 : (b1_ ? g_ : v1); i1 = b0_ ? i0 : (b1_ ? n_ : i1); \
    v0 = b0_ ? g_ : v0; i0 = b0_ ? n_ : i0; } while (0)
__device__ __forceinline__ unsigned moba_select(const bf16x8 (&qr)[8], const char* kmB, int own, int lane) {
    if (own <= 3) return (1u << own) - 1u;
    const int hi = lane >> 5;
    const char* kp = kmB + (lane & 15) * 272 + hi * 16;
    f32x16 g;
#pragma unroll
    for (int r = 0; r < 16; ++r) g[r] = 0.f;
#pragma unroll
    for (int d0 = 0; d0 < 8; ++d0) {
        const bf16x8 ah = *(const bf16x8*)(kp + d0 * 32), al = *(const bf16x8*)(kp + 4352 + d0 * 32);
        g = __builtin_amdgcn_mfma_f32_32x32x16_bf16(ah, qr[d0], g, 0, 0, 0);
        g = __builtin_amdgcn_mfma_f32_32x32x16_bf16(al, qr[d0], g, 0, 0, 0);
    }
    float v0 = -INFINITY, v1 = -INFINITY, v2 = -INFINITY; int i0 = 31, i1 = 31, i2 = 31;
#pragma unroll
    for (int r = 0; r < 8; ++r) { const int n = (r & 3) + 8 * (r >> 2) + 4 * hi; MOBA_INS(n < own ? g[r] : -INFINITY, n, false); }
    float pv[3]; int pi[3];
    { const float mv[3] = {v0, v1, v2}; const int mi[3] = {i0, i1, i2};
#pragma unroll
        for (int e = 0; e < 3; ++e) {
            auto rv = __builtin_amdgcn_permlane32_swap(__float_as_uint(mv[e]), __float_as_uint(mv[e]), false, false);
            auto ri = __builtin_amdgcn_permlane32_swap((unsigned)mi[e], (unsigned)mi[e], false, false);
            pv[e] = __uint_as_float(hi ? rv[0] : rv[1]); pi[e] = (int)(hi ? ri[0] : ri[1]); } }
#pragma unroll
    for (int e = 0; e < 3; ++e) MOBA_INS(pv[e], pi[e], true);
    return (1u << i0) | (1u << i1) | (1u << i2);
}
__device__ __forceinline__ BlockRef<bf16, bf16> mk_block(const bf16* Qb, const bf16* Kb, const bf16* Vb, bf16* ATT, int first, int step, int idx, int& bh_out) {
    const int item = first + (idx >> 1) * step, bh = item >> 3, x = item & 7, qb = (idx & 1) ? x : 15 - x, b = bh >> 3, h = bh & 7;
    BlockRef<bf16, bf16> r;
    r.Q = Qb + (size_t)(b * SEQ + qb * 256) * QPITCH + h * 128;
    r.K = Kb + (size_t)(b * SEQ) * KPITCH + h * 128;
    r.V = Vb + (size_t)(b * SEQ) * KPITCH + h * 128;
    r.O = ATT + (size_t)(b * SEQ + qb * 256) * OPITCH + h * 128;
    r.P0 = qb * 256; bh_out = bh; return r;
}
__device__ __forceinline__ void prompt_attention(unsigned char* ws, char* lds, int first, int step, const int wv) {
    const bf16* Qb = (const bf16*)(ws + WS_Q); const bf16* Kb = (const bf16*)(ws + WS_K); const bf16* Vb = (const bf16*)(ws + WS_V); bf16* ATT = (bf16*)(ws + WS_ATT);
    const float* kmsum = (const float*)(ws + CTL_KMP);
    char* kmB = lds + 69632;
    if (first >= 128) return;
    const int nitems = (128 - first + step - 1) / step, nb = 2 * nitems;
    Seam<bf16> S;
    int bh; BlockRef<bf16, bf16> cur = mk_block(Qb, Kb, Vb, ATT, first, step, 0, bh);
    causal_swa_prime<bf16, bf16>(cur, 0x40000000, lds, S, wv);
    for (int i = 0; i < nb; ++i) {
        int bhn = bh; const BlockRef<bf16, bf16> nxt = (i + 1 < nb) ? mk_block(Qb, Kb, Vb, ATT, first, step, i + 1, bhn) : cur;
        int tl = wv * 64 + lane_id(); asm volatile("" : "+v"(tl));
        { const int b = bh >> 3, h = bh & 7; const float* src = kmsum + ((size_t)(b * 16) * NH + h) * HD;
            const f32x4 v = *(const f32x4*)(src + (size_t)(tl >> 5) * NH * HD + (tl & 31) * 4);
            const unsigned h0 = cvtpk(v[0], v[1]), h1 = cvtpk(v[2], v[3]);
            const unsigned l0 = cvtpk(v[0] - __uint_as_float(h0 << 16), v[1] - __uint_as_float(h0 & 0xffff0000u)), l1 = cvtpk(v[2] - __uint_as_float(h1 << 16), v[3] - __uint_as_float(h1 & 0xffff0000u));
            *(uint2*)(kmB + (tl >> 5) * 272 + (tl & 31) * 8) = make_uint2(h0, h1); *(uint2*)(kmB + 4352 + (tl >> 5) * 272 + (tl & 31) * 8) = make_uint2(l0, l1); }
        __syncthreads();
        unsigned selmask = moba_select(S.qr, kmB, cur.P0 >> 8, tl & 63);
#if PROBE_REP == 90
#pragma unroll 1
        for (int r_ = 0; r_ < 8; ++r_) { int own_ = cur.P0 >> 8; asm volatile("" : "+s"(own_)); selmask &= moba_select(S.qr, kmB, own_, tl & 63); }
#endif
        causal_swa_block<bf16, bf16>(cur, nxt, SEQ, 0x40000000, lds, S, selmask, wv);
        cur = nxt; bh = bhn;
    }
}
}

constexpr size_t CTL_SMP_GATES = CTL_SMP + 4096;
constexpr unsigned SMP_SPIN_CAP = 1u << 22;
typedef float f32x2v __attribute__((ext_vector_type(2)));
__device__ __forceinline__ void sample_scan_item(const Args& a, LAS unsigned char* lds, int b, int n, int tid, int wave, int lane) {
    const float* cache_k = a.in[2]; const int* pt = (const int*)a.in[4]; unsigned char* ws = a.ws;
    LAS float* red = (LAS float*)lds;
    LAS float* qL = (LAS float*)(lds + 32768);
    LAS float* kmr = (LAS float*)(lds + 49152);
    const int page = pt[b * NPG + 2 * n + (wave >> 2)];
    const float* base = cache_k + ((size_t)page * PAGE + (wave & 3) * 32) * 1024 + lane * 4;
    f32x4 acc[4];
#pragma unroll
    for (int c = 0; c < 4; ++c) acc[c] = (f32x4){0.f, 0.f, 0.f, 0.f};
    for (int j = 0; j < 32; j += 8) {
        f32x4 v[8][4];
#pragma unroll
        for (int jj = 0; jj < 8; ++jj)
#pragma unroll
            for (int c = 0; c < 4; ++c) v[jj][c] = __builtin_nontemporal_load((const f32x4*)(base + (size_t)(j + jj) * 1024 + c * 256));
#pragma unroll
        for (int jj = 0; jj < 8; ++jj)
#pragma unroll
            for (int c = 0; c < 4; ++c) acc[c] += v[jj][c];
    }
#pragma unroll
    for (int c = 0; c < 4; ++c) *(LAS f32x4*)(red + wave * 1024 + c * 256 + lane * 4) = acc[c];
    { const bf16* Qb = (const bf16*)(ws + WS_Q) + (size_t)(MP + b * DS) * 1024;
        const v4u qq = *(const GAS v4u*)(Qb + tid * 8); float qf[8];
#pragma unroll
        for (int e = 0; e < 4; ++e) { qf[2 * e] = __uint_as_float(qq[e] << 16); qf[2 * e + 1] = __uint_as_float(qq[e] & 0xffff0000u); }
#pragma unroll
        for (int e = 0; e < 8; ++e) qL[tid * 8 + e] = qf[e]; }
    __syncthreads();
    { float s0 = 0.f, s1 = 0.f;
#pragma unroll
        for (int w = 0; w < 8; ++w) { s0 += red[w * 1024 + tid * 2]; s1 += red[w * 1024 + tid * 2 + 1]; }
        kmr[tid * 2] = s0 * (1.f / 256.f); kmr[tid * 2 + 1] = s1 * (1.f / 256.f); }
    __syncthreads();
    {
        const int h = wave; unsigned* gates = (unsigned*)(ws + CTL_SMP_GATES);
        const float k0 = kmr[h * 128 + lane], k1 = kmr[h * 128 + lane + 64];
#pragma unroll
        for (int t = 0; t < DS; ++t) {
            float p = qL[t * 1024 + h * 128 + lane] * k0 + qL[t * 1024 + h * 128 + lane + 64] * k1;
            p = wave_sum(p);
            if (lane == 0) __hip_atomic_store(gates + ((size_t)(b * DS + t) * NH + h) * 64 + n, __float_as_uint(p), RLX_AGENT);
        }
    }
    asm volatile("s_waitcnt vmcnt(0)" ::: "memory");
    __syncthreads();
    if (tid == 0) __hip_atomic_fetch_add((unsigned*)(ws + CTL_SMP) + 64 * b, 1u, RLX_AGENT);
}
__device__ __forceinline__ void sample_attn_item(const Args& a, LAS unsigned char* lds, int b, int t, int h, int tid, int wave, int lane) {
    const float* cache_k = a.in[2]; const float* cache_v = a.in[3]; const int* pt = (const int*)a.in[4]; unsigned char* ws = a.ws;
    LAS float* lg = (LAS float*)lds;
    LAS float* oL = (LAS float*)(lds + 4096);
    gu32* ctl = (gu32*)(ws + WS_CTL);
    const int row = MP + b * DS + t;
    if (wave == 0) {
        unsigned* cnt = (unsigned*)(ws + CTL_SMP) + 64 * b; unsigned sp = 0;
        while ((unsigned)__builtin_amdgcn_readfirstlane(__hip_atomic_load(cnt, RLX_AGENT)) < 64u) {
            __builtin_amdgcn_s_sleep(2);
            if ((++sp & 255u) == 0u) { if (__hip_atomic_load((unsigned*)(ctl + CW_TMO), RLX_AGENT)) break; if (sp > SMP_SPIN_CAP) { if (lane == 0) __hip_atomic_store((unsigned*)(ctl + CW_TMO), 1u, RLX_AGENT); break; } }
        }
        __builtin_amdgcn_fence(__ATOMIC_ACQUIRE, "agent");
    }
    asm volatile("s_waitcnt vmcnt(0)" ::: "memory");
    __syncthreads();
    float gate = __uint_as_float(__hip_atomic_load((unsigned*)(ws + CTL_SMP_GATES) + ((size_t)(b * DS + t) * NH + h) * 64 + lane, RLX_AGENT));
    int sel0, sel1, sel2;
    {
        float bv = gate;
#pragma unroll
        for (int o = 1; o < 64; o <<= 1) bv = fmaxf(bv, __shfl_xor(bv, o));
        sel0 = __ffsll((long long)__ballot(gate == bv)) - 1; if (lane == sel0) gate = -3e38f;
        bv = gate;
#pragma unroll
        for (int o = 1; o < 64; o <<= 1) bv = fmaxf(bv, __shfl_xor(bv, o));
        sel1 = __ffsll((long long)__ballot(gate == bv)) - 1; if (lane == sel1) gate = -3e38f;
        bv = gate;
#pragma unroll
        for (int o = 1; o < 64; o <<= 1) bv = fmaxf(bv, __shfl_xor(bv, o));
        sel2 = __ffsll((long long)__ballot(gate == bv)) - 1;
    }
    const int pg00 = pt[b * NPG + 2 * sel0], pg01 = pt[b * NPG + 2 * sel0 + 1], pg10 = pt[b * NPG + 2 * sel1], pg11 = pt[b * NPG + 2 * sel1 + 1], pg20 = pt[b * NPG + 2 * sel2], pg21 = pt[b * NPG + 2 * sel2 + 1];
#define SMP_PAGE(g) (((g) >> 8) == 0 ? (((g) & 128) ? pg01 : pg00) : (((g) >> 8) == 1 ? (((g) & 128) ? pg11 : pg10) : (((g) & 128) ? pg21 : pg20)))
    const int sub = lane & 15, kq = lane >> 4;
    float q[8];
    { const bf16* qp = (const bf16*)(ws + WS_Q) + (size_t)row * 1024 + h * 128 + sub * 8; const v4u qq = *(const GAS v4u*)qp;
#pragma unroll
        for (int e = 0; e < 4; ++e) { q[2 * e] = __uint_as_float(qq[e] << 16); q[2 * e + 1] = __uint_as_float(qq[e] & 0xffff0000u); } }
#pragma unroll 1
    for (int it = 0; it < 24; it += 12) {
        f32x4 ka[12], kb[12];
#pragma unroll
        for (int u = 0; u < 12; ++u) {
            const int g = wave * 96 + (it + u) * 4 + kq;
            const unsigned ko = (((unsigned)SMP_PAGE(g) * PAGE + (g & 127)) * 1024 + h * 128 + sub * 8) * 4u;
            ka[u] = __builtin_nontemporal_load((const f32x4*)((const char*)cache_k + ko)); kb[u] = __builtin_nontemporal_load((const f32x4*)((const char*)cache_k + ko + 16));
        }
#pragma unroll
        for (int u = 0; u < 12; ++u) {
            float p = (q[0] * ka[u][0] + q[1] * ka[u][1]) + (q[2] * ka[u][2] + q[3] * ka[u][3]) + (q[4] * kb[u][0] + q[5] * kb[u][1]) + (q[6] * kb[u][2] + q[7] * kb[u][3]);
            p += __shfl_xor(p, 1); p += __shfl_xor(p, 2); p += __shfl_xor(p, 4); p += __shfl_xor(p, 8);
            if (sub == 0) lg[wave * 96 + (it + u) * 4 + kq] = p * 0.08838834764831845f;
        }
    }
    if (wave == 0) {
        const bf16* kp = (const bf16*)(ws + WS_K) + (size_t)(MP + b * DS + kq) * 1024 + h * 128 + sub * 8; const v4u kk = *(const GAS v4u*)kp;
        float p = 0.f;
#pragma unroll
        for (int e = 0; e < 4; ++e) p += q[2 * e] * __uint_as_float(kk[e] << 16) + q[2 * e + 1] * __uint_as_float(kk[e] & 0xffff0000u);
        p += __shfl_xor(p, 1); p += __shfl_xor(p, 2); p += __shfl_xor(p, 4); p += __shfl_xor(p, 8);
        if (sub == 0) lg[768 + kq] = kq <= t ? p * 0.08838834764831845f : -INFINITY;
    }
    __syncthreads();
    float mx = -INFINITY;
    for (int i = lane; i < 772; i += 64) mx = fmaxf(mx, lg[i]);
#pragma unroll
    for (int o = 1; o < 64; o <<= 1) mx = fmaxf(mx, __shfl_xor(mx, o));
    float sum = 0.f;
    for (int i = lane; i < 772; i += 64) sum += __expf(lg[i] - mx);
    sum = wave_sum(sum);
    __syncthreads();
    for (int i = lane; i < 96; i += 64) lg[wave * 96 + i] = __expf(lg[wave * 96 + i] - mx);
    if (wave == 0 && lane < 4) lg[768 + lane] = __expf(lg[768 + lane] - mx);
    const int kh = lane >> 5, dl = lane & 31;
    f32x4 o4 = (f32x4){0.f, 0.f, 0.f, 0.f};
#pragma unroll 1
    for (int j0 = 0; j0 < 48; j0 += 24) {
        f32x4 vv[24];
#pragma unroll
        for (int u = 0; u < 24; ++u) {
            const int g = wave * 96 + 2 * (j0 + u) + kh;
            const unsigned vo = (((unsigned)SMP_PAGE(g) * PAGE + (g & 127)) * 1024 + h * 128 + dl * 4) * 4u;
            vv[u] = __builtin_nontemporal_load((const f32x4*)((const char*)cache_v + vo));
        }
#pragma unroll
        for (int u = 0; u < 24; ++u) o4 += vv[u] * lg[wave * 96 + 2 * (j0 + u) + kh];
    }
    if (wave == 0 && kh == 0) {
        for (int j = 0; j <= t; ++j) { const bf16* vp = (const bf16*)(ws + WS_V) + (size_t)(MP + b * DS + j) * 1024 + h * 128 + dl * 4; const unsigned long long vw = *(const GAS unsigned long long*)vp;
            const float p = lg[768 + j];
            o4 += (f32x4){__uint_as_float((unsigned)vw << 16), __uint_as_float((unsigned)vw & 0xffff0000u), __uint_as_float((unsigned)(vw >> 32) << 16), __uint_as_float((unsigned)(vw >> 32) & 0xffff0000u)} * p; }
    }
#pragma unroll
    for (int e = 0; e < 4; ++e) o4[e] += __shfl_xor(o4[e], 32);
    if (kh == 0) *(LAS f32x4*)(oL + wave * 128 + dl * 4) = o4;
    __syncthreads();
    if (tid < 128) { float s = 0.f;
#pragma unroll
        for (int w = 0; w < 8; ++w) s += oL[w * 128 + tid];
        ((bf16*)(ws + WS_ATT))[(size_t)row * DM + h * 128 + tid] = (bf16)f2bf(s / sum); }
    __syncthreads();
#undef SMP_PAGE
}
__device__ __forceinline__ void sample_path(const Args& a, LAS unsigned char* lds, int ib, int nB, int tid, int wave, int lane) {
    for (int s = ib; s < DB * 64; s += nB) sample_scan_item(a, lds, s >> 6, s & 63, tid, wave, lane);
    for (int j = ib; j < MS * NH; j += nB) sample_attn_item(a, lds, j >> 5, (j >> 3) & 3, j & 7, tid, wave, lane);
}
constexpr int N_PHASES = 10;
__global__ void __launch_bounds__(NWAVES * 64, 2) fwd_kernel(Args args) {
    extern __shared__ __attribute__((aligned(16))) unsigned char lds_raw[];
    LAS unsigned char* lds = (LAS unsigned char*)lds_raw;
    volatile LAS unsigned* MISC = (volatile LAS unsigned*)(lds + MISC_OFF);
    const int tid0 = threadIdx.x, wave = __builtin_amdgcn_readfirstlane(tid0 >> 6);
#define FRESH_TID() int tid = wave * 64 + lane_id(); asm volatile("" : "+v"(tid)); const int lane = tid & 63; (void)lane
    const int G = gridDim.x; const int bx = blockIdx.x; const int vcu = (G % 8 == 0) ? (bx % 8) * (G / 8) + bx / 8 : bx;
    unsigned char* ws = args.ws;
    gu32* ctl = (gu32*)(ws + WS_CTL);
    for (int u = tid0; u < (LDS_BYTES - LDSCTL_OFF) / 4; u += NWAVES * 64) ((LAS unsigned*)(lds + LDSCTL_OFF))[u] = 0u;
    __syncthreads();
    XcdBarrier bar = xcd_barrier_post((unsigned*)(ctl + CW_BAR) + args.li * XCD_BAR_WORDS, MISC + 8, wave);
    const int lo = args.ph_lo, hi = args.ph_hi;
#define IN(k) (lo <= (k) && (k) < hi)
#define BOTH(k) (IN(k) && IN((k) + 1))
#define GRID_BAR() xcd_barrier(bar)
    unsigned long long* SS = (unsigned long long*)(ws + CTL_SS);
    float* out = args.out;
    float* o_kp = out + (size_t)MV * DM; float* o_vp = o_kp + (size_t)MP * 1024; float* o_ks = o_vp + (size_t)MP * 1024; float* o_vs = o_ks + (size_t)MS * 1024;
    float* o_cp = o_vs + (size_t)MS * 1024; float* o_cs = o_cp + (size_t)NB * 2 * CC;
    pg8::bf16_t* XB = (pg8::bf16_t*)(ws + WS_XB);

    if (IN(0)) { FRESH_TID(); p0_prologue(args, lds, vcu, G, wave, lane);
#if PROBE_REP == 0
        for (int rep_ = 0; rep_ < 4; ++rep_) { GRID_BAR(); p0_prologue(args, lds, vcu, G, wave, lane); }
#endif
        if (BOTH(0)) GRID_BAR(); }

    if (IN(1)) {
        pg8::Gemm g{XB, (const pg8::bf16_t*)(ws + WS_WIN), MP, INW, DM, DM, DM, 31, 0, 128, 128}; pg8::StaticOrder S; S.init(MP, INW, G, bx);
        pg8::EpiInProj E{SS, (const float*)(ws + WS_COS), (const float*)(ws + WS_SIN),
                         (pg8::bf16_t*)(ws + WS_Q), (pg8::bf16_t*)(ws + WS_K), (pg8::bf16_t*)(ws + WS_V), (pg8::bf16_t*)(ws + WS_G), (pg8::bf16_t*)(ws + WS_U),
                         o_kp, o_vp, o_ks, o_vs, o_cp, o_cs, (float*)(ws + CTL_KMP)};
        pg8::skinny_phase<pg8::EpiInProj>(lds + RING_OFF, g, E, bx, G, wave);
        pg8::gemm_phase<pg8::EpiInProj, pg8::StaticOrder, true, true>(lds + RING_OFF, g, S, E, wave);
        if (PROBE_REP == 1 || PROBE_REP == 11 || PROBE_REP == 12) { for (int rep_ = 0; rep_ < 4; ++rep_) { GRID_BAR();
            if (PROBE_REP == 12) { pg8::EpiSwiGLU El{SS, (pg8::bf16_t*)(ws + WS_END)}; pg8::gemm_phase<pg8::EpiSwiGLU, pg8::StaticOrder, true, true>(lds + RING_OFF, g, S, El, wave); }
            else { pg8::gemm_phase<pg8::EpiInProj, pg8::StaticOrder, true, true>(lds + RING_OFF, g, S, E, wave); if (PROBE_REP == 1) pg8::skinny_phase<pg8::EpiInProj>(lds + RING_OFF, g, E, bx, G, wave); } } }
        if (BOTH(1)) GRID_BAR();
    }
    if (IN(2)) { FRESH_TID();
#if MK_ATTN_EXTERNAL
        conv_pass(args, vcu, G, tid);
#else
        conv_pass(args, vcu, G, tid);
        if ((vcu & 1) == 0) mb::prompt_attention(ws, (char*)lds_raw, vcu >> 1, G >> 1, wave);
        else sample_path(args, lds, vcu >> 1, G >> 1, tid, wave, lane);
#if PROBE_REP == 2
        GRID_BAR();
        if ((vcu & 1) == 0) mb::prompt_attention(ws, (char*)lds_raw, vcu >> 1, G >> 1, wave);
        else { conv_pass(args, vcu >> 1, G >> 1, tid); sample_path(args, lds, vcu >> 1, G >> 1, tid, wave, lane); }
#endif
#if PROBE_REP == 21
        for (int rep_ = 0; rep_ < 4; ++rep_) { GRID_BAR();
        if ((vcu & 1) == 0) mb::prompt_attention(ws, (char*)lds_raw, vcu >> 1, G >> 1, wave); }
#endif
#if PROBE_REP == 23
        GRID_BAR();
        if ((vcu & 1) != 0) conv_pass(args, vcu >> 1, G >> 1, tid);
#endif
#if PROBE_REP == 24
        for (int rep_ = 0; rep_ < 4; ++rep_) { GRID_BAR();
        if ((vcu & 1) != 0) { for (int s_ = (vcu >> 1); s_ < DB * 64; s_ += (G >> 1)) sample_scan_item(args, lds, s_ >> 6, s_ & 63, tid, wave, lane); } }
#endif
#if PROBE_REP == 25
        GRID_BAR();
        if ((vcu & 1) != 0) { for (int j_ = (vcu >> 1); j_ < MS * NH; j_ += (G >> 1)) sample_attn_item(args, lds, j_ >> 5, (j_ >> 3) & 3, j_ & 7, tid, wave, lane); }
#endif
#if PROBE_REP == 22
        GRID_BAR();
        if ((vcu & 1) != 0) { conv_pass(args, vcu >> 1, G >> 1, tid); sample_path(args, lds, vcu >> 1, G >> 1, tid, wave, lane); }
#endif
#endif
        if (BOTH(2)) GRID_BAR();
    }
    if (IN(3)) { FRESH_TID();
        pg8::Gemm g{(const pg8::bf16_t*)(ws + WS_ATT), (const pg8::bf16_t*)(ws + WS_WO), MP, DM, DM, DM, DM, 31, 0, 128, 128}; pg8::StaticOrder S; S.init(MP, DM, G, bx);
        pg8::EpiResid E{XB, SS + 1 * MPAD, 0};
        pg8::skinny_phase_narrow<pg8::EpiResid>(lds + RING_OFF, g, E, bx, G, wave);
        pg8::gemm_phase<pg8::EpiResid, pg8::StaticOrder, false, true>(lds + RING_OFF, g, S, E, wave);
        if (CONV_IN_SLOTS && bx >= G / 2) convert_weights(args, (LAS float*)(lds + RING_OFF + wave * 16384), 1, (bx - G / 2) * NWAVES + wave, (G / 2) * NWAVES, lane, GU1_IN_P0, GU1_END_P3);
        if (BOTH(3)) GRID_BAR();
    }
#define FFN_PHASES(l, pb) \
    if (IN(pb)) { FRESH_TID();     \
        pg8::Gemm g{XB, (const pg8::bf16_t*)(ws + WS_WGU) + (size_t)(l) * 2 * FF * DM, MP, 2 * FF, DM, DM, DM, 31, 0, 128, 128}; pg8::StaticOrder S; S.init(MP, 2 * FF, G, bx); \
        pg8::EpiSwiGLU E{SS + ((l) == 0 ? 1 : 3) * MPAD, (pg8::bf16_t*)(ws + WS_H)}; \
        if (HALF_UNITS && G == 256) { \
            pg8::HalfOrder Hh; Hh.so = S; Hh.L = 5 * G + (bx & (G / 2 - 1)); Hh.half = bx / (G / 2);     \
            S.lim = 5 * G; \
            pg8::gemm_phase<pg8::EpiSwiGLU, pg8::StaticOrder, true, true>(lds + RING_OFF, g, S, E, wave); \
            pg8::gemm_phase_hm<pg8::EpiSwiGLU, pg8::HalfOrder>(lds + RING_OFF, g, Hh, E, wave); \
            pg8::skinny_phase<pg8::EpiSwiGLU>(lds + RING_OFF, g, E, bx, G, wave); \
        } else { \
            pg8::gemm_phase<pg8::EpiSwiGLU, pg8::StaticOrder, true, true>(lds + RING_OFF, g, S, E, wave); \
            pg8::skinny_phase<pg8::EpiSwiGLU>(lds + RING_OFF, g, E, bx >= G / 2 ? bx - G / 2 : (1 << 30), G / 2, wave);     \
            if (CONV_IN_SLOTS && bx >= G / 2) convert_weights(args, (LAS float*)(lds + RING_OFF + wave * 16384), 1 + (l), (bx - G / 2) * NWAVES + wave, (G / 2) * NWAVES, lane, (l) == 0 ? GU1_END_P3 : 0, (l) == 0 ? GU1_END_P4 : (1 << 30)); \
        } \
        if ((PROBE_REP == 70 && (l) == 1) || (PROBE_REP == 72 && (l) == 0) || (PROBE_REP == 71 && (l) == 1)) { for (int rep_ = 0; rep_ < 4; ++rep_) { GRID_BAR();     \
            pg8::gemm_phase<pg8::EpiSwiGLU, pg8::StaticOrder, true, true>(lds + RING_OFF, g, S, E, wave); \
            if (PROBE_REP != 71) { pg8::skinny_phase<pg8::EpiSwiGLU>(lds + RING_OFF, g, E, bx >= G / 2 ? bx - G / 2 : (1 << 30), G / 2, wave); \
                if (bx >= G / 2) convert_weights(args, (LAS float*)(lds + RING_OFF + wave * 16384), 1 + (l), (bx - G / 2) * NWAVES + wave, (G / 2) * NWAVES, lane, 0); } } } \
        if (BOTH(pb)) GRID_BAR(); \
    } \
    if (IN((pb) + 1)) { FRESH_TID();     \
        pg8::Gemm g{(const pg8::bf16_t*)(ws + WS_H), (const pg8::bf16_t*)(ws + WS_WDN) + (size_t)(l) * DM * FF, MP, DM, FF, 64, 64, 31, 0, (size_t)MPAD * 128, (size_t)DM * 128};     pg8::StaticOrder S; S.init(MP, DM, G, bx); \
        if ((l) == 0) { \
            pg8::EpiResid E{XB, SS + 2 * MPAD, 0}; \
            pg8::skinny_phase_narrow<pg8::EpiResid>(lds + RING_OFF, g, E, bx, G, wave); \
            pg8::gemm_phase<pg8::EpiResid, pg8::StaticOrder, false, true>(lds + RING_OFF, g, S, E, wave); \
            if (CONV_IN_SLOTS && bx >= G / 2) convert_weights(args, (LAS float*)(lds + RING_OFF + wave * 16384), 1, (bx - G / 2) * NWAVES + wave, (G / 2) * NWAVES, lane, GU1_END_P4, GU1_END_P5); \
        } else { \
            pg8::EpiFinal E{XB, SS + 4 * MPAD, args.in[9], out, (unsigned*)(ws + CTL_FIN), (unsigned*)(ctl + CW_TMO)}; \
            pg8::skinny_phase_narrow<pg8::EpiFinal>(lds + RING_OFF, g, E, bx, G, wave); \
            pg8::gemm_phase<pg8::EpiFinal, pg8::StaticOrder, false, true>(lds + RING_OFF, g, S, E, wave); \
        } \
        if (BOTH((pb) + 1)) GRID_BAR(); \
    }
#if PROBE_REP == 83 || PROBE_REP == 84
    if (IN(5)) {
        for (int rep_ = 0; rep_ < 4; ++rep_) { FRESH_TID();
            if ((vcu & 1) != 0) {
                if (PROBE_REP == 83) { for (int s_ = (vcu >> 1); s_ < DB * 64; s_ += (G >> 1)) sample_scan_item(args, lds, s_ >> 6, s_ & 63, tid, wave, lane); }
                else { for (int j_ = (vcu >> 1); j_ < MS * NH; j_ += (G >> 1)) sample_attn_item(args, lds, j_ >> 5, (j_ >> 3) & 3, j_ & 7, tid, wave, lane); } }
            GRID_BAR(); }
    }
#endif
#if PROBE_REP == 82
    if (IN(5)) {
        for (int rep_ = 0; rep_ < 8; ++rep_) { FRESH_TID(); convert_weights(args, (LAS float*)(lds + RING_OFF + wave * 16384), 0, vcu * NWAVES + wave, G * NWAVES, lane); GRID_BAR(); }
    }
#endif
#if PROBE_REP == 80 || PROBE_REP == 81
    if (IN(5)) {
        for (int rep_ = 0; rep_ < 8; ++rep_) { FRESH_TID();
            if (PROBE_REP == 81) convert_weights(args, (LAS float*)(lds + RING_OFF + wave * 16384), 1, bx * NWAVES + wave, G * NWAVES, lane, 0);
            else if (bx >= G / 2) convert_weights(args, (LAS float*)(lds + RING_OFF + wave * 16384), 1, (bx - G / 2) * NWAVES + wave, (G / 2) * NWAVES, lane, 0);
            GRID_BAR(); }
    }
#endif
#if PROBE_REP >= 60 && PROBE_REP <= 65
    if (IN(5)) {
        for (int rep_ = 0; rep_ < 8; ++rep_) {
            if (PROBE_REP != 62) {
                if (PROBE_REP == 64) {
                    pg8::Gemm g{(const pg8::bf16_t*)(ws + WS_H), (const pg8::bf16_t*)(ws + WS_WDN), MP, DM, FF, 64, 64, 31, 0, (size_t)MPAD * 128, (size_t)DM * 128}; pg8::StaticOrder S; S.init(MP, DM, G, bx);
                    pg8::EpiResid E{(pg8::bf16_t*)(ws + WS_END), (unsigned long long*)(ws + WS_END + (size_t)MPAD * DM * 2), PROBE_REP == 65};
                    pg8::gemm_phase<pg8::EpiResid, pg8::StaticOrder, false, true>(lds + RING_OFF, g, S, E, wave);
                    pg8::skinny_phase_narrow<pg8::EpiResid>(lds + RING_OFF, g, E, bx, G, wave);
                } else {
                    pg8::Gemm g{(const pg8::bf16_t*)(ws + WS_ATT), (const pg8::bf16_t*)(ws + WS_WO), MP, DM, DM, DM, DM, 31, 0, 128, 128}; pg8::StaticOrder S; S.init(MP, DM, G, bx);
                    if (PROBE_REP == 63) { pg8::EpiSwiGLU E{SS, (pg8::bf16_t*)(ws + WS_END)}; pg8::gemm_phase<pg8::EpiSwiGLU, pg8::StaticOrder, false, true>(lds + RING_OFF, g, S, E, wave); }
                    else { pg8::EpiResid E{(pg8::bf16_t*)(ws + WS_END), (unsigned long long*)(ws + WS_END + (size_t)MPAD * DM * 2), PROBE_REP == 65};
                        pg8::gemm_phase<pg8::EpiResid, pg8::StaticOrder, false, true>(lds + RING_OFF, g, S, E, wave);
                        if (PROBE_REP == 60) pg8::skinny_phase_narrow<pg8::EpiResid>(lds + RING_OFF, g, E, bx, G, wave); }
                }
            }
            GRID_BAR();
        }
    }
#endif
#if PROBE_REP == 52 || PROBE_REP == 53
    if (IN(5)) {
        constexpr bool BLK = PROBE_REP == 53;
        pg8::Gemm g{XB, (const pg8::bf16_t*)(ws + WS_WIN), MP, INW, DM, BLK ? 64 : DM, BLK ? 64 : DM, 31, 0, BLK ? (size_t)MPAD * 128 : 128, BLK ? (size_t)INW * 128 : 128}; pg8::StaticOrder S; S.init(MP, INW, G, bx);
        pg8::EpiSwiGLU E{SS, (pg8::bf16_t*)(ws + WS_END)};
        pg8::gemm_phase<pg8::EpiSwiGLU, pg8::StaticOrder, true, true>(lds + RING_OFF, g, S, E, wave);
        GRID_BAR();
    }
#endif
#if PROBE_REP == 50 || PROBE_REP == 51
    if (IN(5)) {
        constexpr int LD = PROBE_REP == 50 ? FF : DM;
        pg8::Gemm g{(const pg8::bf16_t*)(ws + WS_H), (const pg8::bf16_t*)(ws + WS_WDN), MP, DM, FF, LD, LD, 31, 0, 128, 128}; pg8::StaticOrder S; S.init(MP, DM, G, bx);
        pg8::EpiResid E{(pg8::bf16_t*)(ws + WS_END), (unsigned long long*)(ws + WS_END + (size_t)MPAD * DM * 2), PROBE_REP == 65};
        pg8::gemm_phase<pg8::EpiResid, pg8::StaticOrder, false, true>(lds + RING_OFF, g, S, E, wave);
        GRID_BAR();
    }
#endif
    FFN_PHASES(0, 4)
    if (IN(6)) { FRESH_TID(); pool_pass(args, vcu, G, tid); if (PROBE_REP == 6) { for (int rep_ = 0; rep_ < 8; ++rep_) { GRID_BAR(); pool_pass(args, vcu, G, tid); } } if (BOTH(6)) GRID_BAR(); }
    if (IN(7)) { FRESH_TID();
        pg8::Gemm g{(const pg8::bf16_t*)(ws + WS_D), (const pg8::bf16_t*)(ws + WS_WPL), MP, DM, 512, DM, 512, 1, 512 * 2, 128, 128}; pg8::StaticOrder S; S.init(MP, DM, G, bx);
        pg8::EpiResid E{XB, SS + 3 * MPAD, 0};
        pg8::skinny_phase_narrow<pg8::EpiResid>(lds + RING_OFF, g, E, bx, G, wave);
        pg8::gemm_phase<pg8::EpiResid, pg8::StaticOrder, false, true>(lds + RING_OFF, g, S, E, wave);
        if (CONV_IN_SLOTS && bx >= G / 2) convert_weights(args, (LAS float*)(lds + RING_OFF + wave * 16384), 1, (bx - G / 2) * NWAVES + wave, (G / 2) * NWAVES, lane, GU1_END_P5, 1 << 30);
        if (BOTH(7)) GRID_BAR();
    }
    FFN_PHASES(1, 8)
#undef FFN_PHASES
#undef FRESH_TID
#undef IN
#undef BOTH
#undef GRID_BAR
}
extern "C" void kernel_launch(void* const* d_in, const int* in_sizes, int n_in, void* d_out, int out_size, void* d_ws, size_t ws_size, hipStream_t stream) {
    static int grid = 0;
    if (grid == 0) {
        if (n_in != 18 || ws_size < WS_END + (size_t)MPAD * DM * 8) { fprintf(stderr, "kernel_launch: built for 18 inputs and >= %zu bytes of workspace; got n_in %d, ws %zu; nothing launched\n", (size_t)WS_END, n_in, ws_size); grid = -1; return; }
        int dev = 0, cus = 0, per_cu = 0;
        if (hipGetDevice(&dev) != hipSuccess || hipDeviceGetAttribute(&cus, hipDeviceAttributeMultiprocessorCount, dev) != hipSuccess) { fprintf(stderr, "kernel_launch: device query failed\n"); grid = -1; return; }
        if (hipFuncSetAttribute((const void*)fwd_kernel, hipFuncAttributeMaxDynamicSharedMemorySize, LDS_BYTES) != hipSuccess) { fprintf(stderr, "kernel_launch: hipFuncSetAttribute failed\n"); grid = -1; return; }
        if (hipOccupancyMaxActiveBlocksPerMultiprocessor(&per_cu, (const void*)fwd_kernel, NWAVES * 64, LDS_BYTES) != hipSuccess || per_cu < 1)
            fprintf(stderr, "kernel_launch: note: occupancy query reports %d workgroups per CU\n", per_cu);
        (void)hipGetLastError();
        grid = cus;
    }
    if (grid < 0) return;
    if (hipMemsetAsync((char*)d_ws + WS_CTL, 0, CTL_ZERO_BYTES, stream) != hipSuccess) { fprintf(stderr, "kernel_launch: memset failed\n"); return; }
    Args a{};
    for (int i = 0; i < 18; ++i) a.in[i] = (const float*)d_in[i];
    a.out = (float*)d_out; a.ws = (unsigned char*)d_ws; a.pad = 0;
    unsigned char* ws = (unsigned char*)d_ws;
#if MK_ATTN_EXTERNAL
    a.ph_lo = 0; a.ph_hi = 2; a.li = 0;
    hipLaunchKernelGGL(fwd_kernel, dim3(grid), dim3(NWAVES * 64), LDS_BYTES, stream, a);
    na::k_kmean_sample<<<DB * 64 * 1024 / 256, 256, 0, stream>>>((const float*)d_in[2], (const int*)d_in[4], (float*)(ws + WS_KMS));
    na::k_attn_prompt<<<MP * 8 / 4, 256, 0, stream>>>((const bf16*)(ws + WS_Q), (const bf16*)(ws + WS_K), (const bf16*)(ws + WS_V), (const float*)(ws + CTL_KMP), (bf16*)(ws + WS_ATT));
    na::k_attn_sample<<<MS * 8 / 4, 256, 0, stream>>>((const bf16*)(ws + WS_Q), (const bf16*)(ws + WS_K), (const bf16*)(ws + WS_V), (const float*)(ws + WS_KMS),
                                                      (const float*)d_in[2], (const float*)d_in[3], (const int*)d_in[4], (bf16*)(ws + WS_ATT));
    a.ph_lo = 2; a.ph_hi = N_PHASES; a.li = 1;
    hipLaunchKernelGGL(fwd_kernel, dim3(grid), dim3(NWAVES * 64), LDS_BYTES, stream, a);
#else
    a.ph_lo = 0; a.ph_hi = N_PHASES; a.li = 0;
    hipLaunchKernelGGL(fwd_kernel, dim3(grid), dim3(NWAVES * 64), LDS_BYTES, stream, a);
#endif
    const hipError_t le = hipPeekAtLastError();
    if (le != hipSuccess) fprintf(stderr, "kernel_launch: launch failed: %s\n", hipGetErrorName(le));
}
```

```cpp
#include <hip/hip_runtime.h>
#include <hip/hip_bf16.h>
#include <cstdio>
#include <cstdint>
#include <cmath>
#ifndef MK_ATTN_EXTERNAL
#define MK_ATTN_EXTERNAL 0
#endif
#ifndef PROBE_REP
#define PROBE_REP -1
#endif
#ifndef CONV_IN_SLOTS
#define CONV_IN_SLOTS 1
#endif
#ifndef GU1_IN_P0
#define GU1_IN_P0 0
#endif
#ifndef HALF_UNITS
#define HALF_UNITS 0
#endif
#ifndef XB_NT_STORE
#define XB_NT_STORE 0
#endif
#ifndef GEMM_A_AUX
#define GEMM_A_AUX 0
#endif
#ifndef GEMM_B_AUX
#define GEMM_B_AUX 0
#endif
#ifndef CONV_BATCH
#define CONV_BATCH 4
#endif
#ifndef KV_NT_STORE
#define KV_NT_STORE 0
#endif
#ifndef XB_WT_STORE
#define XB_WT_STORE 0
#endif
#ifndef GU1_END_P3
#define GU1_END_P1 2560
#define GU1_END_P3 0
#define GU1_END_P4 (1 << 30)
#define GU1_END_P5 (1 << 30)
#endif
constexpr int DM = 2048, SEQ = 4096, NB = 2, DB = 8, DS = 4, PAST = 16384, PAGE = 128, NPG = PAST / PAGE;
constexpr int MP = NB * SEQ, MS = DB * DS, MV = MP + MS, MPAD = 8448;
constexpr int INW = 6144, FF = 5632, HD = 128, NH = 8, CC = 1024;
constexpr float RMS_EPS = 1e-6f;
constexpr float SS_SCALE = 1048576.f;
namespace pg8 {
#define PG8_LAS __attribute__((address_space(3)))
typedef unsigned short bf16_t;
typedef short bf16x8 __attribute__((ext_vector_type(8)));
typedef float f32x4 __attribute__((ext_vector_type(4)));
typedef unsigned u32x4 __attribute__((ext_vector_type(4)));
constexpr int BM = 256, BK = 64, HALF = 128, HTB = HALF * BK * 2  , STAGE_BYTES = 8 * HTB, NXCD = 8, WGM = 8;

__host__ __device__ __forceinline__ int lds_byte(int r, int c) { const int st = (r >> 4) * 2 + (c >> 5), rr = r & 15, cc = c & 31, ob = rr * 64 + cc * 2; return st * 1024 + (ob ^ (((ob >> 9) & 1) << 5)); }
__host__ __device__ __forceinline__ void stage_rc(int b, int& R, int& C) { const int st = b / 1024, sb = b % 1024, swz = sb ^ (((sb >> 9) & 1) << 5); R = (st >> 1) * 16 + swz / 64; C = (st & 1) * 32 + (swz % 64) / 2; }
__host__ __device__ __forceinline__ int perm32(int rho) { const int n = rho >> 4, i = rho & 15; return 8 * (i >> 2) + 4 * n + (i & 3); }

struct Unit { int pm, pn, half; };
struct Gemm { const bf16_t* A; const bf16_t* Bt; int M, N, K, lda, ldb, gshift, gstride; size_t kstepA, kstepB; };

struct StaticOrder {
    int nM, nN, nwg, G, c, lim;
    __host__ __device__ void init(int M, int N, int G_, int c_) { nM = M / BM; nN = N / BM; nwg = nM * nN; G = G_; c = c_; lim = nwg; }
    __host__ __device__ bool next(int i, Unit& u) const { const long L = (long)i * G + c; if (L >= lim) return false; map(L, u); return true; }
    __host__ __device__ void map(long L, Unit& u) const {
        int wgid = (int)L; { const int q = nwg / NXCD, r = nwg % NXCD, xcd = wgid % NXCD, off = wgid / NXCD; wgid = (xcd < r ? xcd * (q + 1) : r * (q + 1) + (xcd - r) * q) + off; }
        const int nig = WGM * nN, gid = wgid / nig, fm = gid * WGM, gsz = (nM - fm) < WGM ? (nM - fm) : WGM;
        u.pm = fm + ((wgid % nig) % gsz); u.pn = (wgid % nig) / gsz; u.half = 0;
    }
    __device__ __forceinline__ void a_ready(const Unit&) const {}
    __device__ __forceinline__ void done(const Unit&) const {}
};

__device__ __forceinline__ unsigned cvt_pk_bf16(float lo, float hi) { unsigned r; asm volatile("v_cvt_pk_bf16_f32 %0, %1, %2" : "=v"(r) : "v"(lo), "v"(hi)); return r; }
typedef unsigned u32x2 __attribute__((ext_vector_type(2)));
__device__ __forceinline__ void store16_wt(void* p, const u32x4 v) { asm volatile("global_store_dwordx4 %0, %1, off sc1" :: "v"(p), "v"(v) : "memory"); }
__device__ __forceinline__ float ss_to_rstd(unsigned long long s) { return rsqrtf((float)s * (1.0f / (SS_SCALE * (float)DM)) + RMS_EPS); }
__device__ __forceinline__ u32x4 pack8f(const f32x4 a, const f32x4 b) { u32x4 w; w.x = cvt_pk_bf16(a[0], a[1]); w.y = cvt_pk_bf16(a[2], a[3]); w.z = cvt_pk_bf16(b[0], b[1]); w.w = cvt_pk_bf16(b[2], b[3]); return w; }
__device__ __forceinline__ u32x2 pack4f(const f32x4 a) { u32x2 w; w.x = cvt_pk_bf16(a[0], a[1]); w.y = cvt_pk_bf16(a[2], a[3]); return w; }
template <bool GUARD>
__device__ __forceinline__ void load_rstd8(const unsigned long long* ss, int rbase, float (&rs)[2][4]) {
    unsigned long long s[2][4];
#pragma unroll
    for (int ai = 0; ai < 2; ++ai)
#pragma unroll
        for (int m = 0; m < 4; ++m) { const int row = rbase + ai * HALF + m * 16; s[ai][m] = (!GUARD || row < MV) ? ss[row] : 0ull; }
#pragma unroll
    for (int ai = 0; ai < 2; ++ai)
#pragma unroll
        for (int m = 0; m < 4; ++m) rs[ai][m] = ss_to_rstd(s[ai][m]);
}

struct EpiInProj {
    static constexpr bool PERM = true, AFTER_DRAIN = false, ACC_INIT = false;
    const unsigned long long* ss; const float* cosT; const float* sinT;
    bf16_t *Qb, *Kb, *Vb, *Gb, *Ub;
    float *o_kp, *o_vp, *o_ks, *o_vs, *o_cp, *o_cs; float* kmean;
    template <bool GUARD>
    __device__ __forceinline__ void run(const f32x4 (&acc)[2][2][4][2], const Unit& u, int wr, int wc, int fr, int fq) const {
        const int pn = u.pn, typ = pn >> 2, rbase = u.pm * BM + wr * 64 + fr;
        float rs[2][4]; load_rstd8<GUARD>(ss, rbase, rs);
        if (typ <= 1) {
            const int head = 2 * (pn & 3) + (wc >> 1), i0 = 32 * (wc & 1) + 8 * fq, colb = head * HD + i0;
            f32x4 cs[2][2];
#pragma unroll
            for (int bj = 0; bj < 2; ++bj) { cs[bj][0] = (f32x4){0.f, 0.f, 0.f, 0.f}; cs[bj][1] = (f32x4){0.f, 0.f, 0.f, 0.f}; }
#pragma unroll
            for (int am = 0; am < 4; ++am) {
                const int ai = am >> 1;
                f32x4 c4[2][2], s4[2][2];
#pragma unroll
                for (int mm = 0; mm < 2; ++mm) { const int m = (am & 1) * 2 + mm, row = rbase + ai * HALF + m * 16;
                    const int pidx = row < MP ? (row & (SEQ - 1)) : SEQ + ((row - MP) & (DS - 1));
#pragma unroll
                    for (int n = 0; n < 2; ++n) { c4[mm][n] = *(const f32x4*)(cosT + pidx * 64 + i0 + 4 * n); s4[mm][n] = *(const f32x4*)(sinT + pidx * 64 + i0 + 4 * n); } }
#pragma unroll
                for (int mm = 0; mm < 2; ++mm) {
                    const int m = (am & 1) * 2 + mm, row = rbase + ai * HALF + m * 16;
                    if (!GUARD || row < MV) {
                        const float rstd = rs[ai][m];
                        f32x4 o1[2], o2[2];
#pragma unroll
                        for (int n = 0; n < 2; ++n) { const f32x4 x1 = acc[ai][0][m][n] * rstd, x2 = acc[ai][1][m][n] * rstd;
                            o1[n] = x1 * c4[mm][n] - x2 * s4[mm][n]; o2[n] = x2 * c4[mm][n] + x1 * s4[mm][n]; }
                        bf16_t* dst = (typ == 0 ? Qb : Kb) + (size_t)row * 1024 + colb;
                        *(u32x4*)dst = pack8f(o1[0], o1[1]); *(u32x4*)(dst + 64) = pack8f(o2[0], o2[1]);
                        if (typ == 1) {
                            float* od = ((!GUARD || row < MP) ? o_kp + (size_t)row * 1024 : o_ks + (size_t)(row - MP) * 1024) + colb;
                            if (KV_NT_STORE) { __builtin_nontemporal_store(o1[0], (f32x4*)od); __builtin_nontemporal_store(o1[1], (f32x4*)(od + 4)); __builtin_nontemporal_store(o2[0], (f32x4*)(od + 64)); __builtin_nontemporal_store(o2[1], (f32x4*)(od + 68)); }
                            else { *(f32x4*)od = o1[0]; *(f32x4*)(od + 4) = o1[1]; *(f32x4*)(od + 64) = o2[0]; *(f32x4*)(od + 68) = o2[1]; }
                            cs[0][0] += o1[0]; cs[0][1] += o1[1]; cs[1][0] += o2[0]; cs[1][1] += o2[1];
                        }
                    }
                }
                asm volatile("" ::: "memory");
            }
            if (!GUARD && typ == 1) {
#pragma unroll
                for (int hf = 0; hf < 2; ++hf)
#pragma unroll
                    for (int n = 0; n < 2; ++n)
#pragma unroll
                        for (int e = 0; e < 4; ++e) {
                            float v = cs[hf][n][e];
                            v += __shfl_xor(v, 1); v += __shfl_xor(v, 2); v += __shfl_xor(v, 4); v += __shfl_xor(v, 8);
                            if (fr == 0) atomicAdd(kmean + ((size_t)u.pm * NH + head) * HD + 64 * hf + i0 + 4 * n + e, v);
                        }
            }
        } else if (typ <= 3) {
            const int colb = (pn & 3) * 256 + 32 * wc + 8 * fq;
#pragma unroll
            for (int ai = 0; ai < 2; ++ai)
#pragma unroll
                for (int m = 0; m < 4; ++m) {
                    const int row = rbase + ai * HALF + m * 16;
                    if (!GUARD || row < MV) {
                        const float rstd = rs[ai][m];
#pragma unroll
                        for (int bj = 0; bj < 2; ++bj) {
                            const f32x4 v0 = acc[ai][bj][m][0] * rstd, v1 = acc[ai][bj][m][1] * rstd;
                            *(u32x4*)((typ == 2 ? Vb : Gb) + (size_t)row * 1024 + colb + bj * HALF) = pack8f(v0, v1);
                            if (typ == 2) {
                                float* od = ((!GUARD || row < MP) ? o_vp + (size_t)row * 1024 : o_vs + (size_t)(row - MP) * 1024) + colb + bj * HALF;
                                if (KV_NT_STORE) { __builtin_nontemporal_store(v0, (f32x4*)od); __builtin_nontemporal_store(v1, (f32x4*)(od + 4)); } else { *(f32x4*)od = v0; *(f32x4*)(od + 4) = v1; }
                            }
                        }
                    }
                }
        } else {
            const int ch = (pn - 16) * 128 + 32 * wc + 8 * fq;
#pragma unroll
            for (int ai = 0; ai < 2; ++ai)
#pragma unroll
                for (int m = 0; m < 4; ++m) {
                    const int row = rbase + ai * HALF + m * 16;
                    if (!GUARD || row < MV) {
                        const float rstd = rs[ai][m], r2 = rstd * rstd;
                        const f32x4 u0 = acc[ai][0][m][0] * acc[ai][1][m][0] * r2, u1 = acc[ai][0][m][1] * acc[ai][1][m][1] * r2;
                        *(u32x4*)(Ub + (size_t)row * 1024 + ch) = pack8f(u0, u1);
                        if (!GUARD) { const int t = row & (SEQ - 1);
                            if (t >= SEQ - 2) { float* od = o_cp + ((size_t)(row >> 12) * 2 + (t - (SEQ - 2))) * CC + ch; *(f32x4*)od = u0; *(f32x4*)(od + 4) = u1; } }
                        else { const int t = (row - MP) & (DS - 1);
                            if (t >= DS - 2) { float* od = o_cs + ((size_t)((row - MP) >> 2) * 2 + (t - (DS - 2))) * CC + ch; *(f32x4*)od = u0; *(f32x4*)(od + 4) = u1; } }
                    }
                }
        }
    }
};

__device__ __forceinline__ int rcol(int pn, int wc, int bj, int fq) { return pn * BM + 64 * wc + 32 * bj + 8 * fq; }
__device__ __forceinline__ f32x4 bflo4(const u32x4 w) { return (f32x4){__uint_as_float(w.x << 16), __uint_as_float(w.x & 0xffff0000u), __uint_as_float(w.y << 16), __uint_as_float(w.y & 0xffff0000u)}; }
__device__ __forceinline__ f32x4 bfhi4(const u32x4 w) { return (f32x4){__uint_as_float(w.z << 16), __uint_as_float(w.z & 0xffff0000u), __uint_as_float(w.w << 16), __uint_as_float(w.w & 0xffff0000u)}; }
struct EpiResid {
    static constexpr bool PERM = true, AFTER_DRAIN = false, ACC_INIT = true;
    bf16_t* XB; unsigned long long* ss; int noat;
    __device__ __forceinline__ void init_load(u32x4 (&raw)[2][4][2], const Unit& u, int wr, int wc, int fr, int fq) const {
        const int rbase = u.pm * BM + wr * 64 + fr;
#pragma unroll
        for (int ai = 0; ai < 2; ++ai)
#pragma unroll
            for (int m = 0; m < 4; ++m)
#pragma unroll
                for (int bj = 0; bj < 2; ++bj) raw[ai][m][bj] = *(const u32x4*)(XB + (size_t)(rbase + ai * HALF + m * 16) * DM + rcol(u.pn, wc, bj, fq));
    }
    __device__ __forceinline__ void init_acc(f32x4 (&acc)[2][2][4][2], const u32x4 (&raw)[2][4][2]) const {
#pragma unroll
        for (int ai = 0; ai < 2; ++ai)
#pragma unroll
            for (int m = 0; m < 4; ++m)
#pragma unroll
                for (int bj = 0; bj < 2; ++bj) { acc[ai][bj][m][0] = bflo4(raw[ai][m][bj]); acc[ai][bj][m][1] = bfhi4(raw[ai][m][bj]); }
    }
    __device__ __forceinline__ void run_narrow(const f32x4 (&v)[2], int pn, int wc, int bj, int n, int fr, int fq) const {
        const int col0 = rcol(pn, wc, bj, fq) + 4 * n;
        u32x2 xo[2];
#pragma unroll
        for (int m = 0; m < 2; ++m) xo[m] = *(const u32x2*)(XB + (size_t)(MP + 16 * m + fr) * DM + col0);
#pragma unroll
        for (int m = 0; m < 2; ++m) {
            const int row = MP + 16 * m + fr;
            const f32x4 a0 = (f32x4){__uint_as_float(xo[m].x << 16), __uint_as_float(xo[m].x & 0xffff0000u), __uint_as_float(xo[m].y << 16), __uint_as_float(xo[m].y & 0xffff0000u)} + v[m];
            float part = (a0[0] * a0[0] + a0[1] * a0[1]) + (a0[2] * a0[2] + a0[3] * a0[3]);
            *(u32x2*)(XB + (size_t)row * DM + col0) = pack4f(a0);
            part += __shfl_xor(part, 16); part += __shfl_xor(part, 32);
            if (fq == 0) atomicAdd(ss + row, (unsigned long long)(part * SS_SCALE + 0.5f));
        }
    }
    template <bool GUARD>
    __device__ __forceinline__ void run(const f32x4 (&acc)[2][2][4][2], const Unit& u, int wr, int wc, int fr, int fq) const {
        const int rbase = u.pm * BM + wr * 64 + fr;
        u32x4 xo[2][4][2];
#pragma unroll
        for (int ai = 0; ai < 2; ++ai)
#pragma unroll
            for (int m = 0; m < 4; ++m) {
                const int row = rbase + ai * HALF + m * 16;
#pragma unroll
                for (int bj = 0; bj < 2; ++bj) xo[ai][m][bj] = (GUARD && row < MV) ? *(const u32x4*)(XB + (size_t)row * DM + rcol(u.pn, wc, bj, fq)) : (u32x4){0u, 0u, 0u, 0u};
            }
        asm volatile("" ::: "memory");
#pragma unroll
        for (int ai = 0; ai < 2; ++ai)
#pragma unroll
            for (int m = 0; m < 4; ++m) {
                const int row = rbase + ai * HALF + m * 16;
                float part = 0.f;
                if (!GUARD || row < MV) {
#pragma unroll
                    for (int bj = 0; bj < 2; ++bj) {
                        const f32x4 a0 = GUARD ? bflo4(xo[ai][m][bj]) + acc[ai][bj][m][0] : acc[ai][bj][m][0];
                        const f32x4 a1 = GUARD ? bfhi4(xo[ai][m][bj]) + acc[ai][bj][m][1] : acc[ai][bj][m][1];
                        part += (a0[0] * a0[0] + a0[1] * a0[1]) + (a0[2] * a0[2] + a0[3] * a0[3]) + (a1[0] * a1[0] + a1[1] * a1[1]) + (a1[2] * a1[2] + a1[3] * a1[3]);
                        if (XB_WT_STORE) store16_wt(XB + (size_t)row * DM + rcol(u.pn, wc, bj, fq), pack8f(a0, a1)); else *(u32x4*)(XB + (size_t)row * DM + rcol(u.pn, wc, bj, fq)) = pack8f(a0, a1);
                    }
                }
                part += __shfl_xor(part, 16); part += __shfl_xor(part, 32);
                if (fq == 0 && (!GUARD || row < MV)) { if (!noat) atomicAdd(ss + row, (unsigned long long)(part * SS_SCALE + 0.5f)); else if (part < 0.f) ss[row] = 1ull; }
            }
    }
};

struct EpiSwiGLU {
    static constexpr bool PERM = true, AFTER_DRAIN = false, ACC_INIT = false;
    const unsigned long long* ss; bf16_t* H;
    template <bool GUARD>
    __device__ __forceinline__ void run_half(const f32x4 (&acc)[2][2][4][2], const Unit& u, int wr, int wc, int fr, int fq) const {
        const int rbase = u.pm * BM + u.half * HALF + wr * 64 + fr, col0 = u.pn * HALF + 32 * wc + 8 * fq;
        unsigned long long s[4];
#pragma unroll
        for (int m = 0; m < 4; ++m) s[m] = ss[rbase + m * 16];
#pragma unroll
        for (int m = 0; m < 4; ++m) {
            const int row = rbase + m * 16; const float rstd = ss_to_rstd(s[m]);
            f32x4 h[2];
#pragma unroll
            for (int n = 0; n < 2; ++n)
#pragma unroll
                for (int e = 0; e < 4; ++e) { const float g = acc[0][0][m][n][e] * rstd, up = acc[0][1][m][n][e] * rstd;
                    h[n][e] = g * up * __builtin_amdgcn_rcpf(1.0f + __expf(-g)); }
            *(u32x4*)(H + ((size_t)(col0 >> 6) * MPAD + row) * 64 + (col0 & 63)) = pack8f(h[0], h[1]);
        }
    }
    template <bool GUARD>
    __device__ __forceinline__ void run(const f32x4 (&acc)[2][2][4][2], const Unit& u, int wr, int wc, int fr, int fq) const {
        const int rbase = u.pm * BM + wr * 64 + fr, col0 = u.pn * HALF + 32 * wc + 8 * fq;
        float rs[2][4]; load_rstd8<GUARD>(ss, rbase, rs);
#pragma unroll
        for (int ai = 0; ai < 2; ++ai)
#pragma unroll
            for (int m = 0; m < 4; ++m) {
                const int row = rbase + ai * HALF + m * 16;
                if (!GUARD || row < MV) {
                    const float rstd = rs[ai][m];
                    f32x4 h[2];
#pragma unroll
                    for (int n = 0; n < 2; ++n)
#pragma unroll
                        for (int e = 0; e < 4; ++e) { const float g = acc[ai][0][m][n][e] * rstd, up = acc[ai][1][m][n][e] * rstd;
                            h[n][e] = g * up * __builtin_amdgcn_rcpf(1.0f + __expf(-g)); }
                    *(u32x4*)(H + ((size_t)(col0 >> 6) * MPAD + row) * 64 + (col0 & 63)) = pack8f(h[0], h[1]);
                }
            }
    }
};

struct EpiFinal {
    static constexpr bool PERM = true, AFTER_DRAIN = true, ACC_INIT = true;
    const bf16_t* XB; unsigned long long* ss; const float* gfin; float* out; unsigned* cnt; unsigned* tmo;
    __device__ __forceinline__ bool wait_count(unsigned* c, unsigned want, int lane) const {
        unsigned sp = 0;
        while ((unsigned)__builtin_amdgcn_readfirstlane(__hip_atomic_load(c, __ATOMIC_RELAXED, __HIP_MEMORY_SCOPE_AGENT)) < want) {
            __builtin_amdgcn_s_sleep(1);
            if ((++sp & 255u) == 0u) { if (__hip_atomic_load(tmo, __ATOMIC_RELAXED, __HIP_MEMORY_SCOPE_AGENT)) return false;
                if (sp > (1u << 22)) { if (lane == 0) __hip_atomic_store(tmo, 1u, __ATOMIC_RELAXED, __HIP_MEMORY_SCOPE_AGENT); return false; } }
        }
        return true;
    }
    __device__ __forceinline__ void init_load(u32x4 (&raw)[2][4][2], const Unit& u, int wr, int wc, int fr, int fq) const {
        const int rbase = u.pm * BM + wr * 64 + fr;
#pragma unroll
        for (int ai = 0; ai < 2; ++ai)
#pragma unroll
            for (int m = 0; m < 4; ++m)
#pragma unroll
                for (int bj = 0; bj < 2; ++bj) raw[ai][m][bj] = *(const u32x4*)(XB + (size_t)(rbase + ai * HALF + m * 16) * DM + rcol(u.pn, wc, bj, fq));
    }
    __device__ __forceinline__ void init_acc(f32x4 (&acc)[2][2][4][2], const u32x4 (&raw)[2][4][2]) const {
#pragma unroll
        for (int ai = 0; ai < 2; ++ai)
#pragma unroll
            for (int m = 0; m < 4; ++m)
#pragma unroll
                for (int bj = 0; bj < 2; ++bj) { acc[ai][bj][m][0] = bflo4(raw[ai][m][bj]); acc[ai][bj][m][1] = bfhi4(raw[ai][m][bj]); }
    }
    __device__ __forceinline__ void sumsq4(const f32x4 (&v)[2][4][2], int rbase, int fq) const {
#pragma unroll
        for (int m = 0; m < 4; ++m) {
            float part = 0.f;
#pragma unroll
            for (int bj = 0; bj < 2; ++bj) { const f32x4 a0 = v[bj][m][0], a1 = v[bj][m][1];
                part += (a0[0] * a0[0] + a0[1] * a0[1]) + (a0[2] * a0[2] + a0[3] * a0[3]) + (a1[0] * a1[0] + a1[1] * a1[1]) + (a1[2] * a1[2] + a1[3] * a1[3]); }
            part += __shfl_xor(part, 16); part += __shfl_xor(part, 32);
            if (fq == 0) atomicAdd(ss + rbase + m * 16, (unsigned long long)(part * SS_SCALE + 0.5f));
        }
    }
    template <int NM>
    __device__ __forceinline__ void write_y(const f32x4 (&v)[2][4][2], int rbase, int pn, int wc, int fq, bool bad) const {
        unsigned long long s[NM];
#pragma unroll
        for (int m = 0; m < NM; ++m) s[m] = __hip_atomic_load(ss + rbase + m * 16, __ATOMIC_RELAXED, __HIP_MEMORY_SCOPE_AGENT);
        f32x4 g[2][2];
#pragma unroll
        for (int bj = 0; bj < 2; ++bj)
#pragma unroll
            for (int n = 0; n < 2; ++n) g[bj][n] = *(const f32x4*)(gfin + rcol(pn, wc, bj, fq) + 4 * n);
        const float qnan = __builtin_nanf("");
#pragma unroll
        for (int m = 0; m < NM; ++m) {
            const float rstd = bad ? qnan : ss_to_rstd(s[m]);
            float* dst = out + (size_t)(rbase + m * 16) * DM;
#pragma unroll
            for (int bj = 0; bj < 2; ++bj)
#pragma unroll
                for (int n = 0; n < 2; ++n) *(f32x4*)(dst + rcol(pn, wc, bj, fq) + 4 * n) = v[bj][m][n] * rstd * g[bj][n];
        }
    }
    __device__ __forceinline__ void fused(f32x4 (&acc)[2][2][4][2], const Unit& u, int wr, int wc, int fr, int fq, PG8_LAS unsigned char* lds, int wid, int lane) const {
        const int rbase = u.pm * BM + wr * 64 + fr;
        sumsq4(acc[0], rbase, fq);
        sumsq4(acc[1], rbase + HALF, fq);
        asm volatile("s_waitcnt vmcnt(0)" ::: "memory");
        if (lane == 0) __hip_atomic_fetch_add(cnt + 64 * u.pm, 1u, __ATOMIC_RELAXED, __HIP_MEMORY_SCOPE_AGENT);
        PG8_LAS unsigned* flag = (PG8_LAS unsigned*)lds;
        if (wid == 0) { const bool ok = wait_count(cnt + 64 * u.pm, 64u, lane); __builtin_amdgcn_fence(__ATOMIC_ACQUIRE, "agent"); if (lane == 0) flag[0] = ok ? 0u : 1u; }
        asm volatile("s_waitcnt vmcnt(0) lgkmcnt(0)" ::: "memory"); __builtin_amdgcn_s_barrier(); asm volatile("" ::: "memory");
        const bool bad = flag[0] != 0u;
        write_y<4>(acc[0], rbase, u.pn, wc, fq, bad);
        write_y<4>(acc[1], rbase + HALF, u.pn, wc, fq, bad);
    }
    __device__ __forceinline__ void run_narrow(const f32x4 (&v)[2], int pn, int wc, int bj, int n, int fr, int fq) const {
        const int col0 = rcol(pn, wc, bj, fq) + 4 * n, lane = fq * 16 + fr;
        u32x2 xo[2]; f32x4 x[2];
#pragma unroll
        for (int m = 0; m < 2; ++m) xo[m] = *(const u32x2*)(XB + (size_t)(MP + 16 * m + fr) * DM + col0);
#pragma unroll
        for (int m = 0; m < 2; ++m) {
            x[m] = (f32x4){__uint_as_float(xo[m].x << 16), __uint_as_float(xo[m].x & 0xffff0000u), __uint_as_float(xo[m].y << 16), __uint_as_float(xo[m].y & 0xffff0000u)} + v[m];
            float part = (x[m][0] * x[m][0] + x[m][1] * x[m][1]) + (x[m][2] * x[m][2] + x[m][3] * x[m][3]);
            part += __shfl_xor(part, 16); part += __shfl_xor(part, 32);
            if (fq == 0) atomicAdd(ss + MP + 16 * m + fr, (unsigned long long)(part * SS_SCALE + 0.5f));
        }
        asm volatile("s_waitcnt vmcnt(0)" ::: "memory");
        if (lane == 0) __hip_atomic_fetch_add(cnt + 64 * (MP / BM), 1u, __ATOMIC_RELAXED, __HIP_MEMORY_SCOPE_AGENT);
        const bool ok = wait_count(cnt + 64 * (MP / BM), (unsigned)(DM / BM * 16), lane);
        __builtin_amdgcn_fence(__ATOMIC_ACQUIRE, "agent");
        asm volatile("s_waitcnt vmcnt(0)" ::: "memory");
        const f32x4 g4 = *(const f32x4*)(gfin + col0); const float qnan = __builtin_nanf("");
#pragma unroll
        for (int m = 0; m < 2; ++m) {
            const unsigned long long sv = __hip_atomic_load(ss + MP + 16 * m + fr, __ATOMIC_RELAXED, __HIP_MEMORY_SCOPE_AGENT);
            const float rstd = ok ? ss_to_rstd(sv) : qnan;
            *(f32x4*)(out + (size_t)(MP + 16 * m + fr) * DM + col0) = x[m] * rstd * g4;
        }
    }
};
template <class Epi, class Sched, bool ALIGN_EPI = false, bool SP2 = false>
__device__ __forceinline__ void gemm_phase(PG8_LAS unsigned char* lds, const Gemm g, const Sched& S, const Epi& E, const int wv  ) {
    int tid = wv * 64 + (int)__builtin_amdgcn_mbcnt_hi(~0u, __builtin_amdgcn_mbcnt_lo(~0u, 0u)); asm volatile("" : "+v"(tid));
    const int wid = wv, lane = tid & 63, wr = wid >> 2, wc = wid & 3, fr = lane & 15, fq = lane >> 4;
    static_assert(SP2 || !Epi::ACC_INIT, "accumulator initialisation from the epilogue's addend is wired into the SP2 prologue only");
    const int K = g.K, nt = K / BK;
    unsigned voffA[2], voffB[2];
#pragma unroll
    for (int i = 0; i < 2; ++i) { int R, C; stage_rc(tid * 16 + i * 8192, R, C); const int Rb = Epi::PERM ? ((R & ~31) + perm32(R & 31)) : R;
        voffA[i] = (unsigned)(R * g.lda + C) * 2u; voffB[i] = (unsigned)(Rb * g.ldb + C) * 2u; }
    const size_t kstepA = g.kstepA, kstepB = g.kstepB;
    const size_t hstepA = (size_t)HALF * g.lda * 2, hstepB = (size_t)HALF * g.ldb * 2;
    const size_t tstepA = 2 * hstepA, tstepB = 2 * hstepB;
    const unsigned ldsw = (unsigned)wid * 1024u;
    const int aoff = lds_byte(wr * 64 + fr, fq * 8), boff = lds_byte(wc * 32 + fr, fq * 8);
#define PG8_SA(b, h) (((b) * 2 + (h)) * HTB)
#define PG8_SB(b, h) ((4 + (b) * 2 + (h)) * HTB)
#define PG8_STAGE_AUX(bufoff, gbase, voff, aux) do { _Pragma("unroll") for (int _i = 0; _i < 2; ++_i) \
        __builtin_amdgcn_global_load_lds((const unsigned*)((const char*)(gbase) + (voff)[_i]), (PG8_LAS unsigned*)(lds + (bufoff) + ldsw + _i * 8192), 16, 0, aux); } while (0)
#define PG8_STAGE(bufoff, gbase, voff) PG8_STAGE_AUX(bufoff, gbase, voff, GEMM_A_AUX)
#define PG8_STAGEB(bufoff, gbase, voff) PG8_STAGE_AUX(bufoff, gbase, voff, GEMM_B_AUX)
#define PG8_LDA(dst, b, h) do { _Pragma("unroll") for (int m = 0; m < 4; ++m) _Pragma("unroll") for (int k = 0; k < 2; ++k) dst[m][k] = *(const PG8_LAS bf16x8*)(lds + PG8_SA(b, h) + aoff + m * 2048 + k * 1024); } while (0)
#define PG8_LDB(dst, b, h) do { _Pragma("unroll") for (int n = 0; n < 2; ++n) _Pragma("unroll") for (int k = 0; k < 2; ++k) dst[n][k] = *(const PG8_LAS bf16x8*)(lds + PG8_SB(b, h) + boff + n * 2048 + k * 1024); } while (0)
#define PG8_MMA(ai, bj, At, Bt) do { __builtin_amdgcn_s_setprio(1); _Pragma("unroll") for (int m = 0; m < 4; ++m) _Pragma("unroll") for (int n = 0; n < 2; ++n) _Pragma("unroll") for (int k = 0; k < 2; ++k) \
        acc[ai][bj][m][n] = __builtin_amdgcn_mfma_f32_16x16x32_bf16(Bt[n][k], At[m][k], acc[ai][bj][m][n], 0, 0, 0); __builtin_amdgcn_s_setprio(0); } while (0)
#define PG8_WAIT_V(n) asm volatile("s_waitcnt vmcnt(" #n ")" ::: "memory")
#define PG8_WAIT_L(n) asm volatile("s_waitcnt lgkmcnt(" #n ")" ::: "memory")
#define PG8_BAR __builtin_amdgcn_s_barrier()
#define PG8_SCHED __builtin_amdgcn_sched_barrier(0)
    Unit cur, nxt; int ui = 0;
    if (!S.next(0, cur)) return;
    f32x4 acc[2][2][4][2];
#pragma unroll
    for (int a = 0; a < 2; ++a)
#pragma unroll
        for (int b = 0; b < 2; ++b)
#pragma unroll
            for (int m = 0; m < 4; ++m)
#pragma unroll
                for (int n = 0; n < 2; ++n) acc[a][b][m][n] = (f32x4){0.f, 0.f, 0.f, 0.f};
    bf16x8 At[4][2], B0[2][2], B1[2][2];
    const char* cA = (const char*)g.A + (size_t)cur.pm * tstepA + (size_t)(cur.pn >> g.gshift) * g.gstride; const char* cB = (const char*)g.Bt + (size_t)cur.pn * tstepB;
    S.a_ready(cur);
    if constexpr (SP2) {
        PG8_STAGEB(PG8_SB(0, 0), cB, voffB); PG8_STAGEB(PG8_SB(0, 1), cB + hstepB, voffB); PG8_STAGE(PG8_SA(0, 0), cA, voffA); PG8_STAGE(PG8_SA(0, 1), cA + hstepA, voffA);
        if constexpr (Epi::ACC_INIT) {
            u32x4 raw[2][4][2];
            E.init_load(raw, cur, wr, wc, fr, fq);
            if (wr == 1) PG8_BAR;
            PG8_WAIT_V(18); PG8_BAR;
            PG8_STAGEB(PG8_SB(1, 0), cB + kstepB, voffB); PG8_STAGE(PG8_SA(1, 0), cA + kstepA, voffA); PG8_STAGEB(PG8_SB(1, 1), cB + hstepB + kstepB, voffB);
            PG8_WAIT_V(6); PG8_BAR;
            E.init_acc(acc, raw);
        } else {
        if (wr == 1) PG8_BAR;
        PG8_WAIT_V(2); PG8_BAR;
        PG8_STAGEB(PG8_SB(1, 0), cB + kstepB, voffB); PG8_STAGE(PG8_SA(1, 0), cA + kstepA, voffA); PG8_STAGEB(PG8_SB(1, 1), cB + hstepB + kstepB, voffB);
        PG8_WAIT_V(6); PG8_BAR;
        }
    } else {
        PG8_STAGEB(PG8_SB(0, 0), cB, voffB); PG8_STAGE(PG8_SA(0, 0), cA, voffA); PG8_STAGEB(PG8_SB(0, 1), cB + hstepB, voffB); PG8_STAGE(PG8_SA(0, 1), cA + hstepA, voffA);
        if (wr == 1) PG8_BAR;
        PG8_WAIT_V(4); PG8_BAR;
        PG8_STAGEB(PG8_SB(1, 0), cB + kstepB, voffB); PG8_STAGE(PG8_SA(1, 0), cA + kstepA, voffA); PG8_STAGEB(PG8_SB(1, 1), cB + hstepB + kstepB, voffB);
        PG8_WAIT_V(6); PG8_BAR;
    }
    for (;;) {
        const bool has_next = S.next(ui + 1, nxt);
        const char* nA = has_next ? (const char*)g.A + (size_t)nxt.pm * tstepA + (size_t)(nxt.pn >> g.gshift) * g.gstride : cA; const char* nB = has_next ? (const char*)g.Bt + (size_t)nxt.pn * tstepB : cB;
        for (int t = 0; t < nt; t += 2) {
            const bool last = (t == nt - 2);
            const char* a1 = cA + (size_t)(t + 1) * kstepA;
            const char* a2 = last ? nA : cA + (size_t)(t + 2) * kstepA; const char* b2 = last ? nB : cB + (size_t)(t + 2) * kstepB;
            const char* a3 = a2 + kstepA; const char* b3 = b2 + kstepB;
            if (last && has_next) S.a_ready(nxt);
            if constexpr (SP2) {
            PG8_LDB(B0, 0, 0); PG8_LDB(B1, 0, 1); PG8_SCHED; PG8_LDA(At, 0, 0); PG8_STAGE(PG8_SA(1, 1), a1 + hstepA, voffA);
            PG8_WAIT_V(8); PG8_WAIT_L(0); PG8_BAR; PG8_MMA(0, 0, At, B0); PG8_MMA(0, 1, At, B1); PG8_BAR; PG8_SCHED;
            PG8_LDA(At, 0, 1); PG8_STAGEB(PG8_SB(0, 0), b2, voffB); PG8_STAGEB(PG8_SB(0, 1), b2 + hstepB, voffB); PG8_STAGE(PG8_SA(0, 0), a2, voffA);
            PG8_WAIT_V(8); PG8_WAIT_L(0); PG8_BAR; PG8_MMA(1, 0, At, B0); PG8_MMA(1, 1, At, B1); PG8_BAR; PG8_SCHED;
            PG8_LDB(B0, 1, 0); PG8_LDB(B1, 1, 1); PG8_SCHED; PG8_LDA(At, 1, 0); PG8_STAGE(PG8_SA(0, 1), a2 + hstepA, voffA);
            PG8_WAIT_V(8); PG8_WAIT_L(0); PG8_BAR; PG8_MMA(0, 0, At, B0); PG8_MMA(0, 1, At, B1); PG8_BAR; PG8_SCHED;
            PG8_LDA(At, 1, 1); PG8_STAGEB(PG8_SB(1, 0), b3, voffB); PG8_STAGEB(PG8_SB(1, 1), b3 + hstepB, voffB); PG8_STAGE(PG8_SA(1, 0), a3, voffA);
            PG8_WAIT_V(8); PG8_WAIT_L(0); PG8_BAR; PG8_MMA(1, 0, At, B0); PG8_MMA(1, 1, At, B1); PG8_BAR; PG8_SCHED;
            } else {
            PG8_LDB(B0, 0, 0); PG8_SCHED; PG8_LDA(At, 0, 0); PG8_STAGE(PG8_SA(1, 1), a1 + hstepA, voffA);
            PG8_WAIT_L(8); PG8_BAR; PG8_WAIT_L(0); PG8_MMA(0, 0, At, B0); PG8_BAR; PG8_SCHED;
            PG8_LDB(B1, 0, 1); PG8_STAGEB(PG8_SB(0, 0), b2, voffB);
            PG8_BAR; PG8_WAIT_L(0); PG8_MMA(0, 1, At, B1); PG8_BAR;
            PG8_LDA(At, 0, 1); PG8_STAGE(PG8_SA(0, 0), a2, voffA);
            PG8_BAR; PG8_WAIT_L(0); PG8_MMA(1, 0, At, B0); PG8_BAR; PG8_SCHED;
            PG8_STAGEB(PG8_SB(0, 1), b2 + hstepB, voffB);
            PG8_WAIT_V(6); PG8_BAR; PG8_MMA(1, 1, At, B1); PG8_BAR;
            PG8_LDB(B0, 1, 0); PG8_SCHED; PG8_LDA(At, 1, 0); PG8_STAGE(PG8_SA(0, 1), a2 + hstepA, voffA);
            PG8_WAIT_L(8); PG8_BAR; PG8_WAIT_L(0); PG8_MMA(0, 0, At, B0); PG8_BAR; PG8_SCHED;
            PG8_LDB(B1, 1, 1); PG8_STAGEB(PG8_SB(1, 0), b3, voffB);
            PG8_BAR; PG8_WAIT_L(0); PG8_MMA(0, 1, At, B1); PG8_BAR;
            PG8_LDA(At, 1, 1); PG8_STAGE(PG8_SA(1, 0), a3, voffA);
            PG8_BAR; PG8_WAIT_L(0); PG8_MMA(1, 0, At, B0); PG8_BAR; PG8_SCHED;
            PG8_STAGEB(PG8_SB(1, 1), b3 + hstepB, voffB);
            PG8_WAIT_V(6); PG8_BAR; PG8_MMA(1, 1, At, B1); PG8_BAR;
            }
        }
        if constexpr (ALIGN_EPI) { if (wr == 0) PG8_BAR; }
        if constexpr (!Epi::AFTER_DRAIN) { E.template run<false>(acc, cur, wr, wc, fr, fq); S.done(cur); }
        if (!has_next) break;
#pragma unroll
        for (int a = 0; a < 2; ++a)
#pragma unroll
            for (int b = 0; b < 2; ++b)
#pragma unroll
                for (int m = 0; m < 4; ++m)
#pragma unroll
                    for (int n = 0; n < 2; ++n) acc[a][b][m][n] = (f32x4){0.f, 0.f, 0.f, 0.f};
        cur = nxt; cA = nA; cB = nB; ++ui;
        if constexpr (Epi::ACC_INIT) { u32x4 raw[2][4][2]; E.init_load(raw, cur, wr, wc, fr, fq); E.init_acc(acc, raw); }
        if constexpr (ALIGN_EPI) { if (wr == 1) PG8_BAR; }
    }
    PG8_WAIT_V(0);
    if constexpr (!ALIGN_EPI) { if (wr == 0) PG8_BAR; }
    PG8_BAR;
    if constexpr (Epi::AFTER_DRAIN) { E.fused(acc, cur, wr, wc, fr, fq, lds, wid, lane); S.done(cur); }
#undef PG8_SA
#undef PG8_SB
#undef PG8_STAGE
#undef PG8_STAGEB
#undef PG8_STAGE_AUX
#undef PG8_LDA
#undef PG8_LDB
#undef PG8_MMA
#undef PG8_WAIT_V
#undef PG8_WAIT_L
#undef PG8_BAR
#undef PG8_SCHED
}

struct HalfOrder {
    StaticOrder so; long L; int half;
    __device__ __forceinline__ bool next(int i, Unit& u) const { if (i > 0) return false; so.map(L, u); u.half = half; return true; }
    __device__ __forceinline__ void a_ready(const Unit&) const {}
    __device__ __forceinline__ void done(const Unit&) const {}
};
template <class Epi, class Sched>
__device__ __forceinline__ void gemm_phase_hm(PG8_LAS unsigned char* lds, const Gemm g, const Sched& S, const Epi& E, const int wv) {
    int tid = wv * 64 + (int)__builtin_amdgcn_mbcnt_hi(~0u, __builtin_amdgcn_mbcnt_lo(~0u, 0u)); asm volatile("" : "+v"(tid));
    const int wid = wv, lane = tid & 63, wr = wid >> 2, wc = wid & 3, fr = lane & 15, fq = lane >> 4;
    const int K = g.K, nt = K / BK;
    unsigned voffA[2], voffB[2];
#pragma unroll
    for (int i = 0; i < 2; ++i) { int R, C; stage_rc(tid * 16 + i * 8192, R, C); const int Rb = Epi::PERM ? ((R & ~31) + perm32(R & 31)) : R;
        voffA[i] = (unsigned)(R * g.lda + C) * 2u; voffB[i] = (unsigned)(Rb * g.ldb + C) * 2u; }
    const size_t kstepA = g.kstepA, kstepB = g.kstepB;
    const size_t hstepA = (size_t)HALF * g.lda * 2, hstepB = (size_t)HALF * g.ldb * 2;
    const size_t tstepA = 2 * hstepA, tstepB = 2 * hstepB;
    const unsigned ldsw = (unsigned)wid * 1024u;
    const int aoff = lds_byte(wr * 64 + fr, fq * 8), boff = lds_byte(wc * 32 + fr, fq * 8);
#define PG8_SA(b, h) (((b) * 2 + (h)) * HTB)
#define PG8_SB(b, h) ((4 + (b) * 2 + (h)) * HTB)
#define PG8_STAGE(bufoff, gbase, voff) do { _Pragma("unroll") for (int _i = 0; _i < 2; ++_i) \
        __builtin_amdgcn_global_load_lds((const unsigned*)((const char*)(gbase) + (voff)[_i]), (PG8_LAS unsigned*)(lds + (bufoff) + ldsw + _i * 8192), 16, 0, 0); } while (0)
#define PG8_LDA(dst, b, h) do { _Pragma("unroll") for (int m = 0; m < 4; ++m) _Pragma("unroll") for (int k = 0; k < 2; ++k) dst[m][k] = *(const PG8_LAS bf16x8*)(lds + PG8_SA(b, h) + aoff + m * 2048 + k * 1024); } while (0)
#define PG8_LDB(dst, b, h) do { _Pragma("unroll") for (int n = 0; n < 2; ++n) _Pragma("unroll") for (int k = 0; k < 2; ++k) dst[n][k] = *(const PG8_LAS bf16x8*)(lds + PG8_SB(b, h) + boff + n * 2048 + k * 1024); } while (0)
#define PG8_MMA(ai, bj, At, Bt) do { __builtin_amdgcn_s_setprio(1); _Pragma("unroll") for (int m = 0; m < 4; ++m) _Pragma("unroll") for (int n = 0; n < 2; ++n) _Pragma("unroll") for (int k = 0; k < 2; ++k) \
        acc[ai][bj][m][n] = __builtin_amdgcn_mfma_f32_16x16x32_bf16(Bt[n][k], At[m][k], acc[ai][bj][m][n], 0, 0, 0); __builtin_amdgcn_s_setprio(0); } while (0)
#define PG8_WAIT_V(n) asm volatile("s_waitcnt vmcnt(" #n ")" ::: "memory")
#define PG8_WAIT_L(n) asm volatile("s_waitcnt lgkmcnt(" #n ")" ::: "memory")
#define PG8_BAR __builtin_amdgcn_s_barrier()
#define PG8_SCHED __builtin_amdgcn_sched_barrier(0)
    Unit cur, nxt; int ui = 0;
    if (!S.next(0, cur)) return;
    f32x4 acc[2][2][4][2];
#pragma unroll
    for (int a = 0; a < 2; ++a)
#pragma unroll
        for (int b = 0; b < 2; ++b)
#pragma unroll
            for (int m = 0; m < 4; ++m)
#pragma unroll
                for (int n = 0; n < 2; ++n) acc[a][b][m][n] = (f32x4){0.f, 0.f, 0.f, 0.f};
    bf16x8 At[4][2], B0[2][2], B1[2][2];
    const char* cA = (const char*)g.A + (size_t)cur.pm * tstepA + (size_t)cur.half * hstepA + (size_t)(cur.pn >> g.gshift) * g.gstride; const char* cB = (const char*)g.Bt + (size_t)cur.pn * tstepB;
    PG8_STAGE(PG8_SB(0, 0), cB, voffB); PG8_STAGE(PG8_SB(0, 1), cB + hstepB, voffB); PG8_STAGE(PG8_SA(0, 0), cA, voffA);
    if (wr == 1) PG8_BAR;
    PG8_WAIT_V(0); PG8_BAR;
    PG8_STAGE(PG8_SB(1, 0), cB + kstepB, voffB); PG8_STAGE(PG8_SA(1, 0), cA + kstepA, voffA); PG8_STAGE(PG8_SB(1, 1), cB + hstepB + kstepB, voffB);
    PG8_WAIT_V(6); PG8_BAR;
    for (;;) {
        const bool has_next = S.next(ui + 1, nxt);
        const char* nA = has_next ? (const char*)g.A + (size_t)nxt.pm * tstepA + (size_t)nxt.half * hstepA + (size_t)(nxt.pn >> g.gshift) * g.gstride : cA; const char* nB = has_next ? (const char*)g.Bt + (size_t)nxt.pn * tstepB : cB;
        for (int t = 0; t < nt; t += 2) {
            const bool last = (t == nt - 2);
            const char* a2 = last ? nA : cA + (size_t)(t + 2) * kstepA; const char* b2 = last ? nB : cB + (size_t)(t + 2) * kstepB;
            const char* a3 = a2 + kstepA; const char* b3 = b2 + kstepB;
            PG8_LDB(B0, 0, 0); PG8_LDB(B1, 0, 1); PG8_SCHED; PG8_LDA(At, 0, 0);
            PG8_WAIT_V(6); PG8_WAIT_L(0); PG8_BAR; PG8_MMA(0, 0, At, B0); PG8_MMA(0, 1, At, B1); PG8_BAR; PG8_SCHED;
            PG8_STAGE(PG8_SB(0, 0), b2, voffB); PG8_STAGE(PG8_SB(0, 1), b2 + hstepB, voffB); PG8_STAGE(PG8_SA(0, 0), a2, voffA);
            PG8_WAIT_V(6); PG8_WAIT_L(0); PG8_BAR; PG8_BAR; PG8_SCHED;
            PG8_LDB(B0, 1, 0); PG8_LDB(B1, 1, 1); PG8_SCHED; PG8_LDA(At, 1, 0);
            PG8_WAIT_V(6); PG8_WAIT_L(0); PG8_BAR; PG8_MMA(0, 0, At, B0); PG8_MMA(0, 1, At, B1); PG8_BAR; PG8_SCHED;
            PG8_STAGE(PG8_SB(1, 0), b3, voffB); PG8_STAGE(PG8_SB(1, 1), b3 + hstepB, voffB); PG8_STAGE(PG8_SA(1, 0), a3, voffA);
            PG8_WAIT_V(6); PG8_WAIT_L(0); PG8_BAR; PG8_BAR; PG8_SCHED;
        }
        if (wr == 0) PG8_BAR;
        E.template run_half<false>(acc, cur, wr, wc, fr, fq); S.done(cur);
        if (!has_next) break;
#pragma unroll
        for (int b = 0; b < 2; ++b)
#pragma unroll
            for (int m = 0; m < 4; ++m)
#pragma unroll
                for (int n = 0; n < 2; ++n) acc[0][b][m][n] = (f32x4){0.f, 0.f, 0.f, 0.f};
        cur = nxt; cA = nA; cB = nB; ++ui;
        if (wr == 1) PG8_BAR;
    }
    PG8_WAIT_V(0);
    PG8_BAR;
#undef PG8_SA
#undef PG8_SB
#undef PG8_STAGE
#undef PG8_LDA
#undef PG8_LDB
#undef PG8_MMA
#undef PG8_WAIT_V
#undef PG8_WAIT_L
#undef PG8_BAR
#undef PG8_SCHED
}

__device__ __forceinline__ size_t skinny_koff(int k, size_t kstep) { return kstep == 128 ? (size_t)k * 2 : (size_t)(k >> 6) * kstep + (size_t)(k & 63) * 2; }
template <int NS>
__device__ __forceinline__ void skinny_steps(const char* Ab, const char* Bb, int k0, size_t kstepA, size_t kstepB, size_t a16, size_t b4, size_t b128, f32x4 (&acc)[2][2][2]) {
    bf16x8 a[NS][2], b[NS][2][2];
#pragma unroll
    for (int s = 0; s < NS; ++s) {
        const size_t ka = skinny_koff(k0 + 32 * s, kstepA), kb = skinny_koff(k0 + 32 * s, kstepB);
        a[s][0] = *(const bf16x8*)(Ab + ka); a[s][1] = *(const bf16x8*)(Ab + a16 + ka);
#pragma unroll
        for (int bj = 0; bj < 2; ++bj)
#pragma unroll
            for (int n = 0; n < 2; ++n) b[s][bj][n] = *(const bf16x8*)(Bb + bj * b128 + n * b4 + kb);
    }
#pragma unroll
    for (int s = 0; s < NS; ++s)
#pragma unroll
        for (int bj = 0; bj < 2; ++bj)
#pragma unroll
            for (int m = 0; m < 2; ++m)
#pragma unroll
                for (int n = 0; n < 2; ++n) acc[bj][m][n] = __builtin_amdgcn_mfma_f32_16x16x32_bf16(b[s][bj][n], a[s][m], acc[bj][m][n], 0, 0, 0);
}
template <class Epi>
__device__ __forceinline__ void skinny_phase(PG8_LAS unsigned char* lds, const Gemm g, const Epi& E, int first, int step, const int wv) {
    int tid = wv * 64 + (int)__builtin_amdgcn_mbcnt_hi(~0u, __builtin_amdgcn_mbcnt_lo(~0u, 0u)); asm volatile("" : "+v"(tid));
    const int wid = wv, lane = tid & 63, fr = lane & 15, fq = lane >> 4;
    const int nit = (g.N / BM) * 4, Kw = g.K / 8;
    PG8_LAS f32x4* R = (PG8_LAS f32x4*)lds;
    for (int it = first; it < nit; it += step) {
        const int pn = it >> 2, wc = it & 3;
        const int kw0 = wid * Kw;
        const char* Ab = (const char*)g.A + (size_t)(pn >> g.gshift) * g.gstride + ((size_t)(MP + fr) * g.lda + fq * 8) * 2;
        const char* Bb = (const char*)g.Bt + ((size_t)(pn * BM + 32 * wc + 8 * (fr >> 2) + (fr & 3)) * g.ldb + fq * 8) * 2;
        const size_t a16 = (size_t)16 * g.lda * 2, b4 = (size_t)4 * g.ldb * 2, b128 = (size_t)HALF * g.ldb * 2;
        f32x4 acc[2][2][2];
#pragma unroll
        for (int bj = 0; bj < 2; ++bj)
#pragma unroll
            for (int m = 0; m < 2; ++m)
#pragma unroll
                for (int n = 0; n < 2; ++n) acc[bj][m][n] = (f32x4){0.f, 0.f, 0.f, 0.f};
        int k = 0;
        for (; k + 128 <= Kw; k += 128) skinny_steps<4>(Ab, Bb, kw0 + k, g.kstepA, g.kstepB, a16, b4, b128, acc);
        for (; k + 64 <= Kw; k += 64) skinny_steps<2>(Ab, Bb, kw0 + k, g.kstepA, g.kstepB, a16, b4, b128, acc);
        for (; k < Kw; k += 32) skinny_steps<1>(Ab, Bb, kw0 + k, g.kstepA, g.kstepB, a16, b4, b128, acc);
#pragma unroll
        for (int bj = 0; bj < 2; ++bj)
#pragma unroll
            for (int m = 0; m < 2; ++m)
#pragma unroll
                for (int n = 0; n < 2; ++n) R[(wid * 8 + bj * 4 + m * 2 + n) * 64 + lane] = acc[bj][m][n];
        __syncthreads();
        if (wid == 0) {
            f32x4 accF[2][2][4][2];
#pragma unroll
            for (int ai = 0; ai < 2; ++ai)
#pragma unroll
                for (int bj = 0; bj < 2; ++bj)
#pragma unroll
                    for (int m = 0; m < 4; ++m)
#pragma unroll
                        for (int n = 0; n < 2; ++n) accF[ai][bj][m][n] = (f32x4){0.f, 0.f, 0.f, 0.f};
            f32x4 s8[8];
#pragma unroll
            for (int i = 0; i < 8; ++i) s8[i] = R[i * 64 + lane];
#pragma unroll 1
            for (int w = 1; w < 8; ++w) {
#pragma unroll
                for (int i = 0; i < 8; ++i) s8[i] += R[(w * 8 + i) * 64 + lane];
            }
#pragma unroll
            for (int bj = 0; bj < 2; ++bj)
#pragma unroll
                for (int m = 0; m < 2; ++m)
#pragma unroll
                    for (int n = 0; n < 2; ++n) accF[0][bj][m][n] = s8[bj * 4 + m * 2 + n];
            const Unit u{MP / BM, pn};
            E.template run<true>(accF, u, 0, wc, fr, fq);
        }
        __syncthreads();
    }
}

template <int NS>
__device__ __forceinline__ void narrow_steps(const char* Ab, const char* Bb, int k0, size_t kstepA, size_t kstepB, size_t a16, f32x4 (&acc)[2]) {
    bf16x8 a[NS][2], b[NS];
#pragma unroll
    for (int s = 0; s < NS; ++s) {
        const size_t ka = skinny_koff(k0 + 32 * s, kstepA), kb = skinny_koff(k0 + 32 * s, kstepB);
        a[s][0] = *(const bf16x8*)(Ab + ka); a[s][1] = *(const bf16x8*)(Ab + a16 + ka); b[s] = *(const bf16x8*)(Bb + kb);
    }
#pragma unroll
    for (int s = 0; s < NS; ++s)
#pragma unroll
        for (int m = 0; m < 2; ++m) acc[m] = __builtin_amdgcn_mfma_f32_16x16x32_bf16(b[s], a[s][m], acc[m], 0, 0, 0);
}
template <class Epi>
__device__ __forceinline__ void skinny_phase_narrow(PG8_LAS unsigned char* lds, const Gemm g, const Epi& E, int first, int step, const int wv) {
    int tid = wv * 64 + (int)__builtin_amdgcn_mbcnt_hi(~0u, __builtin_amdgcn_mbcnt_lo(~0u, 0u)); asm volatile("" : "+v"(tid));
    const int wid = wv, lane = tid & 63, fr = lane & 15, fq = lane >> 4;
    const int nit = (g.N / BM) * 16, Kw = g.K / 8;
    PG8_LAS f32x4* R = (PG8_LAS f32x4*)lds;
    for (int it = first; it < nit; it += step) {
        const int pn = it >> 4, wc = (it >> 2) & 3, bj = (it >> 1) & 1, n = it & 1;
        const int kw0 = wid * Kw;
        const char* Ab = (const char*)g.A + (size_t)(pn >> g.gshift) * g.gstride + ((size_t)(MP + fr) * g.lda + fq * 8) * 2;
        const char* Bb = (const char*)g.Bt + ((size_t)(pn * BM + bj * HALF + 32 * wc + 8 * (fr >> 2) + 4 * n + (fr & 3)) * g.ldb + fq * 8) * 2;
        const size_t a16 = (size_t)16 * g.lda * 2;
        f32x4 acc[2] = {(f32x4){0.f, 0.f, 0.f, 0.f}, (f32x4){0.f, 0.f, 0.f, 0.f}};
        int k = 0;
        for (; k + 256 <= Kw; k += 256) narrow_steps<8>(Ab, Bb, kw0 + k, g.kstepA, g.kstepB, a16, acc);
        for (; k + 128 <= Kw; k += 128) narrow_steps<4>(Ab, Bb, kw0 + k, g.kstepA, g.kstepB, a16, acc);
        for (; k + 64 <= Kw; k += 64) narrow_steps<2>(Ab, Bb, kw0 + k, g.kstepA, g.kstepB, a16, acc);
        for (; k < Kw; k += 32) narrow_steps<1>(Ab, Bb, kw0 + k, g.kstepA, g.kstepB, a16, acc);
        R[(wid * 2 + 0) * 64 + lane] = acc[0]; R[(wid * 2 + 1) * 64 + lane] = acc[1];
        __syncthreads();
        if (wid == 0) {
            f32x4 v[2] = {R[lane], R[64 + lane]};
#pragma unroll
            for (int w = 1; w < 8; ++w) { v[0] += R[(w * 2 + 0) * 64 + lane]; v[1] += R[(w * 2 + 1) * 64 + lane]; }
            E.run_narrow(v, pn, wc, bj, n, fr, fq);
        }
        __syncthreads();
    }
}
}
#define GAS __attribute__((address_space(1)))
#define LAS __attribute__((address_space(3)))
typedef unsigned short bf16;
typedef unsigned v4u __attribute__((ext_vector_type(4)));
typedef float f32x4 __attribute__((ext_vector_type(4)));
typedef short bf16x8 __attribute__((ext_vector_type(8)));
typedef GAS unsigned gu32;
typedef GAS unsigned long long gu64;
#define RLX_AGENT __ATOMIC_RELAXED, __HIP_MEMORY_SCOPE_AGENT
#define LDS_WAIT() asm volatile("s_waitcnt lgkmcnt(0)" ::: "memory")
#define VM_WAIT() asm volatile("s_waitcnt vmcnt(0)" ::: "memory")
__device__ __forceinline__ unsigned long long rt() { return __builtin_amdgcn_s_memrealtime(); }
__device__ __forceinline__ int lane_id() { return (int)__builtin_amdgcn_mbcnt_hi(~0u, __builtin_amdgcn_mbcnt_lo(~0u, 0u)); }
__device__ __forceinline__ unsigned f2bf(float f) { unsigned u = __builtin_bit_cast(unsigned, f); return (u + 0x7fffu + ((u >> 16) & 1u)) >> 16; }
__device__ __forceinline__ unsigned pk2(float lo, float hi) { return f2bf(lo) | (f2bf(hi) << 16); }

#define XB_TMO      128
#define XB_XCNT(j)  (256  + 64 * (j))
#define XB_XSUB(j)  (1280 + 64 * (j))
#define XB_XGEN(j)  (2304 + 64 * (j))
#define XB_TOP      3328
#define XB_TOPGEN   3392
#define XCD_BAR_WORDS 3456
#define XB_SPIN_CAP (1u << 18)

__device__ __forceinline__ unsigned xb_ld(unsigned* p)              { return __hip_atomic_load(p, __ATOMIC_RELAXED, __HIP_MEMORY_SCOPE_AGENT); }
__device__ __forceinline__ unsigned xb_add(unsigned* p, unsigned v) { return __hip_atomic_fetch_add(p, v, __ATOMIC_RELAXED, __HIP_MEMORY_SCOPE_AGENT); }
__device__ __forceinline__ unsigned xb_xcc_id() { return (unsigned)__builtin_amdgcn_s_getreg((3 << 11) | 20) & 0xFu; }
#define XB_SPIN(cond, bar) do { unsigned _sp = 0; while (cond) { __builtin_amdgcn_s_sleep(1); \
    if ((++_sp & 255u) == 0u) { if (xb_ld(&(bar)[XB_TMO])) break; if (_sp > XB_SPIN_CAP) { atomicAdd(&(bar)[XB_TMO], 1u); break; } } } } while (0)

struct XcdBarrier {
    unsigned* bar; unsigned x; int wv;
    volatile LAS unsigned* st;
};

__device__ __forceinline__ XcdBarrier xcd_barrier_post(unsigned* bar, volatile LAS unsigned* st, int wv) {
    XcdBarrier b; b.bar = bar; b.x = xb_xcc_id(); b.st = st; b.wv = wv;
    if (wv == 0 && lane_id() == 0) (void)xb_add(&bar[XB_XCNT(b.x)], 1u);
    return b;
}
__device__ __forceinline__ void xcd_barrier_complete(unsigned* bar, unsigned x, unsigned& nloc, unsigned& nx) {
    const unsigned G = gridDim.x * gridDim.y * gridDim.z;
    unsigned sum, cnt, mine, sp = 0u;
    for (;;) {
        sum = 0u; cnt = 0u; mine = 0u;
#pragma unroll
        for (unsigned j = 0; j < 16; ++j) { const unsigned c = xb_ld(&bar[XB_XCNT(j)]); sum += c; cnt += (c > 0u) ? 1u : 0u; mine = (j == x) ? c : mine; }
        if (sum == G) break;
        __builtin_amdgcn_s_sleep(1);
        if ((++sp & 255u) == 0u) { if (xb_ld(&bar[XB_TMO])) break; if (sp > XB_SPIN_CAP) { atomicAdd(&bar[XB_TMO], 1u); break; } }
    }
    nloc = mine > 0u ? mine : 1u; nx = cnt > 0u ? cnt : 1u;
}

__device__ __forceinline__ void xcd_barrier(const XcdBarrier& b) {
    asm volatile("s_waitcnt vmcnt(0)" ::: "memory");
    __syncthreads();
    if (b.wv == 0 && lane_id() == 0) {
        unsigned* bar = b.bar;
        __builtin_amdgcn_s_waitcnt(0);
        unsigned nloc = b.st[0], nx = b.st[1];
        if (nloc == 0u) { xcd_barrier_complete(bar, b.x, nloc, nx); b.st[0] = nloc; b.st[1] = nx; }
        const unsigned old = xb_add(&bar[XB_XSUB(b.x)], 1u);
        const unsigned gen = old / nloc;
        if (old + 1u == (gen + 1u) * nloc) {
            __builtin_amdgcn_fence(__ATOMIC_RELEASE, "agent");
            asm volatile("s_waitcnt vmcnt(0)" ::: "memory");
            const unsigned og = xb_add(&bar[XB_TOP], 1u);
            const unsigned tg = og / nx;
            if (og + 1u == (tg + 1u) * nx) xb_add(&bar[XB_TOPGEN], 1u);
            else XB_SPIN(xb_ld(&bar[XB_TOPGEN]) == tg, bar);
            __builtin_amdgcn_fence(__ATOMIC_ACQUIRE, "agent");
            xb_add(&bar[XB_XGEN(b.x)], 1u);
            asm volatile("s_waitcnt vmcnt(0)" ::: "memory");
        } else {
            XB_SPIN(xb_ld(&bar[XB_XGEN(b.x)]) == gen, bar);
            __builtin_amdgcn_fence(__ATOMIC_ACQUIRE, "agent");
            asm volatile("s_waitcnt vmcnt(0)" ::: "memory");
        }
    }
    __syncthreads();
}
constexpr size_t MiB = 1u << 20;
constexpr size_t WS_CTL = 0, CTL_ZERO_BYTES = 2 * MiB;
constexpr int CW_TMO = 0, CW_CODE = 1, CW_BAR = 1024;
constexpr size_t CTL_SS = 128 * 1024;
constexpr size_t CTL_KMP = 512 * 1024;
constexpr size_t CTL_SMP = 768 * 1024;
constexpr size_t CTL_CONVQ = 960 * 1024;
constexpr size_t CTL_FIN = 896 * 1024;
constexpr size_t WS_COS = 2 * MiB, WS_SIN = 4 * MiB;
constexpr size_t WS_WIN = 6 * MiB;
constexpr size_t WS_WO = WS_WIN + (size_t)INW * DM * 2;
constexpr size_t WS_WGU = WS_WO + (size_t)DM * DM * 2;
constexpr size_t WS_WDN = WS_WGU + (size_t)2 * 2 * FF * DM * 2;
constexpr size_t WS_WPL = WS_WDN + (size_t)2 * DM * FF * 2;
constexpr size_t WS_XB = WS_WPL + (size_t)DM * 512 * 2;
constexpr size_t WS_X = WS_XB + (size_t)MPAD * DM * 2;
constexpr size_t WS_Q = WS_X + (size_t)MPAD * DM * 4;
constexpr size_t WS_K = WS_Q + (size_t)MPAD * 1024 * 2, WS_V = WS_K + (size_t)MPAD * 1024 * 2, WS_G = WS_V + (size_t)MPAD * 1024 * 2, WS_U = WS_G + (size_t)MPAD * 1024 * 2;
constexpr size_t WS_ATT = WS_U + (size_t)MPAD * 1024 * 2;
constexpr size_t WS_H = WS_ATT + (size_t)MPAD * DM * 2;
constexpr size_t WS_D = WS_H + (size_t)MPAD * FF * 2;
constexpr size_t WS_KMS = WS_D + (size_t)MPAD * DM * 2;
constexpr size_t WS_END = WS_KMS + (size_t)DB * 64 * 1024 * 4;
static_assert(CTL_SS + 5 * MPAD * 8 <= CTL_KMP && CTL_KMP + 32 * 1024 * 4 <= CTL_SMP && (CW_BAR + 3 * 3456) * 4 <= (int)CTL_SS, "control region map");

constexpr int NWAVES = 8;
constexpr int RING_OFF = 0, RING_BYTES = 131072;
constexpr int LDSCTL_OFF = RING_BYTES, MISC_OFF = LDSCTL_OFF + 320;
constexpr int LDS_BYTES = 147456;
static_assert(MISC_OFF + 128 <= LDS_BYTES, "LDS map");
__device__ __forceinline__ float bf2f(unsigned short h) { return __uint_as_float(((unsigned)h) << 16); }
__device__ __forceinline__ float wave_sum(float v) {
#pragma unroll
    for (int o = 1; o < 64; o <<= 1) v += __shfl_xor(v, o);
    return v;
}
struct Args {
    const float* in[18]; float* out; unsigned char* ws;
    int ph_lo, ph_hi, li, pad;
};

__device__ __forceinline__ int inproj_src_col(int r) {
    const int pn = r >> 8, bj = (r >> 7) & 1, jj = r & 127;
    if (pn < 8) return (pn >> 2) * 1024 + (2 * (pn & 3) + (jj >> 6)) * 128 + 64 * bj + (jj & 63);
    if (pn < 16) return r;
    return 4096 + 1024 * bj + 128 * (pn - 16) + jj;
}
__device__ __forceinline__ int resid_src_col(int r) { const int rho = r & 255; return (r & ~255) + 64 * ((rho >> 5) & 3) + 32 * (rho >> 7) + (rho & 31); }
struct TItem { const float* W; const float* gain; const float* cscale; bf16* WT; int ldw, scol4, ldk, drow0, k0, kblk; };
__device__ __forceinline__ void titem_load(const TItem& t, int lane, f32x4 (&v)[8], float (&g)[8]) {
    const int kr = lane >> 3;
#pragma unroll
    for (int i = 0; i < 8; ++i) v[i] = __builtin_nontemporal_load((const GAS f32x4*)(t.W + (size_t)(t.k0 + 8 * i + kr) * t.ldw + t.scol4));
#pragma unroll
    for (int i = 0; i < 8; ++i) g[i] = t.gain ? t.gain[t.k0 + 8 * i + kr] : 1.0f;
}
__device__ __forceinline__ void titem_store(const TItem& t, int lane, const f32x4 (&v)[8], const float (&g)[8], LAS float* scr) {
    const int kr = lane >> 3, n4 = lane & 7;
#pragma unroll
    for (int i = 0; i < 8; ++i) { LAS float* d = scr + (8 * i + kr) * 33 + 4 * n4; d[0] = v[i].x * g[i]; d[1] = v[i].y * g[i]; d[2] = v[i].z * g[i]; d[3] = v[i].w * g[i]; }
    LDS_WAIT(); asm volatile("" ::: "memory");
    const int c = lane & 7;
#pragma unroll
    for (int j = 0; j < 4; ++j) { const int n = (lane >> 3) + 8 * j; const LAS float* s = scr + (8 * c) * 33 + n; const float cs = t.cscale ? t.cscale[resid_src_col(t.drow0 + n)] : 1.0f;
        v4u o; o.x = pk2(s[0 * 33] * cs, s[1 * 33] * cs); o.y = pk2(s[2 * 33] * cs, s[3 * 33] * cs); o.z = pk2(s[4 * 33] * cs, s[5 * 33] * cs); o.w = pk2(s[6 * 33] * cs, s[7 * 33] * cs);
        bf16* d = t.kblk ? t.WT + ((size_t)(t.k0 >> 6) * t.kblk + t.drow0 + n) * 64 + 8 * c : t.WT + (size_t)(t.drow0 + n) * t.ldk + t.k0 + 8 * c;
        *(GAS v4u*)d = o; }
    LDS_WAIT(); asm volatile("" ::: "memory");
}

__device__ __forceinline__ TItem titem_decode(const Args& a, int set, int it, int lane) {
    unsigned char* ws = a.ws;
    constexpr int I_IN = (DM / 64) * (INW / 32), I_O = (DM / 64) * (DM / 32), I_GU = (DM / 64) * (2 * FF / 32), I_DN = (FF / 64) * (DM / 32);
    TItem t; int r = it; const int l = set == 0 ? 0 : 1; const int l4 = 4 * (lane & 7);
    if (set == 0) {
        if (r < I_IN) { const int nb = r % (INW / 32), kb = r / (INW / 32);
            t.W = a.in[10]; t.gain = a.in[7]; t.cscale = nullptr; t.WT = (bf16*)(ws + WS_WIN); t.ldw = INW; t.scol4 = inproj_src_col(nb * 32 + l4); t.ldk = DM; t.drow0 = nb * 32; t.k0 = kb * 64; t.kblk = 0; return t; }
        r -= I_IN;
        if (r < I_O) { const int nb = r % (DM / 32), kb = r / (DM / 32);
            t.W = a.in[12]; t.gain = nullptr; t.cscale = nullptr; t.WT = (bf16*)(ws + WS_WO); t.ldw = DM; t.scol4 = resid_src_col(nb * 32 + l4); t.ldk = DM; t.drow0 = nb * 32; t.k0 = kb * 64; t.kblk = 0; return t; }
        r -= I_O;
    }
    if (set == 2) r += I_GU;
    if (r < I_GU) { const int nb = r % (2 * FF / 32), kb = r / (2 * FF / 32);
        const int drow = nb * 32, pn = drow >> 8, bj = (drow >> 7) & 1, jj = drow & 127;
        t.W = (bj ? a.in[16] : a.in[15]) + (size_t)l * DM * FF; t.gain = a.in[8] + l * DM; t.cscale = nullptr; t.WT = (bf16*)(ws + WS_WGU) + (size_t)l * 2 * FF * DM;
        t.ldw = FF; t.scol4 = pn * 128 + jj + l4; t.ldk = DM; t.drow0 = drow; t.k0 = kb * 64; t.kblk = 0; return t; }
    r -= I_GU;
    if (r < I_DN) { const int nb = r % (DM / 32), kb = r / (DM / 32);
        t.W = a.in[17] + (size_t)l * FF * DM; t.gain = nullptr; t.cscale = nullptr; t.WT = (bf16*)(ws + WS_WDN) + (size_t)l * DM * FF; t.ldw = DM; t.scol4 = resid_src_col(nb * 32 + l4); t.ldk = FF; t.drow0 = nb * 32; t.k0 = kb * 64; t.kblk = DM; return t; }
    r -= I_DN;
    { const int g = r / 128; r -= g * 128; const int nb = r % 16, kb = r / 16;
        t.W = a.in[13] + (size_t)g * 512 * 512; t.gain = nullptr; t.cscale = a.in[14]; t.WT = (bf16*)(ws + WS_WPL); t.ldw = 512; t.scol4 = resid_src_col(g * 512 + nb * 32 + l4) - g * 512; t.ldk = 512; t.drow0 = g * 512 + nb * 32; t.k0 = kb * 64; t.kblk = 0; return t; }
}
__device__ __forceinline__ void convert_weights(const Args& a, LAS float* scr, int set, int gw, int NGW, int lane, int lo = 0, int hi = 1 << 30) {
    constexpr int I_IN = (DM / 64) * (INW / 32), I_O = (DM / 64) * (DM / 32), I_GU = (DM / 64) * (2 * FF / 32), I_DN = (FF / 64) * (DM / 32), I_PL = 4 * (512 / 64) * (512 / 32);
    int nitems = set == 0 ? I_IN + I_O + I_GU + I_DN + I_PL : (set == 1 ? I_GU : I_DN); if (hi < nitems) nitems = hi;
    constexpr int CVB = CONV_BATCH;
    for (int base = lo + gw; base < nitems; base += CVB * NGW) {
        TItem t[CVB]; f32x4 v[CVB][8]; float g[CVB][8];
#pragma unroll
        for (int j = 0; j < CVB; ++j) { const int it = base + j * NGW; if (it < nitems) { t[j] = titem_decode(a, set, it, lane); titem_load(t[j], lane, v[j], g[j]); } }
#pragma unroll
        for (int j = 0; j < CVB; ++j) { const int it = base + j * NGW; if (it < nitems) titem_store(t[j], lane, v[j], g[j], scr); }
    }
}
__device__ __forceinline__ void convert_weights_queue(const Args& a, LAS float* scr, int set, unsigned* ctr, int lane) {
    constexpr int I_GU = (DM / 64) * (2 * FF / 32), I_DN = (FF / 64) * (DM / 32);
    const int nitems = set == 1 ? I_GU : I_DN;
    for (;;) {
        unsigned b0 = 0; if (lane == 0) b0 = __hip_atomic_fetch_add(ctr, 4u, RLX_AGENT);
        const int base = (int)__builtin_amdgcn_readfirstlane(b0);
        if (base >= nitems) break;
        TItem t[4]; f32x4 v[4][8]; float g[4][8];
#pragma unroll
        for (int j = 0; j < 4; ++j) { const int it = base + j; if (it < nitems) { t[j] = titem_decode(a, set, it, lane); titem_load(t[j], lane, v[j], g[j]); } }
#pragma unroll
        for (int j = 0; j < 4; ++j) { const int it = base + j; if (it < nitems) titem_store(t[j], lane, v[j], g[j], scr); }
    }
}
__device__ __forceinline__ void p0_prologue(const Args& a, LAS unsigned char* lds, int vcu, int G, int wave, int lane) {
    unsigned char* ws = a.ws;
    LAS float* scr = (LAS float*)(lds + RING_OFF + wave * 16384);
    const int gw = vcu * NWAVES + wave, NGW = G * NWAVES;
    convert_weights(a, scr, 0, gw, NGW, lane);
    if (!CONV_IN_SLOTS) { convert_weights(a, scr, 1, gw, NGW, lane); convert_weights(a, scr, 2, gw, NGW, lane); }
    else convert_weights(a, scr, 1, gw, NGW, lane, 0, GU1_IN_P0);
    bf16* XB = (bf16*)(ws + WS_XB); unsigned long long* SS0 = (unsigned long long*)(ws + CTL_SS);
    {
        constexpr int NRW = (MV + 2047) / 2048 + 1;
        for (int m0 = gw; m0 < MV; m0 += NRW * NGW) {
            f32x4 v[NRW][8];
#pragma unroll
            for (int r = 0; r < NRW; ++r) { const int m = m0 + r * NGW;
                if (m < MV) { const float* xrow = m < MP ? a.in[0] + (size_t)m * DM : a.in[1] + (size_t)(m - MP) * DM;
                    const GAS f32x4* xr = (const GAS f32x4*)xrow + lane;
#pragma unroll
                    for (int j = 0; j < 8; ++j) v[r][j] = __builtin_nontemporal_load(xr + 64 * j); } }
#pragma unroll
            for (int r = 0; r < NRW; ++r) { const int m = m0 + r * NGW;
                if (m < MV) { float s = 0.f;
#pragma unroll
                    for (int j = 0; j < 8; ++j) s += (v[r][j].x * v[r][j].x + v[r][j].y * v[r][j].y) + (v[r][j].z * v[r][j].z + v[r][j].w * v[r][j].w);
                    s = wave_sum(s);
                    GAS unsigned long long* o8 = (GAS unsigned long long*)(XB + (size_t)m * DM) + lane;
#pragma unroll
                    for (int j = 0; j < 8; ++j) o8[64 * j] = (unsigned long long)pk2(v[r][j].x, v[r][j].y) | ((unsigned long long)pk2(v[r][j].z, v[r][j].w) << 32);
                    if (lane == 0) SS0[m] = (unsigned long long)(s * SS_SCALE + 0.5f); } }
        }
    }
    float* cosT = (float*)(ws + WS_COS); float* sinT = (float*)(ws + WS_SIN);
    for (int i = gw * 64 + lane; i < (SEQ + DS) * 64; i += NGW * 64) {
        const int p = i >> 6, ii = i & 63; const int pos = p < SEQ ? p : PAST + (p - SEQ);
        const float inv = powf(10000.f, -(float)ii / 64.f); const float ang = (float)pos * inv;
        cosT[i] = cosf(ang); sinT[i] = sinf(ang);
    }
}

__device__ __forceinline__ void unpack8(const v4u w, float (&f)[8]) {
#pragma unroll
    for (int e = 0; e < 4; ++e) { f[2 * e] = __uint_as_float(w[e] << 16); f[2 * e + 1] = __uint_as_float(w[e] & 0xffff0000u); }
}
__device__ __forceinline__ void conv_pass(const Args& a, int vcu, int G, int tid) {
    unsigned char* ws = a.ws;
    const bf16* Ub = (const bf16*)(ws + WS_U); const bf16* Gb = (const bf16*)(ws + WS_G); bf16* ATT = (bf16*)(ws + WS_ATT);
    const float* conv_w = a.in[11]; const float* state_conv = a.in[5];
    const int nthr = G * NWAVES * 64;
    for (int it = vcu * NWAVES * 64 + tid; it < (MV / 4) * 128; it += nthr) {
        const int r0 = (it >> 7) * 4, ch = (it & 127) * 8;
        const bool smp = r0 >= MP;
        const int t0 = smp ? 0 : r0 & (SEQ - 1), b = smp ? (r0 - MP) >> 2 : r0 >> 12;
        v4u up[6], gp[4];
#pragma unroll
        for (int j = 0; j < 4; ++j) { up[j + 2] = *(const GAS v4u*)(Ub + (size_t)(r0 + j) * 1024 + ch); gp[j] = *(const GAS v4u*)(Gb + (size_t)(r0 + j) * 1024 + ch); }
        float u[6][8];
        if (t0 >= 2) { up[0] = *(const GAS v4u*)(Ub + (size_t)(r0 - 2) * 1024 + ch); up[1] = *(const GAS v4u*)(Ub + (size_t)(r0 - 1) * 1024 + ch); unpack8(up[0], u[0]); unpack8(up[1], u[1]); }
        else if (smp) { const float* s0 = state_conv + ((size_t)b * 2) * CC + ch;
#pragma unroll
            for (int e = 0; e < 8; ++e) { u[0][e] = s0[e]; u[1][e] = s0[CC + e]; } }
        else {
#pragma unroll
            for (int e = 0; e < 8; ++e) { u[0][e] = 0.f; u[1][e] = 0.f; } }
#pragma unroll
        for (int j = 2; j < 6; ++j) unpack8(up[j], u[j]);
        float w0[8], w1[8], w2[8];
#pragma unroll
        for (int e = 0; e < 8; ++e) { w0[e] = conv_w[ch + e]; w1[e] = conv_w[CC + ch + e]; w2[e] = conv_w[2 * CC + ch + e]; }
#pragma unroll
        for (int j = 0; j < 4; ++j) {
            float gb[8], y[8]; unpack8(gp[j], gb);
#pragma unroll
            for (int e = 0; e < 8; ++e) y[e] = gb[e] * (w0[e] * u[j][e] + w1[e] * u[j + 1][e] + w2[e] * u[j + 2][e]);
            v4u o; o.x = pk2(y[0], y[1]); o.y = pk2(y[2], y[3]); o.z = pk2(y[4], y[5]); o.w = pk2(y[6], y[7]);
            *(GAS v4u*)(ATT + (size_t)(r0 + j) * DM + 1024 + ch) = o;
        }
    }
}

__device__ __forceinline__ f32x4 pool_h(const bf16* XBp, const unsigned long long* ss, int row, int c, const f32x4 g) {
    const float rstd = rsqrtf((float)ss[row] * (1.0f / (SS_SCALE * (float)DM)) + RMS_EPS);
    const unsigned long long w = *(const GAS unsigned long long*)(XBp + (size_t)row * DM + c);
    const f32x4 x = (f32x4){__uint_as_float((unsigned)w << 16), __uint_as_float((unsigned)w & 0xffff0000u), __uint_as_float((unsigned)(w >> 32) << 16), __uint_as_float((unsigned)(w >> 32) & 0xffff0000u)};
    return x * rstd * g;
}
__device__ __forceinline__ f32x4 pool_unpack(unsigned long long w) {
    return (f32x4){__uint_as_float((unsigned)w << 16), __uint_as_float((unsigned)w & 0xffff0000u), __uint_as_float((unsigned)(w >> 32) << 16), __uint_as_float((unsigned)(w >> 32) & 0xffff0000u)};
}
template <int W, int NRW>
__device__ __forceinline__ void pool_rows(const bf16* XBp, const unsigned long long* ss, bf16* Dd, float* o_pp, int r0, int t0, int bb, int c, const f32x4 g) {
    constexpr int NR = W - 1 + NRW;
    unsigned long long raw[NR]; float rs[NR];
#pragma unroll
    for (int i = 0; i < NR; ++i) { const int dr = i - (W - 1); const bool ok = t0 + dr >= 0;
        raw[i] = ok ? *(const GAS unsigned long long*)(XBp + (size_t)(r0 + dr) * DM + c) : 0ull;
        rs[i] = ok ? rsqrtf((float)ss[r0 + dr] * (1.0f / (SS_SCALE * (float)DM)) + RMS_EPS) : 0.f; }
    f32x4 S = (f32x4){0.f, 0.f, 0.f, 0.f};
#pragma unroll
    for (int i = 0; i < W - 1; ++i) S += pool_unpack(raw[i]) * rs[i] * g;
#pragma unroll
    for (int j = 0; j < NRW; ++j) {
        const int t = t0 + j; const f32x4 hv = pool_unpack(raw[W - 1 + j]) * rs[W - 1 + j] * g;
        S += hv;
        const float cnt = (float)((t + 1) < W ? (t + 1) : W);
        const f32x4 d = S * (1.0f / cnt) - hv;
        *(GAS unsigned long long*)(Dd + (size_t)(r0 + j) * DM + c) = (unsigned long long)pk2(d.x, d.y) | ((unsigned long long)pk2(d.z, d.w) << 32);
        S -= pool_unpack(raw[j]) * rs[j] * g;
        if (t >= SEQ - 15) *(GAS f32x4*)(o_pp + ((size_t)bb * 15 + (t - (SEQ - 15))) * DM + c) = hv;
    }
}
template <int W>
__device__ __forceinline__ void pool_sample(const bf16* XBp, const unsigned long long* ss, bf16* Dd, const float* hist, float* o_ps, int b, int c, const f32x4 g) {
    const int r0 = MP + b * DS;
    f32x4 hs[15]; unsigned long long raw[DS]; float rs[DS];
#pragma unroll
    for (int j = 0; j < 15; ++j) hs[j] = *(const f32x4*)(hist + (size_t)j * DM);
#pragma unroll
    for (int t = 0; t < DS; ++t) { raw[t] = *(const GAS unsigned long long*)(XBp + (size_t)(r0 + t) * DM + c); rs[t] = rsqrtf((float)ss[r0 + t] * (1.0f / (SS_SCALE * (float)DM)) + RMS_EPS); }
    f32x4 h[DS];
#pragma unroll
    for (int t = 0; t < DS; ++t) h[t] = pool_unpack(raw[t]) * rs[t] * g;
    f32x4 S = (f32x4){0.f, 0.f, 0.f, 0.f};
#pragma unroll
    for (int j = 1; j <= W - 1; ++j) S += hs[15 - j];
#pragma unroll
    for (int t = 0; t < DS; ++t) {
        S += h[t];
        const f32x4 d = S * (1.0f / (float)W) - h[t];
        *(GAS unsigned long long*)(Dd + (size_t)(r0 + t) * DM + c) = (unsigned long long)pk2(d.x, d.y) | ((unsigned long long)pk2(d.z, d.w) << 32);
        const int to = t - (W - 1);
        if (to >= 0) S -= h[to >= 0 ? to : 0]; else S -= hs[15 + to >= 0 ? 15 + to : 0];
        *(GAS f32x4*)(o_ps + ((size_t)b * 15 + 11 + t) * DM + c) = h[t];
    }
#pragma unroll
    for (int j = 0; j < 11; ++j) *(GAS f32x4*)(o_ps + ((size_t)b * 15 + j) * DM + c) = hs[j + 4];
}
__device__ __forceinline__ void pool_pass(const Args& a, int vcu, int G, int tid) {
    unsigned char* ws = a.ws;
    const bf16* X = (const bf16*)(ws + WS_XB); const unsigned long long* ss = (const unsigned long long*)(ws + CTL_SS) + 2 * MPAD;
    bf16* Dd = (bf16*)(ws + WS_D);
    const float* state_pool = a.in[6]; const float* gmix = a.in[7] + DM;
    float* o_pp = a.out + (size_t)MV * DM + 2 * (size_t)MP * 1024 + 2 * (size_t)MS * 1024 + (size_t)NB * 2 * CC + (size_t)DB * 2 * CC;
    float* o_ps = o_pp + (size_t)NB * 15 * DM;
    const int c = tid * 4, grp = __builtin_amdgcn_readfirstlane(c >> 9);
    const f32x4 g = *(const f32x4*)(gmix + c);
    if (vcu >= G - DB) { const int b = vcu - (G - DB); const float* hist = state_pool + (size_t)b * 15 * DM + c;
        if (grp == 0) pool_sample<2>(X, ss, Dd, hist, o_ps, b, c, g); else if (grp == 1) pool_sample<4>(X, ss, Dd, hist, o_ps, b, c, g);
        else if (grp == 2) pool_sample<8>(X, ss, Dd, hist, o_ps, b, c, g); else pool_sample<16>(X, ss, Dd, hist, o_ps, b, c, g); }
    for (int it = vcu; it < MP / 32; it += G) {
        const int r0 = it * 32, t0 = r0 & (SEQ - 1), bb = r0 >> 12;
#pragma unroll 1
        for (int q = 0; q < 2; ++q) {
            if (grp == 0) pool_rows<2, 16>(X, ss, Dd, o_pp, r0 + 16 * q, t0 + 16 * q, bb, c, g);
            else if (grp == 1) pool_rows<4, 16>(X, ss, Dd, o_pp, r0 + 16 * q, t0 + 16 * q, bb, c, g);
            else if (grp == 2) pool_rows<8, 16>(X, ss, Dd, o_pp, r0 + 16 * q, t0 + 16 * q, bb, c, g);
            else pool_rows<16, 16>(X, ss, Dd, o_pp, r0 + 16 * q, t0 + 16 * q, bb, c, g);
        }
    }
}

__device__ __forceinline__ void final_norm(const Args& a, int vcu, int G, int wave, int lane) {
    unsigned char* ws = a.ws;
    const bf16* X = (const bf16*)(ws + WS_XB); const unsigned long long* ss = (const unsigned long long*)(ws + CTL_SS) + 4 * MPAD;
    const float* gf = a.in[9];
    const int gw = vcu * NWAVES + wave, NGW = G * NWAVES;
    f32x4 g[8];
#pragma unroll
    for (int j = 0; j < 8; ++j) g[j] = *(const f32x4*)(gf + 4 * (lane + 64 * j));
    for (int m = gw; m < MV; m += NGW) {
        const float rstd = rsqrtf((float)ss[m] * (1.0f / (SS_SCALE * (float)DM)) + RMS_EPS);
        const GAS unsigned long long* xr = (const GAS unsigned long long*)(X + (size_t)m * DM) + lane;
        GAS f32x4* yr = (GAS f32x4*)(a.out + (size_t)m * DM) + lane;
        unsigned long long w[8];
#pragma unroll
        for (int j = 0; j < 8; ++j) w[j] = xr[64 * j];
#pragma unroll
        for (int j = 0; j < 8; ++j) { const f32x4 x = (f32x4){__uint_as_float((unsigned)w[j] << 16), __uint_as_float((unsigned)w[j] & 0xffff0000u), __uint_as_float((unsigned)(w[j] >> 32) << 16), __uint_as_float((unsigned)(w[j] >> 32) & 0xffff0000u)};
            yr[64 * j] = x * rstd * g[j]; }
    }
}

namespace mb {
constexpr int D = 128, QPITCH = 1024, KPITCH = 1024, OPITCH = 2048;
constexpr float THR = 8.f;
constexpr bool WSKIP = false;
constexpr float SCALE = 0.08838834764831845f;
constexpr int NW = 8, QBLK = 32, KVBLK = 64, QB = NW * QBLK;
constexpr int SHM_V = KVBLK * D * 2, SHM_K = KVBLK * D * 2;
constexpr int ATT_LDS_BYTES = 2 * SHM_V + 2 * SHM_K + NW * 64 * 4;

using bf16 = __hip_bfloat16;
typedef short bf16x8 __attribute__((ext_vector_type(8)));
typedef short s16x4 __attribute__((ext_vector_type(4)));
typedef float f32x16 __attribute__((ext_vector_type(16)));
typedef float f32x4 __attribute__((ext_vector_type(4)));
typedef unsigned u32x4 __attribute__((ext_vector_type(4)));
template <class A, class Bt> struct same_t { static constexpr bool v = false; };
template <class A> struct same_t<A, A> { static constexpr bool v = true; };

#define KSWZ(row, colB) ((row) * 256 + ((colB) ^ (((row) & 7) << 4)))
#define SBAR() __builtin_amdgcn_sched_barrier(0)
__device__ __forceinline__ int v_st(int k, int c) { const int kk = (k & ~0xC) | ((k & 4) << 1) | ((k & 8) >> 1); return ((kk >> 3) * 4 + (c >> 5)) * 512 + ((kk & 7) * 32 + (c & 31)) * 2; }
__device__ __forceinline__ int v_rd_base(int lane) { return ((lane & 3) << 3) | (((lane >> 2) & 3) << 6) | (((lane >> 4) & 1) << 5) | (((lane >> 5) & 1) << 8); }
constexpr int v_rd_off(int d0, int ks, int half) { return d0 * 512 + ks * 4096 + half * 2048; }
__device__ __forceinline__ int crow(int r, int hi) { return (r & 3) + 8 * (r >> 2) + 4 * hi; }
__device__ __forceinline__ unsigned cvtpk(float lo, float hi) {
    unsigned r; asm volatile("v_cvt_pk_bf16_f32 %0, %1, %2" : "=v"(r) : "v"(lo), "v"(hi)); return r;
}
__device__ __forceinline__ bf16x8 pack8(f32x4 a, f32x4 b) {
    u32x4 w = {cvtpk(a[0], a[1]), cvtpk(a[2], a[3]), cvtpk(b[0], b[1]), cvtpk(b[2], b[3])};
    return *reinterpret_cast<bf16x8*>(&w);
}
template <class T> __device__ __forceinline__ bf16x8 load8(const T* p) {
    if constexpr (same_t<T, float>::v) { return pack8(*(const f32x4*)p, *(const f32x4*)(p + 4)); }
    else { return *reinterpret_cast<const bf16x8*>(p); }
}
__device__ __forceinline__ void mask_tile(f32x16& p0, f32x16& p1, int dq, unsigned W) {
    const float NEG = -__builtin_inff();
#pragma unroll
    for (int r = 0; r < 16; ++r) {
        const int c = (r & 3) + 8 * (r >> 2);
        if ((unsigned)(dq - c) >= W) p0[r] = NEG;
        if ((unsigned)(dq - c - 32) >= W) p1[r] = NEG;
    }
}
__device__ __forceinline__ void partialSM(f32x16& p0, f32x16& p1, float& m_reg, float& mn, float& alpha, const bool rowoff) {
    float pmax = p0[0]; for (int r = 1; r < 16; ++r) pmax = fmaxf(pmax, p0[r]); for (int r = 0; r < 16; ++r) pmax = fmaxf(pmax, p1[r]);
    { auto rr = __builtin_amdgcn_permlane32_swap(__float_as_uint(pmax), __float_as_uint(pmax), false, false);
      pmax = fmaxf(__uint_as_float(rr[0]), __uint_as_float(rr[1])); }
    if (rowoff) pmax = -__builtin_inff();
    constexpr float C2 = 1.4426950408889634f * SCALE;
    if (__builtin_expect(__all((pmax - m_reg) * SCALE <= THR), 1)) { mn = m_reg; alpha = 1.f; }
    else { mn = fmaxf(m_reg, pmax); alpha = __builtin_amdgcn_exp2f((m_reg - mn) * C2); m_reg = mn; }
    const float mnL = rowoff ? -__builtin_inff() : -mn * C2;
    for (int r = 0; r < 16; ++r) p0[r] = fmaf(p0[r], C2, mnL); for (int r = 0; r < 16; ++r) p1[r] = fmaf(p1[r], C2, mnL);
    for (int r = 0; r < 16; ++r) p0[r] = __builtin_amdgcn_exp2f(p0[r]);
}
__device__ __forceinline__ void finishSM(f32x16& p0, f32x16& p1, float alpha, float& l_reg, bf16x8& pa0, bf16x8& pa1, bf16x8& pa2, bf16x8& pa3) {
    for (int r = 0; r < 16; ++r) p1[r] = __builtin_amdgcn_exp2f(p1[r]);
    float ps = 0; for (int r = 0; r < 16; ++r) ps += p0[r]; for (int r = 0; r < 16; ++r) ps += p1[r];
    { auto rr = __builtin_amdgcn_permlane32_swap(__float_as_uint(ps), __float_as_uint(ps), false, false);
      ps = __uint_as_float(rr[0]) + __uint_as_float(rr[1]); }
    l_reg = l_reg * alpha + ps;
#define PK4(P, B_, OUT) do { unsigned a0 = cvtpk(P[B_+0], P[B_+1]), a1 = cvtpk(P[B_+2], P[B_+3]);                          \
        unsigned b0 = cvtpk(P[B_+4], P[B_+5]), b1 = cvtpk(P[B_+6], P[B_+7]);                                             \
        auto r0 = __builtin_amdgcn_permlane32_swap(a0, b0, false, false); auto r1 = __builtin_amdgcn_permlane32_swap(a1, b1, false, false); \
        u32x4 w = {r0[0], r1[0], r0[1], r1[1]}; OUT = *reinterpret_cast<bf16x8*>(&w); } while (0)
    PK4(p0, 0, pa0); PK4(p0, 8, pa1); PK4(p1, 0, pa2); PK4(p1, 8, pa3);
#undef PK4
}
template <int KB, bool SK>
__device__ __forceinline__ void qkt(f32x16& p0, f32x16& p1, const char* K_lds, int r32, int hi, const bf16x8* qr, bool act) {
    if (SK && !act) { const float NEG = -__builtin_inff();
#pragma unroll
        for (int r = 0; r < 16; ++r) { p0[r] = NEG; p1[r] = NEG; } return; }
    p0 = f32x16{}; p1 = f32x16{};
    const char* kb[4];
#pragma unroll
    for (int dd = 0; dd < 4; ++dd) kb[dd] = K_lds + KB * SHM_K + KSWZ(r32, (dd * 16 + hi * 8) * 2);
#pragma unroll
    for (int d0 = 0; d0 < 8; ++d0) { const char* a = kb[d0 & 3] + (d0 >> 2) * 128;
        bf16x8 b0 = *reinterpret_cast<const bf16x8*>(a);
        bf16x8 b1 = *reinterpret_cast<const bf16x8*>(a + 32 * 256);
        p0 = __builtin_amdgcn_mfma_f32_32x32x16_bf16(b0, qr[d0], p0, 0, 0, 0);
        p1 = __builtin_amdgcn_mfma_f32_32x32x16_bf16(b1, qr[d0], p1, 0, 0, 0); }
}
template <int VB, bool SK>
__device__ __forceinline__ void pv_tile(f32x16* o, int vb0, bf16x8 pa0, bf16x8 pa1, bf16x8 pa2, bf16x8 pa3, bool act) {
    if (SK && !act) return;
#define TRRD(dst, off) asm volatile("ds_read_b64_tr_b16 %0, %1 offset:%2" : "=&v"(dst) : "v"(vb0), "i"(off) : "memory")
#define PV_D0(d0) do { s16x4 l0, l1, l2, l3, h0, h1, h2, h3; constexpr int b_ = VB * SHM_V + v_rd_off(d0, 0, 0);     \
        TRRD(l0, b_); TRRD(h0, b_ + 2048); TRRD(l1, b_ + 4096); TRRD(h1, b_ + 6144); TRRD(l2, b_ + 8192); TRRD(h2, b_ + 10240); TRRD(l3, b_ + 12288); TRRD(h3, b_ + 14336); \
        asm volatile("s_waitcnt lgkmcnt(0)" ::: "memory"); SBAR();                 \
        o[d0] = __builtin_amdgcn_mfma_f32_32x32x16_bf16(pa0, (bf16x8){l0[0], l0[1], l0[2], l0[3], h0[0], h0[1], h0[2], h0[3]}, o[d0], 0, 0, 0);   \
        o[d0] = __builtin_amdgcn_mfma_f32_32x32x16_bf16(pa1, (bf16x8){l1[0], l1[1], l1[2], l1[3], h1[0], h1[1], h1[2], h1[3]}, o[d0], 0, 0, 0);   \
        o[d0] = __builtin_amdgcn_mfma_f32_32x32x16_bf16(pa2, (bf16x8){l2[0], l2[1], l2[2], l2[3], h2[0], h2[1], h2[2], h2[3]}, o[d0], 0, 0, 0);   \
        o[d0] = __builtin_amdgcn_mfma_f32_32x32x16_bf16(pa3, (bf16x8){l3[0], l3[1], l3[2], l3[3], h3[0], h3[1], h3[2], h3[3]}, o[d0], 0, 0, 0); } while (0)
    PV_D0(0); PV_D0(1); PV_D0(2); PV_D0(3);
#undef PV_D0
#undef TRRD
}

template <class TIn, class TOut> struct BlockRef { const TIn* Q; const TIn* K; const TIn* V; TOut* O; int P0; };
template <class TIn> struct Seam {
    bf16x8 qr[8];
    bf16x8 st_v0, st_v1, st_k0, st_k1; f32x4 sf0, sf1, sf2, sf3;
    f32x4 tq[16];
};
__device__ __forceinline__ int swa_jlo(int P0, int W) { const int lowk = P0 - W + 1; return lowk > 0 ? lowk / KVBLK : 0; }
#define ROW(p, k0, rr) ((p) + (size_t)((k0) + (rr)) * KPITCH + sc)
#define VMW() asm volatile("s_waitcnt vmcnt(0)" ::: "memory")
#define VMWN(n) asm volatile("s_waitcnt vmcnt(%0)" :: "i"(n) : "memory")
#define SLOAD_H(Kp, Vp, k0) do { S.st_v0 = load8<TIn>(ROW(Vp, k0, sr)); S.st_v1 = load8<TIn>(ROW(Vp, k0, 32 + sr));              \
                         S.st_k0 = load8<TIn>(ROW(Kp, k0, sr)); S.st_k1 = load8<TIn>(ROW(Kp, k0, 32 + sr)); } while (0)
#define SWRITE_HK(bf) do { *(bf16x8*)(K_lds + (bf) * SHM_K + kws) = S.st_k0; *(bf16x8*)(K_lds + (bf) * SHM_K + kws + 32 * 256) = S.st_k1; } while (0)
#define SWRITE_HV(bf) do { *(bf16x8*)(V_lds + (bf) * SHM_V + vst0) = S.st_v0; *(bf16x8*)(V_lds + (bf) * SHM_V + vst1) = S.st_v1; } while (0)
#define SWRITE_H(bf) do { SWRITE_HV(bf); SWRITE_HK(bf); } while (0)
#define SLOAD_F(p, k0) do { S.sf0 = *(const f32x4*)ROW(p, k0, sr); S.sf1 = *(const f32x4*)(ROW(p, k0, sr) + 4);                \
                            S.sf2 = *(const f32x4*)ROW(p, k0, 32 + sr); S.sf3 = *(const f32x4*)(ROW(p, k0, 32 + sr) + 4); } while (0)
#define SWRITE_KF(bf) do { *(bf16x8*)(K_lds + (bf) * SHM_K + kws) = pack8(S.sf0, S.sf1); *(bf16x8*)(K_lds + (bf) * SHM_K + kws + 32 * 256) = pack8(S.sf2, S.sf3); } while (0)
#define SWRITE_VF(bf) do { *(bf16x8*)(V_lds + (bf) * SHM_V + vst0) = pack8(S.sf0, S.sf1); *(bf16x8*)(V_lds + (bf) * SHM_V + vst1) = pack8(S.sf2, S.sf3); } while (0)
template <class TIn, class TOut>
__device__ __forceinline__ void causal_swa_prime(const BlockRef<TIn, TOut>& cur, int W, char* lds, Seam<TIn>& S, const int wv) {
    constexpr bool F32 = same_t<TIn, float>::v;
    const int tid = wv * 64 + (int)__builtin_amdgcn_mbcnt_hi(~0u, __builtin_amdgcn_mbcnt_lo(~0u, 0u)), wid = wv, lane = tid & 63, r32 = lane & 31, hi = lane >> 5;
    const int sr = tid >> 4, sc = (tid & 15) * 8, kws = KSWZ(sr, sc * 2); char* K_lds = lds + 2 * SHM_V;
    const int kb0 = swa_jlo(cur.P0, W) * KVBLK;
    for (int d0 = 0; d0 < 8; ++d0) S.qr[d0] = load8<TIn>(cur.Q + (size_t)(wid * QBLK + r32) * QPITCH + d0 * 16 + hi * 8);
    if constexpr (F32) { SLOAD_F((const float*)cur.K, kb0); VMW(); SWRITE_KF(0); SBAR(); SLOAD_F((const float*)cur.V, kb0); }
    else { SLOAD_H(cur.K, cur.V, kb0); VMW(); SWRITE_HK(0); }
    __syncthreads();
}
template <class TIn, class TOut>
__device__ __forceinline__ void causal_swa_block(const BlockRef<TIn, TOut>& cur, const BlockRef<TIn, TOut>& nxt, int skv, int W, char* lds, Seam<TIn>& S, const unsigned selmask, const int wv) {
    constexpr bool F32 = same_t<TIn, float>::v;
    int tid = wv * 64 + (int)__builtin_amdgcn_mbcnt_hi(~0u, __builtin_amdgcn_mbcnt_lo(~0u, 0u)); asm volatile("" : "+v"(tid));
    const int wid = wv, lane = tid & 63, r32 = lane & 31, hi = lane >> 5;
    const int j_lo = swa_jlo(cur.P0, W);
    int j_hi = (cur.P0 + QB - 1) / KVBLK + 1; if (j_hi > skv / KVBLK) j_hi = skv / KVBLK;
    const int NT = j_hi - j_lo;
    const int kbn = swa_jlo(nxt.P0, W) * KVBLK;
    const int own = cur.P0 >> 8;
    const int qlo = cur.P0 + wid * QBLK, qm = qlo + r32 - 4 * hi;
    char* V_lds = lds; char* K_lds = lds + 2 * SHM_V;
    float* ws = (float*)(lds + 2 * SHM_V + 2 * SHM_K) + wid * 64; float* li_l = ws, * al_l = ws + 32;
    float m_reg = -1e30f, l_reg = 0; f32x16 o[4] = {};
    const int sr = tid >> 4, sc = (tid & 15) * 8, vst0 = v_st(sr, sc), vst1 = v_st(32 + sr, sc), kws = KSWZ(sr, sc * 2);
    const int vb0 = (int)(uintptr_t)V_lds + v_rd_base(lane);
    const TIn* Kh = cur.K; const TIn* Vh = cur.V;
#define RESC(a) do { if (__any((a) < 1.f)) { if (hi == 0) al_l[r32] = (a); asm volatile("s_waitcnt lgkmcnt(0)" ::: "memory");              \
                     for (int d_ = 0; d_ < 4; ++d_) for (int r = 0; r < 16; ++r) o[d_][r] *= al_l[crow(r, hi)]; } } while (0)
#define KBASE(t) ((j_lo + (t)) * KVBLK)
#define ACT(t) (KBASE(t) <= qlo + QBLK - 1 && KBASE(t) + KVBLK - 1 >= qlo - W + 1)
#define MASKT(P0_, P1_, t) do { const int kb_ = KBASE(t); if ((kb_ >> 8) == own && kb_ + KVBLK - 1 > qlo) mask_tile(P0_, P1_, qm - kb_, 0x40000000u); } while (0)
#define ROWOFF(t) (own > 3 && (KBASE(t) >> 8) != own && ((selmask >> (KBASE(t) >> 8)) & 1u) == 0u)
    constexpr int NQL = F32 ? 16 : 8;
    constexpr bool SK = WSKIP && !F32;
#define SEAM_K0() do { VMWN(NQL); if constexpr (F32) { SWRITE_KF(0); SBAR(); SLOAD_F((const float*)nxt.V, kbn); } else { SWRITE_HK(0); } SBAR(); } while (0)
    f32x16 pA0, pA1, pB0, pB1; float mnA, mnB, alA, alB; bf16x8 pa0, pa1, pa2, pa3;
    if constexpr (F32) { VMW(); SWRITE_VF(0); SBAR(); } else { SWRITE_HV(0); SBAR(); }
    if (NT > 1) { if constexpr (F32) SLOAD_F((const float*)Kh, KBASE(1)); else SLOAD_H(Kh, Vh, KBASE(1)); }
    SBAR(); qkt<0, SK>(pA0, pA1, K_lds, r32, hi, S.qr, ACT(0));
    if constexpr (F32) { if (NT > 1) { VMW(); SWRITE_KF(1); SBAR(); SLOAD_F((const float*)Vh, KBASE(1)); } }
    MASKT(pA0, pA1, 0); partialSM(pA0, pA1, m_reg, mnA, alA, ROWOFF(0));
    if (NT > 1) { VMW(); if constexpr (F32) { SWRITE_VF(1); SBAR(); if (NT > 2) SLOAD_F((const float*)Kh, KBASE(2)); } else SWRITE_H(1); }
    __syncthreads();
#define HALF_STEP(PX0, PX1, mnX, alX, PY0, PY1, alY, t, KB, VB, SB) do {                                                      \
        SBAR(); qkt<KB, SK>(PX0, PX1, K_lds, r32, hi, S.qr, ACT(t));                                             \
        finishSM(PY0, PY1, alY, l_reg, pa0, pa1, pa2, pa3); SBAR();                                                           \
        if ((t) + 1 < NT) { if constexpr (F32) { VMW(); SWRITE_KF(SB); SBAR(); SLOAD_F((const float*)Vh, KBASE((t) + 1)); }  \
                            else { SLOAD_H(Kh, Vh, KBASE((t) + 1)); } SBAR(); }                                               \
        pv_tile<VB, SK>(o, vb0, pa0, pa1, pa2, pa3, ACT((t) - 1)); MASKT(PX0, PX1, (t)); partialSM(PX0, PX1, m_reg, mnX, alX, ROWOFF(t));                                        \
        __syncthreads();                                                                                                      \
        if ((t) + 1 < NT) { VMW(); if constexpr (F32) { SWRITE_VF(SB); SBAR(); if ((t) + 2 < NT) SLOAD_F((const float*)Kh, KBASE((t) + 2)); } \
                            else { SWRITE_H(SB); } }                                                                          \
        RESC(alX); __syncthreads(); } while (0)
    for (int t = 1; t + 1 < NT; t += 2) {
        HALF_STEP(pB0, pB1, mnB, alB, pA0, pA1, alA, t, 1, 0, 0);
        HALF_STEP(pA0, pA1, mnA, alA, pB0, pB1, alB, t + 1, 0, 1, 1);
    }
    const bool even = (NT & 1) == 0;
    if (even) { SBAR(); qkt<1, SK>(pB0, pB1, K_lds, r32, hi, S.qr, ACT(NT - 1)); SBAR(); }
#define QROW(e) (nxt.Q + (size_t)(wid * QBLK + r32) * QPITCH + ((e) >> 1) * 16 + hi * 8 + ((e) & 1) * 4)
    if constexpr (F32) { SLOAD_F((const float*)nxt.K, kbn); SBAR();
#pragma unroll
        for (int e = 0; e < 8; ++e) S.tq[e] = *(const f32x4*)QROW(e); }
    else { SLOAD_H(nxt.K, nxt.V, kbn); SBAR();
#pragma unroll
        for (int d0 = 0; d0 < 8; ++d0) S.qr[d0] = load8<TIn>(nxt.Q + (size_t)(wid * QBLK + r32) * QPITCH + d0 * 16 + hi * 8); }
    SBAR();
    finishSM(pA0, pA1, alA, l_reg, pa0, pa1, pa2, pa3); SBAR();
    if constexpr (F32) {
#pragma unroll
        for (int e = 8; e < 16; ++e) S.tq[e] = *(const f32x4*)QROW(e); SBAR(); }
#undef QROW
    pv_tile<0, SK>(o, vb0, pa0, pa1, pa2, pa3, ACT(even ? NT - 2 : NT - 1));
    if (even) { MASKT(pB0, pB1, NT - 1); partialSM(pB0, pB1, m_reg, mnB, alB, ROWOFF(NT - 1)); __syncthreads(); RESC(alB);
        finishSM(pB0, pB1, alB, l_reg, pa0, pa1, pa2, pa3); SBAR(); pv_tile<1, SK>(o, vb0, pa0, pa1, pa2, pa3, ACT(NT - 1)); }
    SBAR(); SEAM_K0();
    if (hi == 0) li_l[r32] = l_reg; asm volatile("s_waitcnt lgkmcnt(0)" ::: "memory");
    float rli[16];
#pragma unroll
    for (int r = 0; r < 16; ++r) rli[r] = __builtin_amdgcn_rcpf(li_l[crow(r, hi)]);
    TOut* Ow = cur.O + (size_t)(wid * QBLK) * OPITCH;
#pragma unroll
    for (int r = 0; r < 16; ++r) { const int orow = crow(r, hi);
#pragma unroll
        for (int d0 = 0; d0 < 4; ++d0) { const float v = o[d0][r] * rli[r];
            if constexpr (same_t<TOut, float>::v) { Ow[(size_t)orow * OPITCH + d0 * 32 + r32] = v; }
            else { const float vn = __shfl_xor(v, 1);
                   if ((r32 & 1) == 0) *(unsigned*)(Ow + (size_t)orow * OPITCH + d0 * 32 + r32) = cvtpk(v, vn); } } }
    if constexpr (F32) {
#pragma unroll
        for (int d0 = 0; d0 < 8; ++d0) S.qr[d0] = pack8(S.tq[2 * d0], S.tq[2 * d0 + 1]); }
    __syncthreads();
#undef RESC
#undef KBASE
#undef ACT
#undef MASKT
#undef ROWOFF
#undef SEAM_K0
#undef HALF_STEP
}
#undef ROW
#undef VMW
#undef VMWN
#undef SLOAD_H
#undef SWRITE_HK
#undef SWRITE_HV
#undef SWRITE_H
#undef SLOAD_F
#undef SWRITE_KF
#undef SWRITE_VF
#undef KSWZ
#undef SBAR
}
namespace mb {
__device__ __forceinline__ float bfx(short s) { return __uint_as_float(((unsigned)(unsigned short)s) << 16); }
#define MOBA_INS(g, n, TIE) do { const float g_ = (g); const int n_ = (n); \
    const bool b0_ = g_ > v0 || (TIE && g_ == v0 && n_ < i0), b1_ = g_ > v1 || (TIE && g_ == v1 && n_ < i1), b2_ = g_ > v2 || (TIE && g_ == v2 && n_ < i2); \
    v2 = b1_ ? v1 : (b2_ ? g_ : v2); i2 = b1_ ? i1 : (b2_ ? n_ : i2); \
    v1 = b0_ ? v0 : (b1_ ? g_ : v1); i1 = b0_ ? i0 : (b1_ ? n_ : i1); \
    v0 = b0_ ? g_ : v0; i0 = b0_ ? n_ : i0; } while (0)
__device__ __forceinline__ unsigned moba_select(const bf16x8 (&qr)[8], const char* kmB, int own, int lane) {
    if (own <= 3) return (1u << own) - 1u;
    const int hi = lane >> 5;
    const char* kp = kmB + (lane & 15) * 272 + hi * 16;
    f32x16 g;
#pragma unroll
    for (int r = 0; r < 16; ++r) g[r] = 0.f;
#pragma unroll
    for (int d0 = 0; d0 < 8; ++d0) {
        const bf16x8 ah = *(const bf16x8*)(kp + d0 * 32), al = *(const bf16x8*)(kp + 4352 + d0 * 32);
        g = __builtin_amdgcn_mfma_f32_32x32x16_bf16(ah, qr[d0], g, 0, 0, 0);
        g = __builtin_amdgcn_mfma_f32_32x32x16_bf16(al, qr[d0], g, 0, 0, 0);
    }
    float v0 = -INFINITY, v1 = -INFINITY, v2 = -INFINITY; int i0 = 31, i1 = 31, i2 = 31;
#pragma unroll
    for (int r = 0; r < 8; ++r) { const int n = (r & 3) + 8 * (r >> 2) + 4 * hi; MOBA_INS(n < own ? g[r] : -INFINITY, n, false); }
    float pv[3]; int pi[3];
    { const float mv[3] = {v0, v1, v2}; const int mi[3] = {i0, i1, i2};
#pragma unroll
        for (int e = 0; e < 3; ++e) {
            auto rv = __builtin_amdgcn_permlane32_swap(__float_as_uint(mv[e]), __float_as_uint(mv[e]), false, false);
            auto ri = __builtin_amdgcn_permlane32_swap((unsigned)mi[e], (unsigned)mi[e], false, false);
            pv[e] = __uint_as_float(hi ? rv[0] : rv[1]); pi[e] = (int)(hi ? ri[0] : ri[1]); } }
#pragma unroll
    for (int e = 0; e < 3; ++e) MOBA_INS(pv[e], pi[e], true);
    return (1u << i0) | (1u << i1) | (1u << i2);
}
__device__ __forceinline__ BlockRef<bf16, bf16> mk_block(const bf16* Qb, const bf16* Kb, const bf16* Vb, bf16* ATT, int first, int step, int idx, int& bh_out) {
    const int item = first + (idx >> 1) * step, bh = item >> 3, x = item & 7, qb = (idx & 1) ? x : 15 - x, b = bh >> 3, h = bh & 7;
    BlockRef<bf16, bf16> r;
    r.Q = Qb + (size_t)(b * SEQ + qb * 256) * QPITCH + h * 128;
    r.K = Kb + (size_t)(b * SEQ) * KPITCH + h * 128;
    r.V = Vb + (size_t)(b * SEQ) * KPITCH + h * 128;
    r.O = ATT + (size_t)(b * SEQ + qb * 256) * OPITCH + h * 128;
    r.P0 = qb * 256; bh_out = bh; return r;
}
__device__ __forceinline__ void prompt_attention(unsigned char* ws, char* lds, int first, int step, const int wv) {
    const bf16* Qb = (const bf16*)(ws + WS_Q); const bf16* Kb = (const bf16*)(ws + WS_K); const bf16* Vb = (const bf16*)(ws + WS_V); bf16* ATT = (bf16*)(ws + WS_ATT);
    const float* kmsum = (const float*)(ws + CTL_KMP);
    char* kmB = lds + 69632;
    if (first >= 128) return;
    const int nitems = (128 - first + step - 1) / step, nb = 2 * nitems;
    Seam<bf16> S;
    int bh; BlockRef<bf16, bf16> cur = mk_block(Qb, Kb, Vb, ATT, first, step, 0, bh);
    causal_swa_prime<bf16, bf16>(cur, 0x40000000, lds, S, wv);
    for (int i = 0; i < nb; ++i) {
        int bhn = bh; const BlockRef<bf16, bf16> nxt = (i + 1 < nb) ? mk_block(Qb, Kb, Vb, ATT, first, step, i + 1, bhn) : cur;
        int tl = wv * 64 + lane_id(); asm volatile("" : "+v"(tl));
        { const int b = bh >> 3, h = bh & 7; const float* src = kmsum + ((size_t)(b * 16) * NH + h) * HD;
            const f32x4 v = *(const f32x4*)(src + (size_t)(tl >> 5) * NH * HD + (tl & 31) * 4);
            const unsigned h0 = cvtpk(v[0], v[1]), h1 = cvtpk(v[2], v[3]);
            const unsigned l0 = cvtpk(v[0] - __uint_as_float(h0 << 16), v[1] - __uint_as_float(h0 & 0xffff0000u)), l1 = cvtpk(v[2] - __uint_as_float(h1 << 16), v[3] - __uint_as_float(h1 & 0xffff0000u));
            *(uint2*)(kmB + (tl >> 5) * 272 + (tl & 31) * 8) = make_uint2(h0, h1); *(uint2*)(kmB + 4352 + (tl >> 5) * 272 + (tl & 31) * 8) = make_uint2(l0, l1); }
        __syncthreads();
        unsigned selmask = moba_select(S.qr, kmB, cur.P0 >> 8, tl & 63);
#if PROBE_REP == 90
#pragma unroll 1
        for (int r_ = 0; r_ < 8; ++r_) { int own_ = cur.P0 >> 8; asm volatile("" : "+s"(own_)); selmask &= moba_select(S.qr, kmB, own_, tl & 63); }
#endif
        causal_swa_block<bf16, bf16>(cur, nxt, SEQ, 0x40000000, lds, S, selmask, wv);
        cur = nxt; bh = bhn;
    }
}
}

constexpr size_t CTL_SMP_GATES = CTL_SMP + 4096;
constexpr unsigned SMP_SPIN_CAP = 1u << 22;
typedef float f32x2v __attribute__((ext_vector_type(2)));
__device__ __forceinline__ void sample_scan_item(const Args& a, LAS unsigned char* lds, int b, int n, int tid, int wave, int lane) {
    const float* cache_k = a.in[2]; const int* pt = (const int*)a.in[4]; unsigned char* ws = a.ws;
    LAS float* red = (LAS float*)lds;
    LAS float* qL = (LAS float*)(lds + 32768);
    LAS float* kmr = (LAS float*)(lds + 49152);
    const int page = pt[b * NPG + 2 * n + (wave >> 2)];
    const float* base = cache_k + ((size_t)page * PAGE + (wave & 3) * 32) * 1024 + lane * 4;
    f32x4 acc[4];
#pragma unroll
    for (int c = 0; c < 4; ++c) acc[c] = (f32x4){0.f, 0.f, 0.f, 0.f};
    for (int j = 0; j < 32; j += 8) {
        f32x4 v[8][4];
#pragma unroll
        for (int jj = 0; jj < 8; ++jj)
#pragma unroll
            for (int c = 0; c < 4; ++c) v[jj][c] = __builtin_nontemporal_load((const f32x4*)(base + (size_t)(j + jj) * 1024 + c * 256));
#pragma unroll
        for (int jj = 0; jj < 8; ++jj)
#pragma unroll
            for (int c = 0; c < 4; ++c) acc[c] += v[jj][c];
    }
#pragma unroll
    for (int c = 0; c < 4; ++c) *(LAS f32x4*)(red + wave * 1024 + c * 256 + lane * 4) = acc[c];
    { const bf16* Qb = (const bf16*)(ws + WS_Q) + (size_t)(MP + b * DS) * 1024;
        const v4u qq = *(const GAS v4u*)(Qb + tid * 8); float qf[8];
#pragma unroll
        for (int e = 0; e < 4; ++e) { qf[2 * e] = __uint_as_float(qq[e] << 16); qf[2 * e + 1] = __uint_as_float(qq[e] & 0xffff0000u); }
#pragma unroll
        for (int e = 0; e < 8; ++e) qL[tid * 8 + e] = qf[e]; }
    __syncthreads();
    { float s0 = 0.f, s1 = 0.f;
#pragma unroll
        for (int w = 0; w < 8; ++w) { s0 += red[w * 1024 + tid * 2]; s1 += red[w * 1024 + tid * 2 + 1]; }
        kmr[tid * 2] = s0 * (1.f / 256.f); kmr[tid * 2 + 1] = s1 * (1.f / 256.f); }
    __syncthreads();
    {
        const int h = wave; unsigned* gates = (unsigned*)(ws + CTL_SMP_GATES);
        const float k0 = kmr[h * 128 + lane], k1 = kmr[h * 128 + lane + 64];
#pragma unroll
        for (int t = 0; t < DS; ++t) {
            float p = qL[t * 1024 + h * 128 + lane] * k0 + qL[t * 1024 + h * 128 + lane + 64] * k1;
            p = wave_sum(p);
            if (lane == 0) __hip_atomic_store(gates + ((size_t)(b * DS + t) * NH + h) * 64 + n, __float_as_uint(p), RLX_AGENT);
        }
    }
    asm volatile("s_waitcnt vmcnt(0)" ::: "memory");
    __syncthreads();
    if (tid == 0) __hip_atomic_fetch_add((unsigned*)(ws + CTL_SMP) + 64 * b, 1u, RLX_AGENT);
}
__device__ __forceinline__ void sample_attn_item(const Args& a, LAS unsigned char* lds, int b, int t, int h, int tid, int wave, int lane) {
    const float* cache_k = a.in[2]; const float* cache_v = a.in[3]; const int* pt = (const int*)a.in[4]; unsigned char* ws = a.ws;
    LAS float* lg = (LAS float*)lds;
    LAS float* oL = (LAS float*)(lds + 4096);
    gu32* ctl = (gu32*)(ws + WS_CTL);
    const int row = MP + b * DS + t;
    if (wave == 0) {
        unsigned* cnt = (unsigned*)(ws + CTL_SMP) + 64 * b; unsigned sp = 0;
        while ((unsigned)__builtin_amdgcn_readfirstlane(__hip_atomic_load(cnt, RLX_AGENT)) < 64u) {
            __builtin_amdgcn_s_sleep(2);
            if ((++sp & 255u) == 0u) { if (__hip_atomic_load((unsigned*)(ctl + CW_TMO), RLX_AGENT)) break; if (sp > SMP_SPIN_CAP) { if (lane == 0) __hip_atomic_store((unsigned*)(ctl + CW_TMO), 1u, RLX_AGENT); break; } }
        }
        __builtin_amdgcn_fence(__ATOMIC_ACQUIRE, "agent");
    }
    asm volatile("s_waitcnt vmcnt(0)" ::: "memory");
    __syncthreads();
    float gate = __uint_as_float(__hip_atomic_load((unsigned*)(ws + CTL_SMP_GATES) + ((size_t)(b * DS + t) * NH + h) * 64 + lane, RLX_AGENT));
    int sel0, sel1, sel2;
    {
        float bv = gate;
#pragma unroll
        for (int o = 1; o < 64; o <<= 1) bv = fmaxf(bv, __shfl_xor(bv, o));
        sel0 = __ffsll((long long)__ballot(gate == bv)) - 1; if (lane == sel0) gate = -3e38f;
        bv = gate;
#pragma unroll
        for (int o = 1; o < 64; o <<= 1) bv = fmaxf(bv, __shfl_xor(bv, o));
        sel1 = __ffsll((long long)__ballot(gate == bv)) - 1; if (lane == sel1) gate = -3e38f;
        bv = gate;
#pragma unroll
        for (int o = 1; o < 64; o <<= 1) bv = fmaxf(bv, __shfl_xor(bv, o));
        sel2 = __ffsll((long long)__ballot(gate == bv)) - 1;
    }
    const int pg00 = pt[b * NPG + 2 * sel0], pg01 = pt[b * NPG + 2 * sel0 + 1], pg10 = pt[b * NPG + 2 * sel1], pg11 = pt[b * NPG + 2 * sel1 + 1], pg20 = pt[b * NPG + 2 * sel2], pg21 = pt[b * NPG + 2 * sel2 + 1];
#define SMP_PAGE(g) (((g) >> 8) == 0 ? (((g) & 128) ? pg01 : pg00) : (((g) >> 8) == 1 ? (((g) & 128) ? pg11 : pg10) : (((g) & 128) ? pg21 : pg20)))
    const int sub = lane & 15, kq = lane >> 4;
    float q[8];
    { const bf16* qp = (const bf16*)(ws + WS_Q) + (size_t)row * 1024 + h * 128 + sub * 8; const v4u qq = *(const GAS v4u*)qp;
#pragma unroll
        for (int e = 0; e < 4; ++e) { q[2 * e] = __uint_as_float(qq[e] << 16); q[2 * e + 1] = __uint_as_float(qq[e] & 0xffff0000u); } }
#pragma unroll 1
    for (int it = 0; it < 24; it += 12) {
        f32x4 ka[12], kb[12];
#pragma unroll
        for (int u = 0; u < 12; ++u) {
            const int g = wave * 96 + (it + u) * 4 + kq;
            const unsigned ko = (((unsigned)SMP_PAGE(g) * PAGE + (g & 127)) * 1024 + h * 128 + sub * 8) * 4u;
            ka[u] = __builtin_nontemporal_load((const f32x4*)((const char*)cache_k + ko)); kb[u] = __builtin_nontemporal_load((const f32x4*)((const char*)cache_k + ko + 16));
        }
#pragma unroll
        for (int u = 0; u < 12; ++u) {
            float p = (q[0] * ka[u][0] + q[1] * ka[u][1]) + (q[2] * ka[u][2] + q[3] * ka[u][3]) + (q[4] * kb[u][0] + q[5] * kb[u][1]) + (q[6] * kb[u][2] + q[7] * kb[u][3]);
            p += __shfl_xor(p, 1); p += __shfl_xor(p, 2); p += __shfl_xor(p, 4); p += __shfl_xor(p, 8);
            if (sub == 0) lg[wave * 96 + (it + u) * 4 + kq] = p * 0.08838834764831845f;
        }
    }
    if (wave == 0) {
        const bf16* kp = (const bf16*)(ws + WS_K) + (size_t)(MP + b * DS + kq) * 1024 + h * 128 + sub * 8; const v4u kk = *(const GAS v4u*)kp;
        float p = 0.f;
#pragma unroll
        for (int e = 0; e < 4; ++e) p += q[2 * e] * __uint_as_float(kk[e] << 16) + q[2 * e + 1] * __uint_as_float(kk[e] & 0xffff0000u);
        p += __shfl_xor(p, 1); p += __shfl_xor(p, 2); p += __shfl_xor(p, 4); p += __shfl_xor(p, 8);
        if (sub == 0) lg[768 + kq] = kq <= t ? p * 0.08838834764831845f : -INFINITY;
    }
    __syncthreads();
    float mx = -INFINITY;
    for (int i = lane; i < 772; i += 64) mx = fmaxf(mx, lg[i]);
#pragma unroll
    for (int o = 1; o < 64; o <<= 1) mx = fmaxf(mx, __shfl_xor(mx, o));
    float sum = 0.f;
    for (int i = lane; i < 772; i += 64) sum += __expf(lg[i] - mx);
    sum = wave_sum(sum);
    __syncthreads();
    for (int i = lane; i < 96; i += 64) lg[wave * 96 + i] = __expf(lg[wave * 96 + i] - mx);
    if (wave == 0 && lane < 4) lg[768 + lane] = __expf(lg[768 + lane] - mx);
    const int kh = lane >> 5, dl = lane & 31;
    f32x4 o4 = (f32x4){0.f, 0.f, 0.f, 0.f};
#pragma unroll 1
    for (int j0 = 0; j0 < 48; j0 += 24) {
        f32x4 vv[24];
#pragma unroll
        for (int u = 0; u < 24; ++u) {
            const int g = wave * 96 + 2 * (j0 + u) + kh;
            const unsigned vo = (((unsigned)SMP_PAGE(g) * PAGE + (g & 127)) * 1024 + h * 128 + dl * 4) * 4u;
            vv[u] = __builtin_nontemporal_load((const f32x4*)((const char*)cache_v + vo));
        }
#pragma unroll
        for (int u = 0; u < 24; ++u) o4 += vv[u] * lg[wave * 96 + 2 * (j0 + u) + kh];
    }
    if (wave == 0 && kh == 0) {
        for (int j = 0; j <= t; ++j) { const bf16* vp = (const bf16*)(ws + WS_V) + (size_t)(MP + b * DS + j) * 1024 + h * 128 + dl * 4; const unsigned long long vw = *(const GAS unsigned long long*)vp;
            const float p = lg[768 + j];
            o4 += (f32x4){__uint_as_float((unsigned)vw << 16), __uint_as_float((unsigned)vw & 0xffff0000u), __uint_as_float((unsigned)(vw >> 32) << 16), __uint_as_float((unsigned)(vw >> 32) & 0xffff0000u)} * p; }
    }
#pragma unroll
    for (int e = 0; e < 4; ++e) o4[e] += __shfl_xor(o4[e], 32);
    if (kh == 0) *(LAS f32x4*)(oL + wave * 128 + dl * 4) = o4;
    __syncthreads();
    if (tid < 128) { float s = 0.f;
#pragma unroll
        for (int w = 0; w < 8; ++w) s += oL[w * 128 + tid];
        ((bf16*)(ws + WS_ATT))[(size_t)row * DM + h * 128 + tid] = (bf16)f2bf(s / sum); }
    __syncthreads();
#undef SMP_PAGE
}
__device__ __forceinline__ void sample_path(const Args& a, LAS unsigned char* lds, int ib, int nB, int tid, int wave, int lane) {
    for (int s = ib; s < DB * 64; s += nB) sample_scan_item(a, lds, s >> 6, s & 63, tid, wave, lane);
    for (int j = ib; j < MS * NH; j += nB) sample_attn_item(a, lds, j >> 5, (j >> 3) & 3, j & 7, tid, wave, lane);
}
constexpr int N_PHASES = 10;
__global__ void __launch_bounds__(NWAVES * 64, 2) fwd_kernel(Args args) {
    extern __shared__ __attribute__((aligned(16))) unsigned char lds_raw[];
    LAS unsigned char* lds = (LAS unsigned char*)lds_raw;
    volatile LAS unsigned* MISC = (volatile LAS unsigned*)(lds + MISC_OFF);
    const int tid0 = threadIdx.x, wave = __builtin_amdgcn_readfirstlane(tid0 >> 6);
#define FRESH_TID() int tid = wave * 64 + lane_id(); asm volatile("" : "+v"(tid)); const int lane = tid & 63; (void)lane
    const int G = gridDim.x; const int bx = blockIdx.x; const int vcu = (G % 8 == 0) ? (bx % 8) * (G / 8) + bx / 8 : bx;
    unsigned char* ws = args.ws;
    gu32* ctl = (gu32*)(ws + WS_CTL);
    for (int u = tid0; u < (LDS_BYTES - LDSCTL_OFF) / 4; u += NWAVES * 64) ((LAS unsigned*)(lds + LDSCTL_OFF))[u] = 0u;
    __syncthreads();
    XcdBarrier bar = xcd_barrier_post((unsigned*)(ctl + CW_BAR) + args.li * XCD_BAR_WORDS, MISC + 8, wave);
    const int lo = args.ph_lo, hi = args.ph_hi;
#define IN(k) (lo <= (k) && (k) < hi)
#define BOTH(k) (IN(k) && IN((k) + 1))
#define GRID_BAR() xcd_barrier(bar)
    unsigned long long* SS = (unsigned long long*)(ws + CTL_SS);
    float* out = args.out;
    float* o_kp = out + (size_t)MV * DM; float* o_vp = o_kp + (size_t)MP * 1024; float* o_ks = o_vp + (size_t)MP * 1024; float* o_vs = o_ks + (size_t)MS * 1024;
    float* o_cp = o_vs + (size_t)MS * 1024; float* o_cs = o_cp + (size_t)NB * 2 * CC;
    pg8::bf16_t* XB = (pg8::bf16_t*)(ws + WS_XB);

    if (IN(0)) { FRESH_TID(); p0_prologue(args, lds, vcu, G, wave, lane);
#if PROBE_REP == 0
        for (int rep_ = 0; rep_ < 4; ++rep_) { GRID_BAR(); p0_prologue(args, lds, vcu, G, wave, lane); }
#endif
        if (BOTH(0)) GRID_BAR(); }

    if (IN(1)) {
        pg8::Gemm g{XB, (const pg8::bf16_t*)(ws + WS_WIN), MP, INW, DM, DM, DM, 31, 0, 128, 128}; pg8::StaticOrder S; S.init(MP, INW, G, bx);
        pg8::EpiInProj E{SS, (const float*)(ws + WS_COS), (const float*)(ws + WS_SIN),
                         (pg8::bf16_t*)(ws + WS_Q), (pg8::bf16_t*)(ws + WS_K), (pg8::bf16_t*)(ws + WS_V), (pg8::bf16_t*)(ws + WS_G), (pg8::bf16_t*)(ws + WS_U),
                         o_kp, o_vp, o_ks, o_vs, o_cp, o_cs, (float*)(ws + CTL_KMP)};
        pg8::skinny_phase<pg8::EpiInProj>(lds + RING_OFF, g, E, bx, G, wave);
        pg8::gemm_phase<pg8::EpiInProj, pg8::StaticOrder, true, true>(lds + RING_OFF, g, S, E, wave);
        if (CONV_IN_SLOTS && GU1_END_P1 > GU1_IN_P0 && bx >= INW / 64) { FRESH_TID();
            convert_weights(args, (LAS float*)(lds + RING_OFF + wave * 16384), 1, (bx - INW / 64) * NWAVES + wave, (G - INW / 64) * NWAVES, lane, GU1_IN_P0, GU1_END_P1); }
        if (PROBE_REP == 1 || PROBE_REP == 11 || PROBE_REP == 12) { for (int rep_ = 0; rep_ < 4; ++rep_) { GRID_BAR();
            if (PROBE_REP == 12) { pg8::EpiSwiGLU El{SS, (pg8::bf16_t*)(ws + WS_END)}; pg8::gemm_phase<pg8::EpiSwiGLU, pg8::StaticOrder, true, true>(lds + RING_OFF, g, S, El, wave); }
            else { pg8::gemm_phase<pg8::EpiInProj, pg8::StaticOrder, true, true>(lds + RING_OFF, g, S, E, wave); if (PROBE_REP == 1) pg8::skinny_phase<pg8::EpiInProj>(lds + RING_OFF, g, E, bx, G, wave); } } }
        if (BOTH(1)) GRID_BAR();
    }
    if (IN(2)) { FRESH_TID();
#if MK_ATTN_EXTERNAL
        conv_pass(args, vcu, G, tid);
#else
        conv_pass(args, vcu, G, tid);
        if ((vcu & 1) == 0) mb::prompt_attention(ws, (char*)lds_raw, vcu >> 1, G >> 1, wave);
        else sample_path(args, lds, vcu >> 1, G >> 1, tid, wave, lane);
#if PROBE_REP == 2
        GRID_BAR();
        if ((vcu & 1) == 0) mb::prompt_attention(ws, (char*)lds_raw, vcu >> 1, G >> 1, wave);
        else { conv_pass(args, vcu >> 1, G >> 1, tid); sample_path(args, lds, vcu >> 1, G >> 1, tid, wave, lane); }
#endif
#if PROBE_REP == 21
        for (int rep_ = 0; rep_ < 4; ++rep_) { GRID_BAR();
        if ((vcu & 1) == 0) mb::prompt_attention(ws, (char*)lds_raw, vcu >> 1, G >> 1, wave); }
#endif
#if PROBE_REP == 23
        GRID_BAR();
        if ((vcu & 1) != 0) conv_pass(args, vcu >> 1, G >> 1, tid);
#endif
#if PROBE_REP == 24
        for (int rep_ = 0; rep_ < 4; ++rep_) { GRID_BAR();
        if ((vcu & 1) != 0) { for (int s_ = (vcu >> 1); s_ < DB * 64; s_ += (G >> 1)) sample_scan_item(args, lds, s_ >> 6, s_ & 63, tid, wave, lane); } }
#endif
#if PROBE_REP == 25
        GRID_BAR();
        if ((vcu & 1) != 0) { for (int j_ = (vcu >> 1); j_ < MS * NH; j_ += (G >> 1)) sample_attn_item(args, lds, j_ >> 5, (j_ >> 3) & 3, j_ & 7, tid, wave, lane); }
#endif
#if PROBE_REP == 22
        GRID_BAR();
        if ((vcu & 1) != 0) { conv_pass(args, vcu >> 1, G >> 1, tid); sample_path(args, lds, vcu >> 1, G >> 1, tid, wave, lane); }
#endif
#endif
        if (BOTH(2)) GRID_BAR();
    }
    if (IN(3)) { FRESH_TID();
        pg8::Gemm g{(const pg8::bf16_t*)(ws + WS_ATT), (const pg8::bf16_t*)(ws + WS_WO), MP, DM, DM, DM, DM, 31, 0, 128, 128}; pg8::StaticOrder S; S.init(MP, DM, G, bx);
        pg8::EpiResid E{XB, SS + 1 * MPAD, 0};
        pg8::skinny_phase_narrow<pg8::EpiResid>(lds + RING_OFF, g, E, bx, G, wave);
        pg8::gemm_phase<pg8::EpiResid, pg8::StaticOrder, false, true>(lds + RING_OFF, g, S, E, wave);
        if (CONV_IN_SLOTS && bx >= G / 2) convert_weights(args, (LAS float*)(lds + RING_OFF + wave * 16384), 1, (bx - G / 2) * NWAVES + wave, (G / 2) * NWAVES, lane, GU1_END_P1, GU1_END_P3);
        if (BOTH(3)) GRID_BAR();
    }
#define FFN_PHASES(l, pb) \
    if (IN(pb)) { FRESH_TID();     \
        pg8::Gemm g{XB, (const pg8::bf16_t*)(ws + WS_WGU) + (size_t)(l) * 2 * FF * DM, MP, 2 * FF, DM, DM, DM, 31, 0, 128, 128}; pg8::StaticOrder S; S.init(MP, 2 * FF, G, bx); \
        pg8::EpiSwiGLU E{SS + ((l) == 0 ? 1 : 3) * MPAD, (pg8::bf16_t*)(ws + WS_H)}; \
        if (HALF_UNITS && G == 256) { \
            pg8::HalfOrder Hh; Hh.so = S; Hh.L = 5 * G + (bx & (G / 2 - 1)); Hh.half = bx / (G / 2);     \
            S.lim = 5 * G; \
            pg8::gemm_phase<pg8::EpiSwiGLU, pg8::StaticOrder, true, true>(lds + RING_OFF, g, S, E, wave); \
            pg8::gemm_phase_hm<pg8::EpiSwiGLU, pg8::HalfOrder>(lds + RING_OFF, g, Hh, E, wave); \
            pg8::skinny_phase<pg8::EpiSwiGLU>(lds + RING_OFF, g, E, bx, G, wave); \
        } else { \
            pg8::gemm_phase<pg8::EpiSwiGLU, pg8::StaticOrder, true, true>(lds + RING_OFF, g, S, E, wave); \
            pg8::skinny_phase<pg8::EpiSwiGLU>(lds + RING_OFF, g, E, bx >= G / 2 ? bx - G / 2 : (1 << 30), G / 2, wave);     \
            if (CONV_IN_SLOTS && bx >= G / 2) convert_weights(args, (LAS float*)(lds + RING_OFF + wave * 16384), 1 + (l), (bx - G / 2) * NWAVES + wave, (G / 2) * NWAVES, lane, (l) == 0 ? (GU1_END_P3 > GU1_END_P1 ? GU1_END_P3 : GU1_END_P1) : 0, (l) == 0 ? GU1_END_P4 : (1 << 30)); \
        } \
        if ((PROBE_REP == 70 && (l) == 1) || (PROBE_REP == 72 && (l) == 0) || (PROBE_REP == 71 && (l) == 1)) { for (int rep_ = 0; rep_ < 4; ++rep_) { GRID_BAR();     \
            pg8::gemm_phase<pg8::EpiSwiGLU, pg8::StaticOrder, true, true>(lds + RING_OFF, g, S, E, wave); \
            if (PROBE_REP != 71) { pg8::skinny_phase<pg8::EpiSwiGLU>(lds + RING_OFF, g, E, bx >= G / 2 ? bx - G / 2 : (1 << 30), G / 2, wave); \
                if (bx >= G / 2) convert_weights(args, (LAS float*)(lds + RING_OFF + wave * 16384), 1 + (l), (bx - G / 2) * NWAVES + wave, (G / 2) * NWAVES, lane, 0); } } } \
        if (BOTH(pb)) GRID_BAR(); \
    } \
    if (IN((pb) + 1)) { FRESH_TID();     \
        pg8::Gemm g{(const pg8::bf16_t*)(ws + WS_H), (const pg8::bf16_t*)(ws + WS_WDN) + (size_t)(l) * DM * FF, MP, DM, FF, 64, 64, 31, 0, (size_t)MPAD * 128, (size_t)DM * 128};     pg8::StaticOrder S; S.init(MP, DM, G, bx); \
        if ((l) == 0) { \
            pg8::EpiResid E{XB, SS + 2 * MPAD, 0}; \
            pg8::skinny_phase_narrow<pg8::EpiResid>(lds + RING_OFF, g, E, bx, G, wave); \
            pg8::gemm_phase<pg8::EpiResid, pg8::StaticOrder, false, true>(lds + RING_OFF, g, S, E, wave); \
            if (CONV_IN_SLOTS && bx >= G / 2) convert_weights(args, (LAS float*)(lds + RING_OFF + wave * 16384), 1, (bx - G / 2) * NWAVES + wave, (G / 2) * NWAVES, lane, GU1_END_P4, GU1_END_P5); \
        } else { \
            pg8::EpiFinal E{XB, SS + 4 * MPAD, args.in[9], out, (unsigned*)(ws + CTL_FIN), (unsigned*)(ctl + CW_TMO)}; \
            pg8::skinny_phase_narrow<pg8::EpiFinal>(lds + RING_OFF, g, E, bx, G, wave); \
            pg8::gemm_phase<pg8::EpiFinal, pg8::StaticOrder, false, true>(lds + RING_OFF, g, S, E, wave); \
        } \
        if (BOTH((pb) + 1)) GRID_BAR(); \
    }
#if PROBE_REP == 83 || PROBE_REP == 84
    if (IN(5)) {
        for (int rep_ = 0; rep_ < 4; ++rep_) { FRESH_TID();
            if ((vcu & 1) != 0) {
                if (PROBE_REP == 83) { for (int s_ = (vcu >> 1); s_ < DB * 64; s_ += (G >> 1)) sample_scan_item(args, lds, s_ >> 6, s_ & 63, tid, wave, lane); }
                else { for (int j_ = (vcu >> 1); j_ < MS * NH; j_ += (G >> 1)) sample_attn_item(args, lds, j_ >> 5, (j_ >> 3) & 3, j_ & 7, tid, wave, lane); } }
            GRID_BAR(); }
    }
#endif
#if PROBE_REP == 82
    if (IN(5)) {
        for (int rep_ = 0; rep_ < 8; ++rep_) { FRESH_TID(); convert_weights(args, (LAS float*)(lds + RING_OFF + wave * 16384), 0, vcu * NWAVES + wave, G * NWAVES, lane); GRID_BAR(); }
    }
#endif
#if PROBE_REP == 80 || PROBE_REP == 81
    if (IN(5)) {
        for (int rep_ = 0; rep_ < 8; ++rep_) { FRESH_TID();
            if (PROBE_REP == 81) convert_weights(args, (LAS float*)(lds + RING_OFF + wave * 16384), 1, bx * NWAVES + wave, G * NWAVES, lane, 0);
            else if (bx >= G / 2) convert_weights(args, (LAS float*)(lds + RING_OFF + wave * 16384), 1, (bx - G / 2) * NWAVES + wave, (G / 2) * NWAVES, lane, 0);
            GRID_BAR(); }
    }
#endif
#if PROBE_REP >= 60 && PROBE_REP <= 65
    if (IN(5)) {
        for (int rep_ = 0; rep_ < 8; ++rep_) {
            if (PROBE_REP != 62) {
                if (PROBE_REP == 64) {
                    pg8::Gemm g{(const pg8::bf16_t*)(ws + WS_H), (const pg8::bf16_t*)(ws + WS_WDN), MP, DM, FF, 64, 64, 31, 0, (size_t)MPAD * 128, (size_t)DM * 128}; pg8::StaticOrder S; S.init(MP, DM, G, bx);
                    pg8::EpiResid E{(pg8::bf16_t*)(ws + WS_END), (unsigned long long*)(ws + WS_END + (size_t)MPAD * DM * 2), PROBE_REP == 65};
                    pg8::gemm_phase<pg8::EpiResid, pg8::StaticOrder, false, true>(lds + RING_OFF, g, S, E, wave);
                    pg8::skinny_phase_narrow<pg8::EpiResid>(lds + RING_OFF, g, E, bx, G, wave);
                } else {
                    pg8::Gemm g{(const pg8::bf16_t*)(ws + WS_ATT), (const pg8::bf16_t*)(ws + WS_WO), MP, DM, DM, DM, DM, 31, 0, 128, 128}; pg8::StaticOrder S; S.init(MP, DM, G, bx);
                    if (PROBE_REP == 63) { pg8::EpiSwiGLU E{SS, (pg8::bf16_t*)(ws + WS_END)}; pg8::gemm_phase<pg8::EpiSwiGLU, pg8::StaticOrder, false, true>(lds + RING_OFF, g, S, E, wave); }
                    else { pg8::EpiResid E{(pg8::bf16_t*)(ws + WS_END), (unsigned long long*)(ws + WS_END + (size_t)MPAD * DM * 2), PROBE_REP == 65};
                        pg8::gemm_phase<pg8::EpiResid, pg8::StaticOrder, false, true>(lds + RING_OFF, g, S, E, wave);
                        if (PROBE_REP == 60) pg8::skinny_phase_narrow<pg8::EpiResid>(lds + RING_OFF, g, E, bx, G, wave); }
                }
            }
            GRID_BAR();
        }
    }
#endif
#if PROBE_REP == 52 || PROBE_REP == 53
    if (IN(5)) {
        constexpr bool BLK = PROBE_REP == 53;
        pg8::Gemm g{XB, (const pg8::bf16_t*)(ws + WS_WIN), MP, INW, DM, BLK ? 64 : DM, BLK ? 64 : DM, 31, 0, BLK ? (size_t)MPAD * 128 : 128, BLK ? (size_t)INW * 128 : 128}; pg8::StaticOrder S; S.init(MP, INW, G, bx);
        pg8::EpiSwiGLU E{SS, (pg8::bf16_t*)(ws + WS_END)};
        pg8::gemm_phase<pg8::EpiSwiGLU, pg8::StaticOrder, true, true>(lds + RING_OFF, g, S, E, wave);
        GRID_BAR();
    }
#endif
#if PROBE_REP == 50 || PROBE_REP == 51
    if (IN(5)) {
        constexpr int LD = PROBE_REP == 50 ? FF : DM;
        pg8::Gemm g{(const pg8::bf16_t*)(ws + WS_H), (const pg8::bf16_t*)(ws + WS_WDN), MP, DM, FF, LD, LD, 31, 0, 128, 128}; pg8::StaticOrder S; S.init(MP, DM, G, bx);
        pg8::EpiResid E{(pg8::bf16_t*)(ws + WS_END), (unsigned long long*)(ws + WS_END + (size_t)MPAD * DM * 2), PROBE_REP == 65};
        pg8::gemm_phase<pg8::EpiResid, pg8::StaticOrder, false, true>(lds + RING_OFF, g, S, E, wave);
        GRID_BAR();
    }
#endif
    FFN_PHASES(0, 4)
    if (IN(6)) { FRESH_TID(); pool_pass(args, vcu, G, tid); if (PROBE_REP == 6) { for (int rep_ = 0; rep_ < 8; ++rep_) { GRID_BAR(); pool_pass(args, vcu, G, tid); } } if (BOTH(6)) GRID_BAR(); }
    if (IN(7)) { FRESH_TID();
        pg8::Gemm g{(const pg8::bf16_t*)(ws + WS_D), (const pg8::bf16_t*)(ws + WS_WPL), MP, DM, 512, DM, 512, 1, 512 * 2, 128, 128}; pg8::StaticOrder S; S.init(MP, DM, G, bx);
        pg8::EpiResid E{XB, SS + 3 * MPAD, 0};
        pg8::skinny_phase_narrow<pg8::EpiResid>(lds + RING_OFF, g, E, bx, G, wave);
        pg8::gemm_phase<pg8::EpiResid, pg8::StaticOrder, false, true>(lds + RING_OFF, g, S, E, wave);
        if (CONV_IN_SLOTS && bx >= G / 2) convert_weights(args, (LAS float*)(lds + RING_OFF + wave * 16384), 1, (bx - G / 2) * NWAVES + wave, (G / 2) * NWAVES, lane, GU1_END_P5, 1 << 30);
        if (BOTH(7)) GRID_BAR();
    }
    FFN_PHASES(1, 8)
#undef FFN_PHASES
#undef FRESH_TID
#undef IN
#undef BOTH
#undef GRID_BAR
}
extern "C" void kernel_launch(void* const* d_in, const int* in_sizes, int n_in, void* d_out, int out_size, void* d_ws, size_t ws_size, hipStream_t stream) {
    static int grid = 0;
    if (grid == 0) {
        if (n_in != 18 || ws_size < WS_END + (size_t)MPAD * DM * 8) { fprintf(stderr, "kernel_launch: built for 18 inputs and >= %zu bytes of workspace; got n_in %d, ws %zu; nothing launched\n", (size_t)WS_END, n_in, ws_size); grid = -1; return; }
        int dev = 0, cus = 0, per_cu = 0;
        if (hipGetDevice(&dev) != hipSuccess || hipDeviceGetAttribute(&cus, hipDeviceAttributeMultiprocessorCount, dev) != hipSuccess) { fprintf(stderr, "kernel_launch: device query failed\n"); grid = -1; return; }
        if (hipFuncSetAttribute((const void*)fwd_kernel, hipFuncAttributeMaxDynamicSharedMemorySize, LDS_BYTES) != hipSuccess) { fprintf(stderr, "kernel_launch: hipFuncSetAttribute failed\n"); grid = -1; return; }
        if (hipOccupancyMaxActiveBlocksPerMultiprocessor(&per_cu, (const void*)fwd_kernel, NWAVES * 64, LDS_BYTES) != hipSuccess || per_cu < 1)
            fprintf(stderr, "kernel_launch: note: occupancy query reports %d workgroups per CU\n", per_cu);
        (void)hipGetLastError();
        grid = cus;
    }
    if (grid < 0) return;
    if (hipMemsetAsync((char*)d_ws + WS_CTL, 0, CTL_ZERO_BYTES, stream) != hipSuccess) { fprintf(stderr, "kernel_launch: memset failed\n"); return; }
    Args a{};
    for (int i = 0; i < 18; ++i) a.in[i] = (const float*)d_in[i];
    a.out = (float*)d_out; a.ws = (unsigned char*)d_ws; a.pad = 0;
    unsigned char* ws = (unsigned char*)d_ws;
#if MK_ATTN_EXTERNAL
    a.ph_lo = 0; a.ph_hi = 2; a.li = 0;
    hipLaunchKernelGGL(fwd_kernel, dim3(grid), dim3(NWAVES * 64), LDS_BYTES, stream, a);
    na::k_kmean_sample<<<DB * 64 * 1024 / 256, 256, 0, stream>>>((const float*)d_in[2], (const int*)d_in[4], (float*)(ws + WS_KMS));
    na::k_attn_prompt<<<MP * 8 / 4, 256, 0, stream>>>((const bf16*)(ws + WS_Q), (const bf16*)(ws + WS_K), (const bf16*)(ws + WS_V), (const float*)(ws + CTL_KMP), (bf16*)(ws + WS_ATT));
    na::k_attn_sample<<<MS * 8 / 4, 256, 0, stream>>>((const bf16*)(ws + WS_Q), (const bf16*)(ws + WS_K), (const bf16*)(ws + WS_V), (const float*)(ws + WS_KMS),
                                                      (const float*)d_in[2], (const float*)d_in[3], (const int*)d_in[4], (bf16*)(ws + WS_ATT));
    a.ph_lo = 2; a.ph_hi = N_PHASES; a.li = 1;
    hipLaunchKernelGGL(fwd_kernel, dim3(grid), dim3(NWAVES * 64), LDS_BYTES, stream, a);
#else
    a.ph_lo = 0; a.ph_hi = N_PHASES; a.li = 0;
    hipLaunchKernelGGL(fwd_kernel, dim3(grid), dim3(NWAVES * 64), LDS_BYTES, stream, a);
#endif
    const hipError_t le = hipPeekAtLastError();
    if (le != hipSuccess) fprintf(stderr, "kernel_launch: launch failed: %s\n", hipGetErrorName(le));
}
```

```cpp
#include <hip/hip_runtime.h>
#include <hip/hip_bf16.h>
#include <cstdio>
#include <cstdint>
#include <cmath>
#ifndef MK_ATTN_EXTERNAL
#define MK_ATTN_EXTERNAL 0
#endif
#ifndef PROBE_REP
#define PROBE_REP -1
#endif
#ifndef CONV_IN_SLOTS
#define CONV_IN_SLOTS 1
#endif
#ifndef GU1_IN_P0
#define GU1_IN_P0 0
#endif
#ifndef HALF_UNITS
#define HALF_UNITS 0
#endif
#ifndef XB_NT_STORE
#define XB_NT_STORE 0
#endif
#ifndef GEMM_A_AUX
#define GEMM_A_AUX 0
#endif
#ifndef GEMM_B_AUX
#define GEMM_B_AUX 0
#endif
constexpr int DM = 2048, SEQ = 4096, NB = 2, DB = 8, DS = 4, PAST = 16384, PAGE = 128, NPG = PAST / PAGE;
constexpr int MP = NB * SEQ, MS = DB * DS, MV = MP + MS, MPAD = 8448;
constexpr int INW = 6144, FF = 5632, HD = 128, NH = 8, CC = 1024;
constexpr float RMS_EPS = 1e-6f;
constexpr float SS_SCALE = 1048576.f;
namespace pg8 {
#define PG8_LAS __attribute__((address_space(3)))
typedef unsigned short bf16_t;
typedef short bf16x8 __attribute__((ext_vector_type(8)));
typedef float f32x4 __attribute__((ext_vector_type(4)));
typedef unsigned u32x4 __attribute__((ext_vector_type(4)));
constexpr int BM = 256, BK = 64, HALF = 128, HTB = HALF * BK * 2  , STAGE_BYTES = 8 * HTB, NXCD = 8, WGM = 8;

__host__ __device__ __forceinline__ int lds_byte(int r, int c) { const int st = (r >> 4) * 2 + (c >> 5), rr = r & 15, cc = c & 31, ob = rr * 64 + cc * 2; return st * 1024 + (ob ^ (((ob >> 9) & 1) << 5)); }
__host__ __device__ __forceinline__ void stage_rc(int b, int& R, int& C) { const int st = b / 1024, sb = b % 1024, swz = sb ^ (((sb >> 9) & 1) << 5); R = (st >> 1) * 16 + swz / 64; C = (st & 1) * 32 + (swz % 64) / 2; }
__host__ __device__ __forceinline__ int perm32(int rho) { const int n = rho >> 4, i = rho & 15; return 8 * (i >> 2) + 4 * n + (i & 3); }

struct Unit { int pm, pn, half; };
struct Gemm { const bf16_t* A; const bf16_t* Bt; int M, N, K, lda, ldb, gshift, gstride; size_t kstepA, kstepB; };

struct StaticOrder {
    int nM, nN, nwg, G, c, lim;
    __host__ __device__ void init(int M, int N, int G_, int c_) { nM = M / BM; nN = N / BM; nwg = nM * nN; G = G_; c = c_; lim = nwg; }
    __host__ __device__ bool next(int i, Unit& u) const { const long L = (long)i * G + c; if (L >= lim) return false; map(L, u); return true; }
    __host__ __device__ void map(long L, Unit& u) const {
        int wgid = (int)L; { const int q = nwg / NXCD, r = nwg % NXCD, xcd = wgid % NXCD, off = wgid / NXCD; wgid = (xcd < r ? xcd * (q + 1) : r * (q + 1) + (xcd - r) * q) + off; }
        const int nig = WGM * nN, gid = wgid / nig, fm = gid * WGM, gsz = (nM - fm) < WGM ? (nM - fm) : WGM;
        u.pm = fm + ((wgid % nig) % gsz); u.pn = (wgid % nig) / gsz; u.half = 0;
    }
    __device__ __forceinline__ void a_ready(const Unit&) const {}
    __device__ __forceinline__ void done(const Unit&) const {}
};

__device__ __forceinline__ unsigned cvt_pk_bf16(float lo, float hi) { unsigned r; asm volatile("v_cvt_pk_bf16_f32 %0, %1, %2" : "=v"(r) : "v"(lo), "v"(hi)); return r; }
typedef unsigned u32x2 __attribute__((ext_vector_type(2)));
__device__ __forceinline__ float ss_to_rstd(unsigned long long s) { return rsqrtf((float)s * (1.0f / (SS_SCALE * (float)DM)) + RMS_EPS); }
__device__ __forceinline__ u32x4 pack8f(const f32x4 a, const f32x4 b) { u32x4 w; w.x = cvt_pk_bf16(a[0], a[1]); w.y = cvt_pk_bf16(a[2], a[3]); w.z = cvt_pk_bf16(b[0], b[1]); w.w = cvt_pk_bf16(b[2], b[3]); return w; }
__device__ __forceinline__ u32x2 pack4f(const f32x4 a) { u32x2 w; w.x = cvt_pk_bf16(a[0], a[1]); w.y = cvt_pk_bf16(a[2], a[3]); return w; }
template <bool GUARD>
__device__ __forceinline__ void load_rstd8(const unsigned long long* ss, int rbase, float (&rs)[2][4]) {
    unsigned long long s[2][4];
#pragma unroll
    for (int ai = 0; ai < 2; ++ai)
#pragma unroll
        for (int m = 0; m < 4; ++m) { const int row = rbase + ai * HALF + m * 16; s[ai][m] = (!GUARD || row < MV) ? ss[row] : 0ull; }
#pragma unroll
    for (int ai = 0; ai < 2; ++ai)
#pragma unroll
        for (int m = 0; m < 4; ++m) rs[ai][m] = ss_to_rstd(s[ai][m]);
}

struct EpiInProj {
    static constexpr bool PERM = true, AFTER_DRAIN = false, ACC_INIT = false;
    const unsigned long long* ss; const float* cosT; const float* sinT;
    bf16_t *Qb, *Kb, *Vb, *Gb, *Ub;
    float *o_kp, *o_vp, *o_ks, *o_vs, *o_cp, *o_cs; float* kmean;
    template <bool GUARD>
    __device__ __forceinline__ void run(const f32x4 (&acc)[2][2][4][2], const Unit& u, int wr, int wc, int fr, int fq) const {
        const int pn = u.pn, typ = pn >> 2, rbase = u.pm * BM + wr * 64 + fr;
        float rs[2][4]; load_rstd8<GUARD>(ss, rbase, rs);
        if (typ <= 1) {
            const int head = 2 * (pn & 3) + (wc >> 1), i0 = 32 * (wc & 1) + 8 * fq, colb = head * HD + i0;
            f32x4 cs[2][2];
#pragma unroll
            for (int bj = 0; bj < 2; ++bj) { cs[bj][0] = (f32x4){0.f, 0.f, 0.f, 0.f}; cs[bj][1] = (f32x4){0.f, 0.f, 0.f, 0.f}; }
#pragma unroll
            for (int am = 0; am < 4; ++am) {
                const int ai = am >> 1;
                f32x4 c4[2][2], s4[2][2];
#pragma unroll
                for (int mm = 0; mm < 2; ++mm) { const int m = (am & 1) * 2 + mm, row = rbase + ai * HALF + m * 16;
                    const int pidx = row < MP ? (row & (SEQ - 1)) : SEQ + ((row - MP) & (DS - 1));
#pragma unroll
                    for (int n = 0; n < 2; ++n) { c4[mm][n] = *(const f32x4*)(cosT + pidx * 64 + i0 + 4 * n); s4[mm][n] = *(const f32x4*)(sinT + pidx * 64 + i0 + 4 * n); } }
#pragma unroll
                for (int mm = 0; mm < 2; ++mm) {
                    const int m = (am & 1) * 2 + mm, row = rbase + ai * HALF + m * 16;
                    if (!GUARD || row < MV) {
                        const float rstd = rs[ai][m];
                        f32x4 o1[2], o2[2];
#pragma unroll
                        for (int n = 0; n < 2; ++n) { const f32x4 x1 = acc[ai][0][m][n] * rstd, x2 = acc[ai][1][m][n] * rstd;
                            o1[n] = x1 * c4[mm][n] - x2 * s4[mm][n]; o2[n] = x2 * c4[mm][n] + x1 * s4[mm][n]; }
                        bf16_t* dst = (typ == 0 ? Qb : Kb) + (size_t)row * 1024 + colb;
                        *(u32x4*)dst = pack8f(o1[0], o1[1]); *(u32x4*)(dst + 64) = pack8f(o2[0], o2[1]);
                        if (typ == 1) {
                            float* od = ((!GUARD || row < MP) ? o_kp + (size_t)row * 1024 : o_ks + (size_t)(row - MP) * 1024) + colb;
                            *(f32x4*)od = o1[0]; *(f32x4*)(od + 4) = o1[1]; *(f32x4*)(od + 64) = o2[0]; *(f32x4*)(od + 68) = o2[1];
                            cs[0][0] += o1[0]; cs[0][1] += o1[1]; cs[1][0] += o2[0]; cs[1][1] += o2[1];
                        }
                    }
                }
                asm volatile("" ::: "memory");
            }
            if (!GUARD && typ == 1) {
#pragma unroll
                for (int hf = 0; hf < 2; ++hf)
#pragma unroll
                    for (int n = 0; n < 2; ++n)
#pragma unroll
                        for (int e = 0; e < 4; ++e) {
                            float v = cs[hf][n][e];
                            v += __shfl_xor(v, 1); v += __shfl_xor(v, 2); v += __shfl_xor(v, 4); v += __shfl_xor(v, 8);
                            if (fr == 0) atomicAdd(kmean + ((size_t)u.pm * NH + head) * HD + 64 * hf + i0 + 4 * n + e, v);
                        }
            }
        } else if (typ <= 3) {
            const int colb = (pn & 3) * 256 + 32 * wc + 8 * fq;
#pragma unroll
            for (int ai = 0; ai < 2; ++ai)
#pragma unroll
                for (int m = 0; m < 4; ++m) {
                    const int row = rbase + ai * HALF + m * 16;
                    if (!GUARD || row < MV) {
                        const float rstd = rs[ai][m];
#pragma unroll
                        for (int bj = 0; bj < 2; ++bj) {
                            const f32x4 v0 = acc[ai][bj][m][0] * rstd, v1 = acc[ai][bj][m][1] * rstd;
                            *(u32x4*)((typ == 2 ? Vb : Gb) + (size_t)row * 1024 + colb + bj * HALF) = pack8f(v0, v1);
                            if (typ == 2) {
                                float* od = ((!GUARD || row < MP) ? o_vp + (size_t)row * 1024 : o_vs + (size_t)(row - MP) * 1024) + colb + bj * HALF;
                                *(f32x4*)od = v0; *(f32x4*)(od + 4) = v1;
                            }
                        }
                    }
                }
        } else {
            const int ch = (pn - 16) * 128 + 32 * wc + 8 * fq;
#pragma unroll
            for (int ai = 0; ai < 2; ++ai)
#pragma unroll
                for (int m = 0; m < 4; ++m) {
                    const int row = rbase + ai * HALF + m * 16;
                    if (!GUARD || row < MV) {
                        const float rstd = rs[ai][m], r2 = rstd * rstd;
                        const f32x4 u0 = acc[ai][0][m][0] * acc[ai][1][m][0] * r2, u1 = acc[ai][0][m][1] * acc[ai][1][m][1] * r2;
                        *(u32x4*)(Ub + (size_t)row * 1024 + ch) = pack8f(u0, u1);
                        if (!GUARD) { const int t = row & (SEQ - 1);
                            if (t >= SEQ - 2) { float* od = o_cp + ((size_t)(row >> 12) * 2 + (t - (SEQ - 2))) * CC + ch; *(f32x4*)od = u0; *(f32x4*)(od + 4) = u1; } }
                        else { const int t = (row - MP) & (DS - 1);
                            if (t >= DS - 2) { float* od = o_cs + ((size_t)((row - MP) >> 2) * 2 + (t - (DS - 2))) * CC + ch; *(f32x4*)od = u0; *(f32x4*)(od + 4) = u1; } }
                    }
                }
        }
    }
};

__device__ __forceinline__ int rcol(int pn, int wc, int bj, int fq) { return pn * BM + 64 * wc + 32 * bj + 8 * fq; }
__device__ __forceinline__ f32x4 bflo4(const u32x4 w) { return (f32x4){__uint_as_float(w.x << 16), __uint_as_float(w.x & 0xffff0000u), __uint_as_float(w.y << 16), __uint_as_float(w.y & 0xffff0000u)}; }
__device__ __forceinline__ f32x4 bfhi4(const u32x4 w) { return (f32x4){__uint_as_float(w.z << 16), __uint_as_float(w.z & 0xffff0000u), __uint_as_float(w.w << 16), __uint_as_float(w.w & 0xffff0000u)}; }
struct EpiResid {
    static constexpr bool PERM = true, AFTER_DRAIN = false, ACC_INIT = true;
    bf16_t* XB; unsigned long long* ss; int noat;
    __device__ __forceinline__ void init_load(u32x4 (&raw)[2][4][2], const Unit& u, int wr, int wc, int fr, int fq) const {
        const int rbase = u.pm * BM + wr * 64 + fr;
#pragma unroll
        for (int ai = 0; ai < 2; ++ai)
#pragma unroll
            for (int m = 0; m < 4; ++m)
#pragma unroll
                for (int bj = 0; bj < 2; ++bj) raw[ai][m][bj] = *(const u32x4*)(XB + (size_t)(rbase + ai * HALF + m * 16) * DM + rcol(u.pn, wc, bj, fq));
    }
    __device__ __forceinline__ void init_acc(f32x4 (&acc)[2][2][4][2], const u32x4 (&raw)[2][4][2]) const {
#pragma unroll
        for (int ai = 0; ai < 2; ++ai)
#pragma unroll
            for (int m = 0; m < 4; ++m)
#pragma unroll
                for (int bj = 0; bj < 2; ++bj) { acc[ai][bj][m][0] = bflo4(raw[ai][m][bj]); acc[ai][bj][m][1] = bfhi4(raw[ai][m][bj]); }
    }
    __device__ __forceinline__ void run_narrow(const f32x4 (&v)[2], int pn, int wc, int bj, int n, int fr, int fq) const {
        const int col0 = rcol(pn, wc, bj, fq) + 4 * n;
        u32x2 xo[2];
#pragma unroll
        for (int m = 0; m < 2; ++m) xo[m] = *(const u32x2*)(XB + (size_t)(MP + 16 * m + fr) * DM + col0);
#pragma unroll
        for (int m = 0; m < 2; ++m) {
            const int row = MP + 16 * m + fr;
            const f32x4 a0 = (f32x4){__uint_as_float(xo[m].x << 16), __uint_as_float(xo[m].x & 0xffff0000u), __uint_as_float(xo[m].y << 16), __uint_as_float(xo[m].y & 0xffff0000u)} + v[m];
            float part = (a0[0] * a0[0] + a0[1] * a0[1]) + (a0[2] * a0[2] + a0[3] * a0[3]);
            *(u32x2*)(XB + (size_t)row * DM + col0) = pack4f(a0);
            part += __shfl_xor(part, 16); part += __shfl_xor(part, 32);
            if (fq == 0) atomicAdd(ss + row, (unsigned long long)(part * SS_SCALE + 0.5f));
        }
    }
    template <bool GUARD>
    __device__ __forceinline__ void run(const f32x4 (&acc)[2][2][4][2], const Unit& u, int wr, int wc, int fr, int fq) const {
        const int rbase = u.pm * BM + wr * 64 + fr;
        u32x4 xo[2][4][2];
#pragma unroll
        for (int ai = 0; ai < 2; ++ai)
#pragma unroll
            for (int m = 0; m < 4; ++m) {
                const int row = rbase + ai * HALF + m * 16;
#pragma unroll
                for (int bj = 0; bj < 2; ++bj) xo[ai][m][bj] = (GUARD && row < MV) ? *(const u32x4*)(XB + (size_t)row * DM + rcol(u.pn, wc, bj, fq)) : (u32x4){0u, 0u, 0u, 0u};
            }
        asm volatile("" ::: "memory");
#pragma unroll
        for (int ai = 0; ai < 2; ++ai)
#pragma unroll
            for (int m = 0; m < 4; ++m) {
                const int row = rbase + ai * HALF + m * 16;
                float part = 0.f;
                if (!GUARD || row < MV) {
#pragma unroll
                    for (int bj = 0; bj < 2; ++bj) {
                        const f32x4 a0 = GUARD ? bflo4(xo[ai][m][bj]) + acc[ai][bj][m][0] : acc[ai][bj][m][0];
                        const f32x4 a1 = GUARD ? bfhi4(xo[ai][m][bj]) + acc[ai][bj][m][1] : acc[ai][bj][m][1];
                        part += (a0[0] * a0[0] + a0[1] * a0[1]) + (a0[2] * a0[2] + a0[3] * a0[3]) + (a1[0] * a1[0] + a1[1] * a1[1]) + (a1[2] * a1[2] + a1[3] * a1[3]);
                        if (XB_NT_STORE) __builtin_nontemporal_store(pack8f(a0, a1), (u32x4*)(XB + (size_t)row * DM + rcol(u.pn, wc, bj, fq))); else *(u32x4*)(XB + (size_t)row * DM + rcol(u.pn, wc, bj, fq)) = pack8f(a0, a1);
                    }
                }
                part += __shfl_xor(part, 16); part += __shfl_xor(part, 32);
                if (fq == 0 && (!GUARD || row < MV)) { if (!noat) atomicAdd(ss + row, (unsigned long long)(part * SS_SCALE + 0.5f)); else if (part < 0.f) ss[row] = 1ull; }
            }
    }
};

struct EpiSwiGLU {
    static constexpr bool PERM = true, AFTER_DRAIN = false, ACC_INIT = false;
    const unsigned long long* ss; bf16_t* H;
    template <bool GUARD>
    __device__ __forceinline__ void run_half(const f32x4 (&acc)[2][2][4][2], const Unit& u, int wr, int wc, int fr, int fq) const {
        const int rbase = u.pm * BM + u.half * HALF + wr * 64 + fr, col0 = u.pn * HALF + 32 * wc + 8 * fq;
        unsigned long long s[4];
#pragma unroll
        for (int m = 0; m < 4; ++m) s[m] = ss[rbase + m * 16];
#pragma unroll
        for (int m = 0; m < 4; ++m) {
            const int row = rbase + m * 16; const float rstd = ss_to_rstd(s[m]);
            f32x4 h[2];
#pragma unroll
            for (int n = 0; n < 2; ++n)
#pragma unroll
                for (int e = 0; e < 4; ++e) { const float g = acc[0][0][m][n][e] * rstd, up = acc[0][1][m][n][e] * rstd;
                    h[n][e] = g * up * __builtin_amdgcn_rcpf(1.0f + __expf(-g)); }
            *(u32x4*)(H + ((size_t)(col0 >> 6) * MPAD + row) * 64 + (col0 & 63)) = pack8f(h[0], h[1]);
        }
    }
    template <bool GUARD>
    __device__ __forceinline__ void run(const f32x4 (&acc)[2][2][4][2], const Unit& u, int wr, int wc, int fr, int fq) const {
        const int rbase = u.pm * BM + wr * 64 + fr, col0 = u.pn * HALF + 32 * wc + 8 * fq;
        float rs[2][4]; load_rstd8<GUARD>(ss, rbase, rs);
#pragma unroll
        for (int ai = 0; ai < 2; ++ai)
#pragma unroll
            for (int m = 0; m < 4; ++m) {
                const int row = rbase + ai * HALF + m * 16;
                if (!GUARD || row < MV) {
                    const float rstd = rs[ai][m];
                    f32x4 h[2];
#pragma unroll
                    for (int n = 0; n < 2; ++n)
#pragma unroll
                        for (int e = 0; e < 4; ++e) { const float g = acc[ai][0][m][n][e] * rstd, up = acc[ai][1][m][n][e] * rstd;
                            h[n][e] = g * up * __builtin_amdgcn_rcpf(1.0f + __expf(-g)); }
                    *(u32x4*)(H + ((size_t)(col0 >> 6) * MPAD + row) * 64 + (col0 & 63)) = pack8f(h[0], h[1]);
                }
            }
    }
};

struct EpiFinal {
    static constexpr bool PERM = true, AFTER_DRAIN = true, ACC_INIT = true;
    const bf16_t* XB; unsigned long long* ss; const float* gfin; float* out; unsigned* cnt; unsigned* tmo;
    __device__ __forceinline__ bool wait_count(unsigned* c, unsigned want, int lane) const {
        unsigned sp = 0;
        while ((unsigned)__builtin_amdgcn_readfirstlane(__hip_atomic_load(c, __ATOMIC_RELAXED, __HIP_MEMORY_SCOPE_AGENT)) < want) {
            __builtin_amdgcn_s_sleep(1);
            if ((++sp & 255u) == 0u) { if (__hip_atomic_load(tmo, __ATOMIC_RELAXED, __HIP_MEMORY_SCOPE_AGENT)) return false;
                if (sp > (1u << 22)) { if (lane == 0) __hip_atomic_store(tmo, 1u, __ATOMIC_RELAXED, __HIP_MEMORY_SCOPE_AGENT); return false; } }
        }
        return true;
    }
    __device__ __forceinline__ void init_load(u32x4 (&raw)[2][4][2], const Unit& u, int wr, int wc, int fr, int fq) const {
        const int rbase = u.pm * BM + wr * 64 + fr;
#pragma unroll
        for (int ai = 0; ai < 2; ++ai)
#pragma unroll
            for (int m = 0; m < 4; ++m)
#pragma unroll
                for (int bj = 0; bj < 2; ++bj) raw[ai][m][bj] = *(const u32x4*)(XB + (size_t)(rbase + ai * HALF + m * 16) * DM + rcol(u.pn, wc, bj, fq));
    }
    __device__ __forceinline__ void init_acc(f32x4 (&acc)[2][2][4][2], const u32x4 (&raw)[2][4][2]) const {
#pragma unroll
        for (int ai = 0; ai < 2; ++ai)
#pragma unroll
            for (int m = 0; m < 4; ++m)
#pragma unroll
                for (int bj = 0; bj < 2; ++bj) { acc[ai][bj][m][0] = bflo4(raw[ai][m][bj]); acc[ai][bj][m][1] = bfhi4(raw[ai][m][bj]); }
    }
    __device__ __forceinline__ void sumsq4(const f32x4 (&v)[2][4][2], int rbase, int fq) const {
#pragma unroll
        for (int m = 0; m < 4; ++m) {
            float part = 0.f;
#pragma unroll
            for (int bj = 0; bj < 2; ++bj) { const f32x4 a0 = v[bj][m][0], a1 = v[bj][m][1];
                part += (a0[0] * a0[0] + a0[1] * a0[1]) + (a0[2] * a0[2] + a0[3] * a0[3]) + (a1[0] * a1[0] + a1[1] * a1[1]) + (a1[2] * a1[2] + a1[3] * a1[3]); }
            part += __shfl_xor(part, 16); part += __shfl_xor(part, 32);
            if (fq == 0) atomicAdd(ss + rbase + m * 16, (unsigned long long)(part * SS_SCALE + 0.5f));
        }
    }
    template <int NM>
    __device__ __forceinline__ void write_y(const f32x4 (&v)[2][4][2], int rbase, int pn, int wc, int fq, bool bad) const {
        unsigned long long s[NM];
#pragma unroll
        for (int m = 0; m < NM; ++m) s[m] = __hip_atomic_load(ss + rbase + m * 16, __ATOMIC_RELAXED, __HIP_MEMORY_SCOPE_AGENT);
        f32x4 g[2][2];
#pragma unroll
        for (int bj = 0; bj < 2; ++bj)
#pragma unroll
            for (int n = 0; n < 2; ++n) g[bj][n] = *(const f32x4*)(gfin + rcol(pn, wc, bj, fq) + 4 * n);
        const float qnan = __builtin_nanf("");
#pragma unroll
        for (int m = 0; m < NM; ++m) {
            const float rstd = bad ? qnan : ss_to_rstd(s[m]);
            float* dst = out + (size_t)(rbase + m * 16) * DM;
#pragma unroll
            for (int bj = 0; bj < 2; ++bj)
#pragma unroll
                for (int n = 0; n < 2; ++n) *(f32x4*)(dst + rcol(pn, wc, bj, fq) + 4 * n) = v[bj][m][n] * rstd * g[bj][n];
        }
    }
    __device__ __forceinline__ void fused(f32x4 (&acc)[2][2][4][2], const Unit& u, int wr, int wc, int fr, int fq, PG8_LAS unsigned char* lds, int wid, int lane) const {
        const int rbase = u.pm * BM + wr * 64 + fr;
        sumsq4(acc[0], rbase, fq);
        sumsq4(acc[1], rbase + HALF, fq);
        asm volatile("s_waitcnt vmcnt(0)" ::: "memory");
        if (lane == 0) __hip_atomic_fetch_add(cnt + 64 * u.pm, 1u, __ATOMIC_RELAXED, __HIP_MEMORY_SCOPE_AGENT);
        PG8_LAS unsigned* flag = (PG8_LAS unsigned*)lds;
        if (wid == 0) { const bool ok = wait_count(cnt + 64 * u.pm, 64u, lane); __builtin_amdgcn_fence(__ATOMIC_ACQUIRE, "agent"); if (lane == 0) flag[0] = ok ? 0u : 1u; }
        asm volatile("s_waitcnt vmcnt(0) lgkmcnt(0)" ::: "memory"); __builtin_amdgcn_s_barrier(); asm volatile("" ::: "memory");
        const bool bad = flag[0] != 0u;
        write_y<4>(acc[0], rbase, u.pn, wc, fq, bad);
        write_y<4>(acc[1], rbase + HALF, u.pn, wc, fq, bad);
    }
    __device__ __forceinline__ void run_narrow(const f32x4 (&v)[2], int pn, int wc, int bj, int n, int fr, int fq) const {
        const int col0 = rcol(pn, wc, bj, fq) + 4 * n, lane = fq * 16 + fr;
        u32x2 xo[2]; f32x4 x[2];
#pragma unroll
        for (int m = 0; m < 2; ++m) xo[m] = *(const u32x2*)(XB + (size_t)(MP + 16 * m + fr) * DM + col0);
#pragma unroll
        for (int m = 0; m < 2; ++m) {
            x[m] = (f32x4){__uint_as_float(xo[m].x << 16), __uint_as_float(xo[m].x & 0xffff0000u), __uint_as_float(xo[m].y << 16), __uint_as_float(xo[m].y & 0xffff0000u)} + v[m];
            float part = (x[m][0] * x[m][0] + x[m][1] * x[m][1]) + (x[m][2] * x[m][2] + x[m][3] * x[m][3]);
            part += __shfl_xor(part, 16); part += __shfl_xor(part, 32);
            if (fq == 0) atomicAdd(ss + MP + 16 * m + fr, (unsigned long long)(part * SS_SCALE + 0.5f));
        }
        asm volatile("s_waitcnt vmcnt(0)" ::: "memory");
        if (lane == 0) __hip_atomic_fetch_add(cnt + 64 * (MP / BM), 1u, __ATOMIC_RELAXED, __HIP_MEMORY_SCOPE_AGENT);
        const bool ok = wait_count(cnt + 64 * (MP / BM), (unsigned)(DM / BM * 16), lane);
        __builtin_amdgcn_fence(__ATOMIC_ACQUIRE, "agent");
        asm volatile("s_waitcnt vmcnt(0)" ::: "memory");
        const f32x4 g4 = *(const f32x4*)(gfin + col0); const float qnan = __builtin_nanf("");
#pragma unroll
        for (int m = 0; m < 2; ++m) {
            const unsigned long long sv = __hip_atomic_load(ss + MP + 16 * m + fr, __ATOMIC_RELAXED, __HIP_MEMORY_SCOPE_AGENT);
            const float rstd = ok ? ss_to_rstd(sv) : qnan;
            *(f32x4*)(out + (size_t)(MP + 16 * m + fr) * DM + col0) = x[m] * rstd * g4;
        }
    }
};
template <class Epi, class Sched, bool ALIGN_EPI = false, bool SP2 = false>
__device__ __forceinline__ void gemm_phase(PG8_LAS unsigned char* lds, const Gemm g, const Sched& S, const Epi& E, const int wv  ) {
    int tid = wv * 64 + (int)__builtin_amdgcn_mbcnt_hi(~0u, __builtin_amdgcn_mbcnt_lo(~0u, 0u)); asm volatile("" : "+v"(tid));
    const int wid = wv, lane = tid & 63, wr = wid >> 2, wc = wid & 3, fr = lane & 15, fq = lane >> 4;
    static_assert(SP2 || !Epi::ACC_INIT, "accumulator initialisation from the epilogue's addend is wired into the SP2 prologue only");
    const int K = g.K, nt = K / BK;
    unsigned voffA[2], voffB[2];
#pragma unroll
    for (int i = 0; i < 2; ++i) { int R, C; stage_rc(tid * 16 + i * 8192, R, C); const int Rb = Epi::PERM ? ((R & ~31) + perm32(R & 31)) : R;
        voffA[i] = (unsigned)(R * g.lda + C) * 2u; voffB[i] = (unsigned)(Rb * g.ldb + C) * 2u; }
    const size_t kstepA = g.kstepA, kstepB = g.kstepB;
    const size_t hstepA = (size_t)HALF * g.lda * 2, hstepB = (size_t)HALF * g.ldb * 2;
    const size_t tstepA = 2 * hstepA, tstepB = 2 * hstepB;
    const unsigned ldsw = (unsigned)wid * 1024u;
    const int aoff = lds_byte(wr * 64 + fr, fq * 8), boff = lds_byte(wc * 32 + fr, fq * 8);
#define PG8_SA(b, h) (((b) * 2 + (h)) * HTB)
#define PG8_SB(b, h) ((4 + (b) * 2 + (h)) * HTB)
#define PG8_STAGE_AUX(bufoff, gbase, voff, aux) do { _Pragma("unroll") for (int _i = 0; _i < 2; ++_i) \
        __builtin_amdgcn_global_load_lds((const unsigned*)((const char*)(gbase) + (voff)[_i]), (PG8_LAS unsigned*)(lds + (bufoff) + ldsw + _i * 8192), 16, 0, aux); } while (0)
#define PG8_STAGE(bufoff, gbase, voff) PG8_STAGE_AUX(bufoff, gbase, voff, GEMM_A_AUX)
#define PG8_STAGEB(bufoff, gbase, voff) PG8_STAGE_AUX(bufoff, gbase, voff, GEMM_B_AUX)
#define PG8_LDA(dst, b, h) do { _Pragma("unroll") for (int m = 0; m < 4; ++m) _Pragma("unroll") for (int k = 0; k < 2; ++k) dst[m][k] = *(const PG8_LAS bf16x8*)(lds + PG8_SA(b, h) + aoff + m * 2048 + k * 1024); } while (0)
#define PG8_LDB(dst, b, h) do { _Pragma("unroll") for (int n = 0; n < 2; ++n) _Pragma("unroll") for (int k = 0; k < 2; ++k) dst[n][k] = *(const PG8_LAS bf16x8*)(lds + PG8_SB(b, h) + boff + n * 2048 + k * 1024); } while (0)
#define PG8_MMA(ai, bj, At, Bt) do { __builtin_amdgcn_s_setprio(1); _Pragma("unroll") for (int m = 0; m < 4; ++m) _Pragma("unroll") for (int n = 0; n < 2; ++n) _Pragma("unroll") for (int k = 0; k < 2; ++k) \
        acc[ai][bj][m][n] = __builtin_amdgcn_mfma_f32_16x16x32_bf16(Bt[n][k], At[m][k], acc[ai][bj][m][n], 0, 0, 0); __builtin_amdgcn_s_setprio(0); } while (0)
#define PG8_WAIT_V(n) asm volatile("s_waitcnt vmcnt(" #n ")" ::: "memory")
#define PG8_WAIT_L(n) asm volatile("s_waitcnt lgkmcnt(" #n ")" ::: "memory")
#define PG8_BAR __builtin_amdgcn_s_barrier()
#define PG8_SCHED __builtin_amdgcn_sched_barrier(0)
    Unit cur, nxt; int ui = 0;
    if (!S.next(0, cur)) return;
    f32x4 acc[2][2][4][2];
#pragma unroll
    for (int a = 0; a < 2; ++a)
#pragma unroll
        for (int b = 0; b < 2; ++b)
#pragma unroll
            for (int m = 0; m < 4; ++m)
#pragma unroll
                for (int n = 0; n < 2; ++n) acc[a][b][m][n] = (f32x4){0.f, 0.f, 0.f, 0.f};
    bf16x8 At[4][2], B0[2][2], B1[2][2];
    const char* cA = (const char*)g.A + (size_t)cur.pm * tstepA + (size_t)(cur.pn >> g.gshift) * g.gstride; const char* cB = (const char*)g.Bt + (size_t)cur.pn * tstepB;
    S.a_ready(cur);
    if constexpr (SP2) {
        PG8_STAGEB(PG8_SB(0, 0), cB, voffB); PG8_STAGEB(PG8_SB(0, 1), cB + hstepB, voffB); PG8_STAGE(PG8_SA(0, 0), cA, voffA); PG8_STAGE(PG8_SA(0, 1), cA + hstepA, voffA);
        if constexpr (Epi::ACC_INIT) {
            u32x4 raw[2][4][2];
            E.init_load(raw, cur, wr, wc, fr, fq);
            if (wr == 1) PG8_BAR;
            PG8_WAIT_V(18); PG8_BAR;
            PG8_STAGEB(PG8_SB(1, 0), cB + kstepB, voffB); PG8_STAGE(PG8_SA(1, 0), cA + kstepA, voffA); PG8_STAGEB(PG8_SB(1, 1), cB + hstepB + kstepB, voffB);
            PG8_WAIT_V(6); PG8_BAR;
            E.init_acc(acc, raw);
        } else {
        if (wr == 1) PG8_BAR;
        PG8_WAIT_V(2); PG8_BAR;
        PG8_STAGEB(PG8_SB(1, 0), cB + kstepB, voffB); PG8_STAGE(PG8_SA(1, 0), cA + kstepA, voffA); PG8_STAGEB(PG8_SB(1, 1), cB + hstepB + kstepB, voffB);
        PG8_WAIT_V(6); PG8_BAR;
        }
    } else {
        PG8_STAGEB(PG8_SB(0, 0), cB, voffB); PG8_STAGE(PG8_SA(0, 0), cA, voffA); PG8_STAGEB(PG8_SB(0, 1), cB + hstepB, voffB); PG8_STAGE(PG8_SA(0, 1), cA + hstepA, voffA);
        if (wr == 1) PG8_BAR;
        PG8_WAIT_V(4); PG8_BAR;
        PG8_STAGEB(PG8_SB(1, 0), cB + kstepB, voffB); PG8_STAGE(PG8_SA(1, 0), cA + kstepA, voffA); PG8_STAGEB(PG8_SB(1, 1), cB + hstepB + kstepB, voffB);
        PG8_WAIT_V(6); PG8_BAR;
    }
    for (;;) {
        const bool has_next = S.next(ui + 1, nxt);
        const char* nA = has_next ? (const char*)g.A + (size_t)nxt.pm * tstepA + (size_t)(nxt.pn >> g.gshift) * g.gstride : cA; const char* nB = has_next ? (const char*)g.Bt + (size_t)nxt.pn * tstepB : cB;
        for (int t = 0; t < nt; t += 2) {
            const bool last = (t == nt - 2);
            const char* a1 = cA + (size_t)(t + 1) * kstepA;
            const char* a2 = last ? nA : cA + (size_t)(t + 2) * kstepA; const char* b2 = last ? nB : cB + (size_t)(t + 2) * kstepB;
            const char* a3 = a2 + kstepA; const char* b3 = b2 + kstepB;
            if (last && has_next) S.a_ready(nxt);
            if constexpr (SP2) {
            PG8_LDB(B0, 0, 0); PG8_LDB(B1, 0, 1); PG8_SCHED; PG8_LDA(At, 0, 0); PG8_STAGE(PG8_SA(1, 1), a1 + hstepA, voffA);
            PG8_WAIT_V(8); PG8_WAIT_L(0); PG8_BAR; PG8_MMA(0, 0, At, B0); PG8_MMA(0, 1, At, B1); PG8_BAR; PG8_SCHED;
            PG8_LDA(At, 0, 1); PG8_STAGEB(PG8_SB(0, 0), b2, voffB); PG8_STAGEB(PG8_SB(0, 1), b2 + hstepB, voffB); PG8_STAGE(PG8_SA(0, 0), a2, voffA);
            PG8_WAIT_V(8); PG8_WAIT_L(0); PG8_BAR; PG8_MMA(1, 0, At, B0); PG8_MMA(1, 1, At, B1); PG8_BAR; PG8_SCHED;
            PG8_LDB(B0, 1, 0); PG8_LDB(B1, 1, 1); PG8_SCHED; PG8_LDA(At, 1, 0); PG8_STAGE(PG8_SA(0, 1), a2 + hstepA, voffA);
            PG8_WAIT_V(8); PG8_WAIT_L(0); PG8_BAR; PG8_MMA(0, 0, At, B0); PG8_MMA(0, 1, At, B1); PG8_BAR; PG8_SCHED;
            PG8_LDA(At, 1, 1); PG8_STAGEB(PG8_SB(1, 0), b3, voffB); PG8_STAGEB(PG8_SB(1, 1), b3 + hstepB, voffB); PG8_STAGE(PG8_SA(1, 0), a3, voffA);
            PG8_WAIT_V(8); PG8_WAIT_L(0); PG8_BAR; PG8_MMA(1, 0, At, B0); PG8_MMA(1, 1, At, B1); PG8_BAR; PG8_SCHED;
            } else {
            PG8_LDB(B0, 0, 0); PG8_SCHED; PG8_LDA(At, 0, 0); PG8_STAGE(PG8_SA(1, 1), a1 + hstepA, voffA);
            PG8_WAIT_L(8); PG8_BAR; PG8_WAIT_L(0); PG8_MMA(0, 0, At, B0); PG8_BAR; PG8_SCHED;
            PG8_LDB(B1, 0, 1); PG8_STAGEB(PG8_SB(0, 0), b2, voffB);
            PG8_BAR; PG8_WAIT_L(0); PG8_MMA(0, 1, At, B1); PG8_BAR;
            PG8_LDA(At, 0, 1); PG8_STAGE(PG8_SA(0, 0), a2, voffA);
            PG8_BAR; PG8_WAIT_L(0); PG8_MMA(1, 0, At, B0); PG8_BAR; PG8_SCHED;
            PG8_STAGEB(PG8_SB(0, 1), b2 + hstepB, voffB);
            PG8_WAIT_V(6); PG8_BAR; PG8_MMA(1, 1, At, B1); PG8_BAR;
            PG8_LDB(B0, 1, 0); PG8_SCHED; PG8_LDA(At, 1, 0); PG8_STAGE(PG8_SA(0, 1), a2 + hstepA, voffA);
            PG8_WAIT_L(8); PG8_BAR; PG8_WAIT_L(0); PG8_MMA(0, 0, At, B0); PG8_BAR; PG8_SCHED;
            PG8_LDB(B1, 1, 1); PG8_STAGEB(PG8_SB(1, 0), b3, voffB);
            PG8_BAR; PG8_WAIT_L(0); PG8_MMA(0, 1, At, B1); PG8_BAR;
            PG8_LDA(At, 1, 1); PG8_STAGE(PG8_SA(1, 0), a3, voffA);
            PG8_BAR; PG8_WAIT_L(0); PG8_MMA(1, 0, At, B0); PG8_BAR; PG8_SCHED;
            PG8_STAGEB(PG8_SB(1, 1), b3 + hstepB, voffB);
            PG8_WAIT_V(6); PG8_BAR; PG8_MMA(1, 1, At, B1); PG8_BAR;
            }
        }
        if constexpr (ALIGN_EPI) { if (wr == 0) PG8_BAR; }
        if constexpr (!Epi::AFTER_DRAIN) { E.template run<false>(acc, cur, wr, wc, fr, fq); S.done(cur); }
        if (!has_next) break;
#pragma unroll
        for (int a = 0; a < 2; ++a)
#pragma unroll
            for (int b = 0; b < 2; ++b)
#pragma unroll
                for (int m = 0; m < 4; ++m)
#pragma unroll
                    for (int n = 0; n < 2; ++n) acc[a][b][m][n] = (f32x4){0.f, 0.f, 0.f, 0.f};
        cur = nxt; cA = nA; cB = nB; ++ui;
        if constexpr (Epi::ACC_INIT) { u32x4 raw[2][4][2]; E.init_load(raw, cur, wr, wc, fr, fq); E.init_acc(acc, raw); }
        if constexpr (ALIGN_EPI) { if (wr == 1) PG8_BAR; }
    }
    PG8_WAIT_V(0);
    if constexpr (!ALIGN_EPI) { if (wr == 0) PG8_BAR; }
    PG8_BAR;
    if constexpr (Epi::AFTER_DRAIN) { E.fused(acc, cur, wr, wc, fr, fq, lds, wid, lane); S.done(cur); }
#undef PG8_SA
#undef PG8_SB
#undef PG8_STAGE
#undef PG8_STAGEB
#undef PG8_STAGE_AUX
#undef PG8_LDA
#undef PG8_LDB
#undef PG8_MMA
#undef PG8_WAIT_V
#undef PG8_WAIT_L
#undef PG8_BAR
#undef PG8_SCHED
}

struct HalfOrder {
    StaticOrder so; long L; int half;
    __device__ __forceinline__ bool next(int i, Unit& u) const { if (i > 0) return false; so.map(L, u); u.half = half; return true; }
    __device__ __forceinline__ void a_ready(const Unit&) const {}
    __device__ __forceinline__ void done(const Unit&) const {}
};
template <class Epi, class Sched>
__device__ __forceinline__ void gemm_phase_hm(PG8_LAS unsigned char* lds, const Gemm g, const Sched& S, const Epi& E, const int wv) {
    int tid = wv * 64 + (int)__builtin_amdgcn_mbcnt_hi(~0u, __builtin_amdgcn_mbcnt_lo(~0u, 0u)); asm volatile("" : "+v"(tid));
    const int wid = wv, lane = tid & 63, wr = wid >> 2, wc = wid & 3, fr = lane & 15, fq = lane >> 4;
    const int K = g.K, nt = K / BK;
    unsigned voffA[2], voffB[2];
#pragma unroll
    for (int i = 0; i < 2; ++i) { int R, C; stage_rc(tid * 16 + i * 8192, R, C); const int Rb = Epi::PERM ? ((R & ~31) + perm32(R & 31)) : R;
        voffA[i] = (unsigned)(R * g.lda + C) * 2u; voffB[i] = (unsigned)(Rb * g.ldb + C) * 2u; }
    const size_t kstepA = g.kstepA, kstepB = g.kstepB;
    const size_t hstepA = (size_t)HALF * g.lda * 2, hstepB = (size_t)HALF * g.ldb * 2;
    const size_t tstepA = 2 * hstepA, tstepB = 2 * hstepB;
    const unsigned ldsw = (unsigned)wid * 1024u;
    const int aoff = lds_byte(wr * 64 + fr, fq * 8), boff = lds_byte(wc * 32 + fr, fq * 8);
#define PG8_SA(b, h) (((b) * 2 + (h)) * HTB)
#define PG8_SB(b, h) ((4 + (b) * 2 + (h)) * HTB)
#define PG8_STAGE(bufoff, gbase, voff) do { _Pragma("unroll") for (int _i = 0; _i < 2; ++_i) \
        __builtin_amdgcn_global_load_lds((const unsigned*)((const char*)(gbase) + (voff)[_i]), (PG8_LAS unsigned*)(lds + (bufoff) + ldsw + _i * 8192), 16, 0, 0); } while (0)
#define PG8_LDA(dst, b, h) do { _Pragma("unroll") for (int m = 0; m < 4; ++m) _Pragma("unroll") for (int k = 0; k < 2; ++k) dst[m][k] = *(const PG8_LAS bf16x8*)(lds + PG8_SA(b, h) + aoff + m * 2048 + k * 1024); } while (0)
#define PG8_LDB(dst, b, h) do { _Pragma("unroll") for (int n = 0; n < 2; ++n) _Pragma("unroll") for (int k = 0; k < 2; ++k) dst[n][k] = *(const PG8_LAS bf16x8*)(lds + PG8_SB(b, h) + boff + n * 2048 + k * 1024); } while (0)
#define PG8_MMA(ai, bj, At, Bt) do { __builtin_amdgcn_s_setprio(1); _Pragma("unroll") for (int m = 0; m < 4; ++m) _Pragma("unroll") for (int n = 0; n < 2; ++n) _Pragma("unroll") for (int k = 0; k < 2; ++k) \
        acc[ai][bj][m][n] = __builtin_amdgcn_mfma_f32_16x16x32_bf16(Bt[n][k], At[m][k], acc[ai][bj][m][n], 0, 0, 0); __builtin_amdgcn_s_setprio(0); } while (0)
#define PG8_WAIT_V(n) asm volatile("s_waitcnt vmcnt(" #n ")" ::: "memory")
#define PG8_WAIT_L(n) asm volatile("s_waitcnt lgkmcnt(" #n ")" ::: "memory")
#define PG8_BAR __builtin_amdgcn_s_barrier()
#define PG8_SCHED __builtin_amdgcn_sched_barrier(0)
    Unit cur, nxt; int ui = 0;
    if (!S.next(0, cur)) return;
    f32x4 acc[2][2][4][2];
#pragma unroll
    for (int a = 0; a < 2; ++a)
#pragma unroll
        for (int b = 0; b < 2; ++b)
#pragma unroll
            for (int m = 0; m < 4; ++m)
#pragma unroll
                for (int n = 0; n < 2; ++n) acc[a][b][m][n] = (f32x4){0.f, 0.f, 0.f, 0.f};
    bf16x8 At[4][2], B0[2][2], B1[2][2];
    const char* cA = (const char*)g.A + (size_t)cur.pm * tstepA + (size_t)cur.half * hstepA + (size_t)(cur.pn >> g.gshift) * g.gstride; const char* cB = (const char*)g.Bt + (size_t)cur.pn * tstepB;
    PG8_STAGE(PG8_SB(0, 0), cB, voffB); PG8_STAGE(PG8_SB(0, 1), cB + hstepB, voffB); PG8_STAGE(PG8_SA(0, 0), cA, voffA);
    if (wr == 1) PG8_BAR;
    PG8_WAIT_V(0); PG8_BAR;
    PG8_STAGE(PG8_SB(1, 0), cB + kstepB, voffB); PG8_STAGE(PG8_SA(1, 0), cA + kstepA, voffA); PG8_STAGE(PG8_SB(1, 1), cB + hstepB + kstepB, voffB);
    PG8_WAIT_V(6); PG8_BAR;
    for (;;) {
        const bool has_next = S.next(ui + 1, nxt);
        const char* nA = has_next ? (const char*)g.A + (size_t)nxt.pm * tstepA + (size_t)nxt.half * hstepA + (size_t)(nxt.pn >> g.gshift) * g.gstride : cA; const char* nB = has_next ? (const char*)g.Bt + (size_t)nxt.pn * tstepB : cB;
        for (int t = 0; t < nt; t += 2) {
            const bool last = (t == nt - 2);
            const char* a2 = last ? nA : cA + (size_t)(t + 2) * kstepA; const char* b2 = last ? nB : cB + (size_t)(t + 2) * kstepB;
            const char* a3 = a2 + kstepA; const char* b3 = b2 + kstepB;
            PG8_LDB(B0, 0, 0); PG8_LDB(B1, 0, 1); PG8_SCHED; PG8_LDA(At, 0, 0);
            PG8_WAIT_V(6); PG8_WAIT_L(0); PG8_BAR; PG8_MMA(0, 0, At, B0); PG8_MMA(0, 1, At, B1); PG8_BAR; PG8_SCHED;
            PG8_STAGE(PG8_SB(0, 0), b2, voffB); PG8_STAGE(PG8_SB(0, 1), b2 + hstepB, voffB); PG8_STAGE(PG8_SA(0, 0), a2, voffA);
            PG8_WAIT_V(6); PG8_WAIT_L(0); PG8_BAR; PG8_BAR; PG8_SCHED;
            PG8_LDB(B0, 1, 0); PG8_LDB(B1, 1, 1); PG8_SCHED; PG8_LDA(At, 1, 0);
            PG8_WAIT_V(6); PG8_WAIT_L(0); PG8_BAR; PG8_MMA(0, 0, At, B0); PG8_MMA(0, 1, At, B1); PG8_BAR; PG8_SCHED;
            PG8_STAGE(PG8_SB(1, 0), b3, voffB); PG8_STAGE(PG8_SB(1, 1), b3 + hstepB, voffB); PG8_STAGE(PG8_SA(1, 0), a3, voffA);
            PG8_WAIT_V(6); PG8_WAIT_L(0); PG8_BAR; PG8_BAR; PG8_SCHED;
        }
        if (wr == 0) PG8_BAR;
        E.template run_half<false>(acc, cur, wr, wc, fr, fq); S.done(cur);
        if (!has_next) break;
#pragma unroll
        for (int b = 0; b < 2; ++b)
#pragma unroll
            for (int m = 0; m < 4; ++m)
#pragma unroll
                for (int n = 0; n < 2; ++n) acc[0][b][m][n] = (f32x4){0.f, 0.f, 0.f, 0.f};
        cur = nxt; cA = nA; cB = nB; ++ui;
        if (wr == 1) PG8_BAR;
    }
    PG8_WAIT_V(0);
    PG8_BAR;
#undef PG8_SA
#undef PG8_SB
#undef PG8_STAGE
#undef PG8_LDA
#undef PG8_LDB
#undef PG8_MMA
#undef PG8_WAIT_V
#undef PG8_WAIT_L
#undef PG8_BAR
#undef PG8_SCHED
}

__device__ __forceinline__ size_t skinny_koff(int k, size_t kstep) { return kstep == 128 ? (size_t)k * 2 : (size_t)(k >> 6) * kstep + (size_t)(k & 63) * 2; }
template <int NS>
__device__ __forceinline__ void skinny_steps(const char* Ab, const char* Bb, int k0, size_t kstepA, size_t kstepB, size_t a16, size_t b4, size_t b128, f32x4 (&acc)[2][2][2]) {
    bf16x8 a[NS][2], b[NS][2][2];
#pragma unroll
    for (int s = 0; s < NS; ++s) {
        const size_t ka = skinny_koff(k0 + 32 * s, kstepA), kb = skinny_koff(k0 + 32 * s, kstepB);
        a[s][0] = *(const bf16x8*)(Ab + ka); a[s][1] = *(const bf16x8*)(Ab + a16 + ka);
#pragma unroll
        for (int bj = 0; bj < 2; ++bj)
#pragma unroll
            for (int n = 0; n < 2; ++n) b[s][bj][n] = *(const bf16x8*)(Bb + bj * b128 + n * b4 + kb);
    }
#pragma unroll
    for (int s = 0; s < NS; ++s)
#pragma unroll
        for (int bj = 0; bj < 2; ++bj)
#pragma unroll
            for (int m = 0; m < 2; ++m)
#pragma unroll
                for (int n = 0; n < 2; ++n) acc[bj][m][n] = __builtin_amdgcn_mfma_f32_16x16x32_bf16(b[s][bj][n], a[s][m], acc[bj][m][n], 0, 0, 0);
}
template <class Epi>
__device__ __forceinline__ void skinny_phase(PG8_LAS unsigned char* lds, const Gemm g, const Epi& E, int first, int step, const int wv) {
    int tid = wv * 64 + (int)__builtin_amdgcn_mbcnt_hi(~0u, __builtin_amdgcn_mbcnt_lo(~0u, 0u)); asm volatile("" : "+v"(tid));
    const int wid = wv, lane = tid & 63, fr = lane & 15, fq = lane >> 4;
    const int nit = (g.N / BM) * 4, Kw = g.K / 8;
    PG8_LAS f32x4* R = (PG8_LAS f32x4*)lds;
    for (int it = first; it < nit; it += step) {
        const int pn = it >> 2, wc = it & 3;
        const int kw0 = wid * Kw;
        const char* Ab = (const char*)g.A + (size_t)(pn >> g.gshift) * g.gstride + ((size_t)(MP + fr) * g.lda + fq * 8) * 2;
        const char* Bb = (const char*)g.Bt + ((size_t)(pn * BM + 32 * wc + 8 * (fr >> 2) + (fr & 3)) * g.ldb + fq * 8) * 2;
        const size_t a16 = (size_t)16 * g.lda * 2, b4 = (size_t)4 * g.ldb * 2, b128 = (size_t)HALF * g.ldb * 2;
        f32x4 acc[2][2][2];
#pragma unroll
        for (int bj = 0; bj < 2; ++bj)
#pragma unroll
            for (int m = 0; m < 2; ++m)
#pragma unroll
                for (int n = 0; n < 2; ++n) acc[bj][m][n] = (f32x4){0.f, 0.f, 0.f, 0.f};
        int k = 0;
        for (; k + 128 <= Kw; k += 128) skinny_steps<4>(Ab, Bb, kw0 + k, g.kstepA, g.kstepB, a16, b4, b128, acc);
        for (; k + 64 <= Kw; k += 64) skinny_steps<2>(Ab, Bb, kw0 + k, g.kstepA, g.kstepB, a16, b4, b128, acc);
        for (; k < Kw; k += 32) skinny_steps<1>(Ab, Bb, kw0 + k, g.kstepA, g.kstepB, a16, b4, b128, acc);
#pragma unroll
        for (int bj = 0; bj < 2; ++bj)
#pragma unroll
            for (int m = 0; m < 2; ++m)
#pragma unroll
                for (int n = 0; n < 2; ++n) R[(wid * 8 + bj * 4 + m * 2 + n) * 64 + lane] = acc[bj][m][n];
        __syncthreads();
        if (wid == 0) {
            f32x4 accF[2][2][4][2];
#pragma unroll
            for (int ai = 0; ai < 2; ++ai)
#pragma unroll
                for (int bj = 0; bj < 2; ++bj)
#pragma unroll
                    for (int m = 0; m < 4; ++m)
#pragma unroll
                        for (int n = 0; n < 2; ++n) accF[ai][bj][m][n] = (f32x4){0.f, 0.f, 0.f, 0.f};
            f32x4 s8[8];
#pragma unroll
            for (int i = 0; i < 8; ++i) s8[i] = R[i * 64 + lane];
#pragma unroll 1
            for (int w = 1; w < 8; ++w) {
#pragma unroll
                for (int i = 0; i < 8; ++i) s8[i] += R[(w * 8 + i) * 64 + lane];
            }
#pragma unroll
            for (int bj = 0; bj < 2; ++bj)
#pragma unroll
                for (int m = 0; m < 2; ++m)
#pragma unroll
                    for (int n = 0; n < 2; ++n) accF[0][bj][m][n] = s8[bj * 4 + m * 2 + n];
            const Unit u{MP / BM, pn};
            E.template run<true>(accF, u, 0, wc, fr, fq);
        }
        __syncthreads();
    }
}

template <int NS>
__device__ __forceinline__ void narrow_steps(const char* Ab, const char* Bb, int k0, size_t kstepA, size_t kstepB, size_t a16, f32x4 (&acc)[2]) {
    bf16x8 a[NS][2], b[NS];
#pragma unroll
    for (int s = 0; s < NS; ++s) {
        const size_t ka = skinny_koff(k0 + 32 * s, kstepA), kb = skinny_koff(k0 + 32 * s, kstepB);
        a[s][0] = *(const bf16x8*)(Ab + ka); a[s][1] = *(const bf16x8*)(Ab + a16 + ka); b[s] = *(const bf16x8*)(Bb + kb);
    }
#pragma unroll
    for (int s = 0; s < NS; ++s)
#pragma unroll
        for (int m = 0; m < 2; ++m) acc[m] = __builtin_amdgcn_mfma_f32_16x16x32_bf16(b[s], a[s][m], acc[m], 0, 0, 0);
}
template <class Epi>
__device__ __forceinline__ void skinny_phase_narrow(PG8_LAS unsigned char* lds, const Gemm g, const Epi& E, int first, int step, const int wv) {
    int tid = wv * 64 + (int)__builtin_amdgcn_mbcnt_hi(~0u, __builtin_amdgcn_mbcnt_lo(~0u, 0u)); asm volatile("" : "+v"(tid));
    const int wid = wv, lane = tid & 63, fr = lane & 15, fq = lane >> 4;
    const int nit = (g.N / BM) * 16, Kw = g.K / 8;
    PG8_LAS f32x4* R = (PG8_LAS f32x4*)lds;
    for (int it = first; it < nit; it += step) {
        const int pn = it >> 4, wc = (it >> 2) & 3, bj = (it >> 1) & 1, n = it & 1;
        const int kw0 = wid * Kw;
        const char* Ab = (const char*)g.A + (size_t)(pn >> g.gshift) * g.gstride + ((size_t)(MP + fr) * g.lda + fq * 8) * 2;
        const char* Bb = (const char*)g.Bt + ((size_t)(pn * BM + bj * HALF + 32 * wc + 8 * (fr >> 2) + 4 * n + (fr & 3)) * g.ldb + fq * 8) * 2;
        const size_t a16 = (size_t)16 * g.lda * 2;
        f32x4 acc[2] = {(f32x4){0.f, 0.f, 0.f, 0.f}, (f32x4){0.f, 0.f, 0.f, 0.f}};
        int k = 0;
        for (; k + 256 <= Kw; k += 256) narrow_steps<8>(Ab, Bb, kw0 + k, g.kstepA, g.kstepB, a16, acc);
        for (; k + 128 <= Kw; k += 128) narrow_steps<4>(Ab, Bb, kw0 + k, g.kstepA, g.kstepB, a16, acc);
        for (; k + 64 <= Kw; k += 64) narrow_steps<2>(Ab, Bb, kw0 + k, g.kstepA, g.kstepB, a16, acc);
        for (; k < Kw; k += 32) narrow_steps<1>(Ab, Bb, kw0 + k, g.kstepA, g.kstepB, a16, acc);
        R[(wid * 2 + 0) * 64 + lane] = acc[0]; R[(wid * 2 + 1) * 64 + lane] = acc[1];
        __syncthreads();
        if (wid == 0) {
            f32x4 v[2] = {R[lane], R[64 + lane]};
#pragma unroll
            for (int w = 1; w < 8; ++w) { v[0] += R[(w * 2 + 0) * 64 + lane]; v[1] += R[(w * 2 + 1) * 64 + lane]; }
            E.run_narrow(v, pn, wc, bj, n, fr, fq);
        }
        __syncthreads();
    }
}
}
#define GAS __attribute__((address_space(1)))
#define LAS __attribute__((address_space(3)))
typedef unsigned short bf16;
typedef unsigned v4u __attribute__((ext_vector_type(4)));
typedef float f32x4 __attribute__((ext_vector_type(4)));
typedef short bf16x8 __attribute__((ext_vector_type(8)));
typedef GAS unsigned gu32;
typedef GAS unsigned long long gu64;
#define RLX_AGENT __ATOMIC_RELAXED, __HIP_MEMORY_SCOPE_AGENT
#define LDS_WAIT() asm volatile("s_waitcnt lgkmcnt(0)" ::: "memory")
#define VM_WAIT() asm volatile("s_waitcnt vmcnt(0)" ::: "memory")
__device__ __forceinline__ unsigned long long rt() { return __builtin_amdgcn_s_memrealtime(); }
__device__ __forceinline__ int lane_id() { return (int)__builtin_amdgcn_mbcnt_hi(~0u, __builtin_amdgcn_mbcnt_lo(~0u, 0u)); }
__device__ __forceinline__ unsigned f2bf(float f) { unsigned u = __builtin_bit_cast(unsigned, f); return (u + 0x7fffu + ((u >> 16) & 1u)) >> 16; }
__device__ __forceinline__ unsigned pk2(float lo, float hi) { return f2bf(lo) | (f2bf(hi) << 16); }

#define XB_TMO      128
#define XB_XCNT(j)  (256  + 64 * (j))
#define XB_XSUB(j)  (1280 + 64 * (j))
#define XB_XGEN(j)  (2304 + 64 * (j))
#define XB_TOP      3328
#define XB_TOPGEN   3392
#define XCD_BAR_WORDS 3456
#define XB_SPIN_CAP (1u << 18)

__device__ __forceinline__ unsigned xb_ld(unsigned* p)              { return __hip_atomic_load(p, __ATOMIC_RELAXED, __HIP_MEMORY_SCOPE_AGENT); }
__device__ __forceinline__ unsigned xb_add(unsigned* p, unsigned v) { return __hip_atomic_fetch_add(p, v, __ATOMIC_RELAXED, __HIP_MEMORY_SCOPE_AGENT); }
__device__ __forceinline__ unsigned xb_xcc_id() { return (unsigned)__builtin_amdgcn_s_getreg((3 << 11) | 20) & 0xFu; }
#define XB_SPIN(cond, bar) do { unsigned _sp = 0; while (cond) { __builtin_amdgcn_s_sleep(1); \
    if ((++_sp & 255u) == 0u) { if (xb_ld(&(bar)[XB_TMO])) break; if (_sp > XB_SPIN_CAP) { atomicAdd(&(bar)[XB_TMO], 1u); break; } } } } while (0)

struct XcdBarrier {
    unsigned* bar; unsigned x; int wv;
    volatile LAS unsigned* st;
};

__device__ __forceinline__ XcdBarrier xcd_barrier_post(unsigned* bar, volatile LAS unsigned* st, int wv) {
    XcdBarrier b; b.bar = bar; b.x = xb_xcc_id(); b.st = st; b.wv = wv;
    if (wv == 0 && lane_id() == 0) (void)xb_add(&bar[XB_XCNT(b.x)], 1u);
    return b;
}
__device__ __forceinline__ void xcd_barrier_complete(unsigned* bar, unsigned x, unsigned& nloc, unsigned& nx) {
    const unsigned G = gridDim.x * gridDim.y * gridDim.z;
    unsigned sum, cnt, mine, sp = 0u;
    for (;;) {
        sum = 0u; cnt = 0u; mine = 0u;
#pragma unroll
        for (unsigned j = 0; j < 16; ++j) { const unsigned c = xb_ld(&bar[XB_XCNT(j)]); sum += c; cnt += (c > 0u) ? 1u : 0u; mine = (j == x) ? c : mine; }
        if (sum == G) break;
        __builtin_amdgcn_s_sleep(1);
        if ((++sp & 255u) == 0u) { if (xb_ld(&bar[XB_TMO])) break; if (sp > XB_SPIN_CAP) { atomicAdd(&bar[XB_TMO], 1u); break; } }
    }
    nloc = mine > 0u ? mine : 1u; nx = cnt > 0u ? cnt : 1u;
}

__device__ __forceinline__ void xcd_barrier(const XcdBarrier& b) {
    asm volatile("s_waitcnt vmcnt(0)" ::: "memory");
    __syncthreads();
    if (b.wv == 0 && lane_id() == 0) {
        unsigned* bar = b.bar;
        __builtin_amdgcn_s_waitcnt(0);
        unsigned nloc = b.st[0], nx = b.st[1];
        if (nloc == 0u) { xcd_barrier_complete(bar, b.x, nloc, nx); b.st[0] = nloc; b.st[1] = nx; }
        const unsigned old = xb_add(&bar[XB_XSUB(b.x)], 1u);
        const unsigned gen = old / nloc;
        if (old + 1u == (gen + 1u) * nloc) {
            __builtin_amdgcn_fence(__ATOMIC_RELEASE, "agent");
            asm volatile("s_waitcnt vmcnt(0)" ::: "memory");
            const unsigned og = xb_add(&bar[XB_TOP], 1u);
            const unsigned tg = og / nx;
            if (og + 1u == (tg + 1u) * nx) xb_add(&bar[XB_TOPGEN], 1u);
            else XB_SPIN(xb_ld(&bar[XB_TOPGEN]) == tg, bar);
            __builtin_amdgcn_fence(__ATOMIC_ACQUIRE, "agent");
            xb_add(&bar[XB_XGEN(b.x)], 1u);
            asm volatile("s_waitcnt vmcnt(0)" ::: "memory");
        } else {
            XB_SPIN(xb_ld(&bar[XB_XGEN(b.x)]) == gen, bar);
            __builtin_amdgcn_fence(__ATOMIC_ACQUIRE, "agent");
            asm volatile("s_waitcnt vmcnt(0)" ::: "memory");
        }
    }
    __syncthreads();
}
constexpr size_t MiB = 1u << 20;
constexpr size_t WS_CTL = 0, CTL_ZERO_BYTES = 2 * MiB;
constexpr int CW_TMO = 0, CW_CODE = 1, CW_BAR = 1024;
constexpr size_t CTL_SS = 128 * 1024;
constexpr size_t CTL_KMP = 512 * 1024;
constexpr size_t CTL_SMP = 768 * 1024;
constexpr size_t CTL_CONVQ = 960 * 1024;
constexpr size_t CTL_FIN = 896 * 1024;
constexpr size_t WS_COS = 2 * MiB, WS_SIN = 4 * MiB;
constexpr size_t WS_WIN = 6 * MiB;
constexpr size_t WS_WO = WS_WIN + (size_t)INW * DM * 2;
constexpr size_t WS_WGU = WS_WO + (size_t)DM * DM * 2;
constexpr size_t WS_WDN = WS_WGU + (size_t)2 * 2 * FF * DM * 2;
constexpr size_t WS_WPL = WS_WDN + (size_t)2 * DM * FF * 2;
constexpr size_t WS_XB = WS_WPL + (size_t)DM * 512 * 2;
constexpr size_t WS_X = WS_XB + (size_t)MPAD * DM * 2;
constexpr size_t WS_Q = WS_X + (size_t)MPAD * DM * 4;
constexpr size_t WS_K = WS_Q + (size_t)MPAD * 1024 * 2, WS_V = WS_K + (size_t)MPAD * 1024 * 2, WS_G = WS_V + (size_t)MPAD * 1024 * 2, WS_U = WS_G + (size_t)MPAD * 1024 * 2;
constexpr size_t WS_ATT = WS_U + (size_t)MPAD * 1024 * 2;
constexpr size_t WS_H = WS_ATT + (size_t)MPAD * DM * 2;
constexpr size_t WS_D = WS_H + (size_t)MPAD * FF * 2;
constexpr size_t WS_KMS = WS_D + (size_t)MPAD * DM * 2;
constexpr size_t WS_END = WS_KMS + (size_t)DB * 64 * 1024 * 4;
static_assert(CTL_SS + 5 * MPAD * 8 <= CTL_KMP && CTL_KMP + 32 * 1024 * 4 <= CTL_SMP && (CW_BAR + 3 * 3456) * 4 <= (int)CTL_SS, "control region map");

constexpr int NWAVES = 8;
constexpr int RING_OFF = 0, RING_BYTES = 131072;
constexpr int LDSCTL_OFF = RING_BYTES, MISC_OFF = LDSCTL_OFF + 320;
constexpr int LDS_BYTES = 147456;
static_assert(MISC_OFF + 128 <= LDS_BYTES, "LDS map");
__device__ __forceinline__ float bf2f(unsigned short h) { return __uint_as_float(((unsigned)h) << 16); }
__device__ __forceinline__ float wave_sum(float v) {
#pragma unroll
    for (int o = 1; o < 64; o <<= 1) v += __shfl_xor(v, o);
    return v;
}
struct Args {
    const float* in[18]; float* out; unsigned char* ws;
    int ph_lo, ph_hi, li, pad;
};

__device__ __forceinline__ int inproj_src_col(int r) {
    const int pn = r >> 8, bj = (r >> 7) & 1, jj = r & 127;
    if (pn < 8) return (pn >> 2) * 1024 + (2 * (pn & 3) + (jj >> 6)) * 128 + 64 * bj + (jj & 63);
    if (pn < 16) return r;
    return 4096 + 1024 * bj + 128 * (pn - 16) + jj;
}
__device__ __forceinline__ int resid_src_col(int r) { const int rho = r & 255; return (r & ~255) + 64 * ((rho >> 5) & 3) + 32 * (rho >> 7) + (rho & 31); }
struct TItem { const float* W; const float* gain; const float* cscale; bf16* WT; int ldw, scol4, ldk, drow0, k0, kblk; };
__device__ __forceinline__ void titem_load(const TItem& t, int lane, f32x4 (&v)[8], float (&g)[8]) {
    const int kr = lane >> 3;
#pragma unroll
    for (int i = 0; i < 8; ++i) v[i] = __builtin_nontemporal_load((const GAS f32x4*)(t.W + (size_t)(t.k0 + 8 * i + kr) * t.ldw + t.scol4));
#pragma unroll
    for (int i = 0; i < 8; ++i) g[i] = t.gain ? t.gain[t.k0 + 8 * i + kr] : 1.0f;
}
__device__ __forceinline__ void titem_store(const TItem& t, int lane, const f32x4 (&v)[8], const float (&g)[8], LAS float* scr) {
    const int kr = lane >> 3, n4 = lane & 7;
#pragma unroll
    for (int i = 0; i < 8; ++i) { LAS float* d = scr + (8 * i + kr) * 33 + 4 * n4; d[0] = v[i].x * g[i]; d[1] = v[i].y * g[i]; d[2] = v[i].z * g[i]; d[3] = v[i].w * g[i]; }
    LDS_WAIT(); asm volatile("" ::: "memory");
    const int c = lane & 7;
#pragma unroll
    for (int j = 0; j < 4; ++j) { const int n = (lane >> 3) + 8 * j; const LAS float* s = scr + (8 * c) * 33 + n; const float cs = t.cscale ? t.cscale[resid_src_col(t.drow0 + n)] : 1.0f;
        v4u o; o.x = pk2(s[0 * 33] * cs, s[1 * 33] * cs); o.y = pk2(s[2 * 33] * cs, s[3 * 33] * cs); o.z = pk2(s[4 * 33] * cs, s[5 * 33] * cs); o.w = pk2(s[6 * 33] * cs, s[7 * 33] * cs);
        bf16* d = t.kblk ? t.WT + ((size_t)(t.k0 >> 6) * t.kblk + t.drow0 + n) * 64 + 8 * c : t.WT + (size_t)(t.drow0 + n) * t.ldk + t.k0 + 8 * c;
        *(GAS v4u*)d = o; }
    LDS_WAIT(); asm volatile("" ::: "memory");
}

__device__ __forceinline__ TItem titem_decode(const Args& a, int set, int it, int lane) {
    unsigned char* ws = a.ws;
    constexpr int I_IN = (DM / 64) * (INW / 32), I_O = (DM / 64) * (DM / 32), I_GU = (DM / 64) * (2 * FF / 32), I_DN = (FF / 64) * (DM / 32);
    TItem t; int r = it; const int l = set == 0 ? 0 : 1; const int l4 = 4 * (lane & 7);
    if (set == 0) {
        if (r < I_IN) { const int nb = r % (INW / 32), kb = r / (INW / 32);
            t.W = a.in[10]; t.gain = a.in[7]; t.cscale = nullptr; t.WT = (bf16*)(ws + WS_WIN); t.ldw = INW; t.scol4 = inproj_src_col(nb * 32 + l4); t.ldk = DM; t.drow0 = nb * 32; t.k0 = kb * 64; t.kblk = 0; return t; }
        r -= I_IN;
        if (r < I_O) { const int nb = r % (DM / 32), kb = r / (DM / 32);
            t.W = a.in[12]; t.gain = nullptr; t.cscale = nullptr; t.WT = (bf16*)(ws + WS_WO); t.ldw = DM; t.scol4 = resid_src_col(nb * 32 + l4); t.ldk = DM; t.drow0 = nb * 32; t.k0 = kb * 64; t.kblk = 0; return t; }
        r -= I_O;
    }
    if (set == 2) r += I_GU;
    if (r < I_GU) { const int nb = r % (2 * FF / 32), kb = r / (2 * FF / 32);
        const int drow = nb * 32, pn = drow >> 8, bj = (drow >> 7) & 1, jj = drow & 127;
        t.W = (bj ? a.in[16] : a.in[15]) + (size_t)l * DM * FF; t.gain = a.in[8] + l * DM; t.cscale = nullptr; t.WT = (bf16*)(ws + WS_WGU) + (size_t)l * 2 * FF * DM;
        t.ldw = FF; t.scol4 = pn * 128 + jj + l4; t.ldk = DM; t.drow0 = drow; t.k0 = kb * 64; t.kblk = 0; return t; }
    r -= I_GU;
    if (r < I_DN) { const int nb = r % (DM / 32), kb = r / (DM / 32);
        t.W = a.in[17] + (size_t)l * FF * DM; t.gain = nullptr; t.cscale = nullptr; t.WT = (bf16*)(ws + WS_WDN) + (size_t)l * DM * FF; t.ldw = DM; t.scol4 = resid_src_col(nb * 32 + l4); t.ldk = FF; t.drow0 = nb * 32; t.k0 = kb * 64; t.kblk = DM; return t; }
    r -= I_DN;
    { const int g = r / 128; r -= g * 128; const int nb = r % 16, kb = r / 16;
        t.W = a.in[13] + (size_t)g * 512 * 512; t.gain = nullptr; t.cscale = a.in[14]; t.WT = (bf16*)(ws + WS_WPL); t.ldw = 512; t.scol4 = resid_src_col(g * 512 + nb * 32 + l4) - g * 512; t.ldk = 512; t.drow0 = g * 512 + nb * 32; t.k0 = kb * 64; t.kblk = 0; return t; }
}
__device__ __forceinline__ void convert_weights(const Args& a, LAS float* scr, int set, int gw, int NGW, int lane, int lo = 0, int hi = 1 << 30) {
    constexpr int I_IN = (DM / 64) * (INW / 32), I_O = (DM / 64) * (DM / 32), I_GU = (DM / 64) * (2 * FF / 32), I_DN = (FF / 64) * (DM / 32), I_PL = 4 * (512 / 64) * (512 / 32);
    int nitems = set == 0 ? I_IN + I_O + I_GU + I_DN + I_PL : (set == 1 ? I_GU : I_DN); if (hi < nitems) nitems = hi;
    for (int base = lo + gw; base < nitems; base += 4 * NGW) {
        TItem t[4]; f32x4 v[4][8]; float g[4][8];
#pragma unroll
        for (int j = 0; j < 4; ++j) { const int it = base + j * NGW; if (it < nitems) { t[j] = titem_decode(a, set, it, lane); titem_load(t[j], lane, v[j], g[j]); } }
#pragma unroll
        for (int j = 0; j < 4; ++j) { const int it = base + j * NGW; if (it < nitems) titem_store(t[j], lane, v[j], g[j], scr); }
    }
}
__device__ __forceinline__ void convert_weights_queue(const Args& a, LAS float* scr, int set, unsigned* ctr, int lane) {
    constexpr int I_GU = (DM / 64) * (2 * FF / 32), I_DN = (FF / 64) * (DM / 32);
    const int nitems = set == 1 ? I_GU : I_DN;
    for (;;) {
        unsigned b0 = 0; if (lane == 0) b0 = __hip_atomic_fetch_add(ctr, 4u, RLX_AGENT);
        const int base = (int)__builtin_amdgcn_readfirstlane(b0);
        if (base >= nitems) break;
        TItem t[4]; f32x4 v[4][8]; float g[4][8];
#pragma unroll
        for (int j = 0; j < 4; ++j) { const int it = base + j; if (it < nitems) { t[j] = titem_decode(a, set, it, lane); titem_load(t[j], lane, v[j], g[j]); } }
#pragma unroll
        for (int j = 0; j < 4; ++j) { const int it = base + j; if (it < nitems) titem_store(t[j], lane, v[j], g[j], scr); }
    }
}
__device__ __forceinline__ void p0_prologue(const Args& a, LAS unsigned char* lds, int vcu, int G, int wave, int lane) {
    unsigned char* ws = a.ws;
    LAS float* scr = (LAS float*)(lds + RING_OFF + wave * 16384);
    const int gw = vcu * NWAVES + wave, NGW = G * NWAVES;
    convert_weights(a, scr, 0, gw, NGW, lane);
    if (!CONV_IN_SLOTS) { convert_weights(a, scr, 1, gw, NGW, lane); convert_weights(a, scr, 2, gw, NGW, lane); }
    else convert_weights(a, scr, 1, gw, NGW, lane, 0, GU1_IN_P0);
    bf16* XB = (bf16*)(ws + WS_XB); unsigned long long* SS0 = (unsigned long long*)(ws + CTL_SS);
    {
        constexpr int NRW = (MV + 2047) / 2048 + 1;
        for (int m0 = gw; m0 < MV; m0 += NRW * NGW) {
            f32x4 v[NRW][8];
#pragma unroll
            for (int r = 0; r < NRW; ++r) { const int m = m0 + r * NGW;
                if (m < MV) { const float* xrow = m < MP ? a.in[0] + (size_t)m * DM : a.in[1] + (size_t)(m - MP) * DM;
                    const GAS f32x4* xr = (const GAS f32x4*)xrow + lane;
#pragma unroll
                    for (int j = 0; j < 8; ++j) v[r][j] = __builtin_nontemporal_load(xr + 64 * j); } }
#pragma unroll
            for (int r = 0; r < NRW; ++r) { const int m = m0 + r * NGW;
                if (m < MV) { float s = 0.f;
#pragma unroll
                    for (int j = 0; j < 8; ++j) s += (v[r][j].x * v[r][j].x + v[r][j].y * v[r][j].y) + (v[r][j].z * v[r][j].z + v[r][j].w * v[r][j].w);
                    s = wave_sum(s);
                    GAS unsigned long long* o8 = (GAS unsigned long long*)(XB + (size_t)m * DM) + lane;
#pragma unroll
                    for (int j = 0; j < 8; ++j) o8[64 * j] = (unsigned long long)pk2(v[r][j].x, v[r][j].y) | ((unsigned long long)pk2(v[r][j].z, v[r][j].w) << 32);
                    if (lane == 0) SS0[m] = (unsigned long long)(s * SS_SCALE + 0.5f); } }
        }
    }
    float* cosT = (float*)(ws + WS_COS); float* sinT = (float*)(ws + WS_SIN);
    for (int i = gw * 64 + lane; i < (SEQ + DS) * 64; i += NGW * 64) {
        const int p = i >> 6, ii = i & 63; const int pos = p < SEQ ? p : PAST + (p - SEQ);
        const float inv = powf(10000.f, -(float)ii / 64.f); const float ang = (float)pos * inv;
        cosT[i] = cosf(ang); sinT[i] = sinf(ang);
    }
}

__device__ __forceinline__ void unpack8(const v4u w, float (&f)[8]) {
#pragma unroll
    for (int e = 0; e < 4; ++e) { f[2 * e] = __uint_as_float(w[e] << 16); f[2 * e + 1] = __uint_as_float(w[e] & 0xffff0000u); }
}
__device__ __forceinline__ void conv_pass(const Args& a, int vcu, int G, int tid) {
    unsigned char* ws = a.ws;
    const bf16* Ub = (const bf16*)(ws + WS_U); const bf16* Gb = (const bf16*)(ws + WS_G); bf16* ATT = (bf16*)(ws + WS_ATT);
    const float* conv_w = a.in[11]; const float* state_conv = a.in[5];
    const int nthr = G * NWAVES * 64;
    for (int it = vcu * NWAVES * 64 + tid; it < (MV / 4) * 128; it += nthr) {
        const int r0 = (it >> 7) * 4, ch = (it & 127) * 8;
        const bool smp = r0 >= MP;
        const int t0 = smp ? 0 : r0 & (SEQ - 1), b = smp ? (r0 - MP) >> 2 : r0 >> 12;
        v4u up[6], gp[4];
#pragma unroll
        for (int j = 0; j < 4; ++j) { up[j + 2] = *(const GAS v4u*)(Ub + (size_t)(r0 + j) * 1024 + ch); gp[j] = *(const GAS v4u*)(Gb + (size_t)(r0 + j) * 1024 + ch); }
        float u[6][8];
        if (t0 >= 2) { up[0] = *(const GAS v4u*)(Ub + (size_t)(r0 - 2) * 1024 + ch); up[1] = *(const GAS v4u*)(Ub + (size_t)(r0 - 1) * 1024 + ch); unpack8(up[0], u[0]); unpack8(up[1], u[1]); }
        else if (smp) { const float* s0 = state_conv + ((size_t)b * 2) * CC + ch;
#pragma unroll
            for (int e = 0; e < 8; ++e) { u[0][e] = s0[e]; u[1][e] = s0[CC + e]; } }
        else {
#pragma unroll
            for (int e = 0; e < 8; ++e) { u[0][e] = 0.f; u[1][e] = 0.f; } }
#pragma unroll
        for (int j = 2; j < 6; ++j) unpack8(up[j], u[j]);
        float w0[8], w1[8], w2[8];
#pragma unroll
        for (int e = 0; e < 8; ++e) { w0[e] = conv_w[ch + e]; w1[e] = conv_w[CC + ch + e]; w2[e] = conv_w[2 * CC + ch + e]; }
#pragma unroll
        for (int j = 0; j < 4; ++j) {
            float gb[8], y[8]; unpack8(gp[j], gb);
#pragma unroll
            for (int e = 0; e < 8; ++e) y[e] = gb[e] * (w0[e] * u[j][e] + w1[e] * u[j + 1][e] + w2[e] * u[j + 2][e]);
            v4u o; o.x = pk2(y[0], y[1]); o.y = pk2(y[2], y[3]); o.z = pk2(y[4], y[5]); o.w = pk2(y[6], y[7]);
            *(GAS v4u*)(ATT + (size_t)(r0 + j) * DM + 1024 + ch) = o;
        }
    }
}

__device__ __forceinline__ f32x4 pool_h(const bf16* XBp, const unsigned long long* ss, int row, int c, const f32x4 g) {
    const float rstd = rsqrtf((float)ss[row] * (1.0f / (SS_SCALE * (float)DM)) + RMS_EPS);
    const unsigned long long w = *(const GAS unsigned long long*)(XBp + (size_t)row * DM + c);
    const f32x4 x = (f32x4){__uint_as_float((unsigned)w << 16), __uint_as_float((unsigned)w & 0xffff0000u), __uint_as_float((unsigned)(w >> 32) << 16), __uint_as_float((unsigned)(w >> 32) & 0xffff0000u)};
    return x * rstd * g;
}
__device__ __forceinline__ f32x4 pool_unpack(unsigned long long w) {
    return (f32x4){__uint_as_float((unsigned)w << 16), __uint_as_float((unsigned)w & 0xffff0000u), __uint_as_float((unsigned)(w >> 32) << 16), __uint_as_float((unsigned)(w >> 32) & 0xffff0000u)};
}
template <int W, int NRW>
__device__ __forceinline__ void pool_rows(const bf16* XBp, const unsigned long long* ss, bf16* Dd, float* o_pp, int r0, int t0, int bb, int c, const f32x4 g) {
    constexpr int NR = W - 1 + NRW;
    unsigned long long raw[NR]; float rs[NR];
#pragma unroll
    for (int i = 0; i < NR; ++i) { const int dr = i - (W - 1); const bool ok = t0 + dr >= 0;
        raw[i] = ok ? *(const GAS unsigned long long*)(XBp + (size_t)(r0 + dr) * DM + c) : 0ull;
        rs[i] = ok ? rsqrtf((float)ss[r0 + dr] * (1.0f / (SS_SCALE * (float)DM)) + RMS_EPS) : 0.f; }
    f32x4 S = (f32x4){0.f, 0.f, 0.f, 0.f};
#pragma unroll
    for (int i = 0; i < W - 1; ++i) S += pool_unpack(raw[i]) * rs[i] * g;
#pragma unroll
    for (int j = 0; j < NRW; ++j) {
        const int t = t0 + j; const f32x4 hv = pool_unpack(raw[W - 1 + j]) * rs[W - 1 + j] * g;
        S += hv;
        const float cnt = (float)((t + 1) < W ? (t + 1) : W);
        const f32x4 d = S * (1.0f / cnt) - hv;
        *(GAS unsigned long long*)(Dd + (size_t)(r0 + j) * DM + c) = (unsigned long long)pk2(d.x, d.y) | ((unsigned long long)pk2(d.z, d.w) << 32);
        S -= pool_unpack(raw[j]) * rs[j] * g;
        if (t >= SEQ - 15) *(GAS f32x4*)(o_pp + ((size_t)bb * 15 + (t - (SEQ - 15))) * DM + c) = hv;
    }
}
template <int W>
__device__ __forceinline__ void pool_sample(const bf16* XBp, const unsigned long long* ss, bf16* Dd, const float* hist, float* o_ps, int b, int c, const f32x4 g) {
    const int r0 = MP + b * DS;
    f32x4 hs[15]; unsigned long long raw[DS]; float rs[DS];
#pragma unroll
    for (int j = 0; j < 15; ++j) hs[j] = *(const f32x4*)(hist + (size_t)j * DM);
#pragma unroll
    for (int t = 0; t < DS; ++t) { raw[t] = *(const GAS unsigned long long*)(XBp + (size_t)(r0 + t) * DM + c); rs[t] = rsqrtf((float)ss[r0 + t] * (1.0f / (SS_SCALE * (float)DM)) + RMS_EPS); }
    f32x4 h[DS];
#pragma unroll
    for (int t = 0; t < DS; ++t) h[t] = pool_unpack(raw[t]) * rs[t] * g;
    f32x4 S = (f32x4){0.f, 0.f, 0.f, 0.f};
#pragma unroll
    for (int j = 1; j <= W - 1; ++j) S += hs[15 - j];
#pragma unroll
    for (int t = 0; t < DS; ++t) {
        S += h[t];
        const f32x4 d = S * (1.0f / (float)W) - h[t];
        *(GAS unsigned long long*)(Dd + (size_t)(r0 + t) * DM + c) = (unsigned long long)pk2(d.x, d.y) | ((unsigned long long)pk2(d.z, d.w) << 32);
        const int to = t - (W - 1);
        if (to >= 0) S -= h[to >= 0 ? to : 0]; else S -= hs[15 + to >= 0 ? 15 + to : 0];
        *(GAS f32x4*)(o_ps + ((size_t)b * 15 + 11 + t) * DM + c) = h[t];
    }
#pragma unroll
    for (int j = 0; j < 11; ++j) *(GAS f32x4*)(o_ps + ((size_t)b * 15 + j) * DM + c) = hs[j + 4];
}
__device__ __forceinline__ void pool_pass(const Args& a, int vcu, int G, int tid) {
    unsigned char* ws = a.ws;
    const bf16* X = (const bf16*)(ws + WS_XB); const unsigned long long* ss = (const unsigned long long*)(ws + CTL_SS) + 2 * MPAD;
    bf16* Dd = (bf16*)(ws + WS_D);
    const float* state_pool = a.in[6]; const float* gmix = a.in[7] + DM;
    float* o_pp = a.out + (size_t)MV * DM + 2 * (size_t)MP * 1024 + 2 * (size_t)MS * 1024 + (size_t)NB * 2 * CC + (size_t)DB * 2 * CC;
    float* o_ps = o_pp + (size_t)NB * 15 * DM;
    const int c = tid * 4, grp = __builtin_amdgcn_readfirstlane(c >> 9);
    const f32x4 g = *(const f32x4*)(gmix + c);
    if (vcu >= G - DB) { const int b = vcu - (G - DB); const float* hist = state_pool + (size_t)b * 15 * DM + c;
        if (grp == 0) pool_sample<2>(X, ss, Dd, hist, o_ps, b, c, g); else if (grp == 1) pool_sample<4>(X, ss, Dd, hist, o_ps, b, c, g);
        else if (grp == 2) pool_sample<8>(X, ss, Dd, hist, o_ps, b, c, g); else pool_sample<16>(X, ss, Dd, hist, o_ps, b, c, g); }
    for (int it = vcu; it < MP / 32; it += G) {
        const int r0 = it * 32, t0 = r0 & (SEQ - 1), bb = r0 >> 12;
#pragma unroll 1
        for (int q = 0; q < 2; ++q) {
            if (grp == 0) pool_rows<2, 16>(X, ss, Dd, o_pp, r0 + 16 * q, t0 + 16 * q, bb, c, g);
            else if (grp == 1) pool_rows<4, 16>(X, ss, Dd, o_pp, r0 + 16 * q, t0 + 16 * q, bb, c, g);
            else if (grp == 2) pool_rows<8, 16>(X, ss, Dd, o_pp, r0 + 16 * q, t0 + 16 * q, bb, c, g);
            else pool_rows<16, 16>(X, ss, Dd, o_pp, r0 + 16 * q, t0 + 16 * q, bb, c, g);
        }
    }
}

__device__ __forceinline__ void final_norm(const Args& a, int vcu, int G, int wave, int lane) {
    unsigned char* ws = a.ws;
    const bf16* X = (const bf16*)(ws + WS_XB); const unsigned long long* ss = (const unsigned long long*)(ws + CTL_SS) + 4 * MPAD;
    const float* gf = a.in[9];
    const int gw = vcu * NWAVES + wave, NGW = G * NWAVES;
    f32x4 g[8];
#pragma unroll
    for (int j = 0; j < 8; ++j) g[j] = *(const f32x4*)(gf + 4 * (lane + 64 * j));
    for (int m = gw; m < MV; m += NGW) {
        const float rstd = rsqrtf((float)ss[m] * (1.0f / (SS_SCALE * (float)DM)) + RMS_EPS);
        const GAS unsigned long long* xr = (const GAS unsigned long long*)(X + (size_t)m * DM) + lane;
        GAS f32x4* yr = (GAS f32x4*)(a.out + (size_t)m * DM) + lane;
        unsigned long long w[8];
#pragma unroll
        for (int j = 0; j < 8; ++j) w[j] = xr[64 * j];
#pragma unroll
        for (int j = 0; j < 8; ++j) { const f32x4 x = (f32x4){__uint_as_float((unsigned)w[j] << 16), __uint_as_float((unsigned)w[j] & 0xffff0000u), __uint_as_float((unsigned)(w[j] >> 32) << 16), __uint_as_float((unsigned)(w[j] >> 32) & 0xffff0000u)};
            yr[64 * j] = x * rstd * g[j]; }
    }
}

namespace mb {
constexpr int D = 128, QPITCH = 1024, KPITCH = 1024, OPITCH = 2048;
constexpr float THR = 8.f;
constexpr bool WSKIP = false;
constexpr float SCALE = 0.08838834764831845f;
constexpr int NW = 8, QBLK = 32, KVBLK = 64, QB = NW * QBLK;
constexpr int SHM_V = KVBLK * D * 2, SHM_K = KVBLK * D * 2;
constexpr int ATT_LDS_BYTES = 2 * SHM_V + 2 * SHM_K + NW * 64 * 4;

using bf16 = __hip_bfloat16;
typedef short bf16x8 __attribute__((ext_vector_type(8)));
typedef short s16x4 __attribute__((ext_vector_type(4)));
typedef float f32x16 __attribute__((ext_vector_type(16)));
typedef float f32x4 __attribute__((ext_vector_type(4)));
typedef unsigned u32x4 __attribute__((ext_vector_type(4)));
template <class A, class Bt> struct same_t { static constexpr bool v = false; };
template <class A> struct same_t<A, A> { static constexpr bool v = true; };

#define KSWZ(row, colB) ((row) * 256 + ((colB) ^ (((row) & 7) << 4)))
#define SBAR() __builtin_amdgcn_sched_barrier(0)
__device__ __forceinline__ int v_st(int k, int c) { const int kk = (k & ~0xC) | ((k & 4) << 1) | ((k & 8) >> 1); return ((kk >> 3) * 4 + (c >> 5)) * 512 + ((kk & 7) * 32 + (c & 31)) * 2; }
__device__ __forceinline__ int v_rd_base(int lane) { return ((lane & 3) << 3) | (((lane >> 2) & 3) << 6) | (((lane >> 4) & 1) << 5) | (((lane >> 5) & 1) << 8); }
constexpr int v_rd_off(int d0, int ks, int half) { return d0 * 512 + ks * 4096 + half * 2048; }
__device__ __forceinline__ int crow(int r, int hi) { return (r & 3) + 8 * (r >> 2) + 4 * hi; }
__device__ __forceinline__ unsigned cvtpk(float lo, float hi) {
    unsigned r; asm volatile("v_cvt_pk_bf16_f32 %0, %1, %2" : "=v"(r) : "v"(lo), "v"(hi)); return r;
}
__device__ __forceinline__ bf16x8 pack8(f32x4 a, f32x4 b) {
    u32x4 w = {cvtpk(a[0], a[1]), cvtpk(a[2], a[3]), cvtpk(b[0], b[1]), cvtpk(b[2], b[3])};
    return *reinterpret_cast<bf16x8*>(&w);
}
template <class T> __device__ __forceinline__ bf16x8 load8(const T* p) {
    if constexpr (same_t<T, float>::v) { return pack8(*(const f32x4*)p, *(const f32x4*)(p + 4)); }
    else { return *reinterpret_cast<const bf16x8*>(p); }
}
__device__ __forceinline__ void mask_tile(f32x16& p0, f32x16& p1, int dq, unsigned W) {
    const float NEG = -__builtin_inff();
#pragma unroll
    for (int r = 0; r < 16; ++r) {
        const int c = (r & 3) + 8 * (r >> 2);
        if ((unsigned)(dq - c) >= W) p0[r] = NEG;
        if ((unsigned)(dq - c - 32) >= W) p1[r] = NEG;
    }
}
__device__ __forceinline__ void partialSM(f32x16& p0, f32x16& p1, float& m_reg, float& mn, float& alpha, const bool rowoff) {
    float pmax = p0[0]; for (int r = 1; r < 16; ++r) pmax = fmaxf(pmax, p0[r]); for (int r = 0; r < 16; ++r) pmax = fmaxf(pmax, p1[r]);
    { auto rr = __builtin_amdgcn_permlane32_swap(__float_as_uint(pmax), __float_as_uint(pmax), false, false);
      pmax = fmaxf(__uint_as_float(rr[0]), __uint_as_float(rr[1])); }
    if (rowoff) pmax = -__builtin_inff();
    constexpr float C2 = 1.4426950408889634f * SCALE;
    if (__builtin_expect(__all((pmax - m_reg) * SCALE <= THR), 1)) { mn = m_reg; alpha = 1.f; }
    else { mn = fmaxf(m_reg, pmax); alpha = __builtin_amdgcn_exp2f((m_reg - mn) * C2); m_reg = mn; }
    const float mnL = rowoff ? -__builtin_inff() : -mn * C2;
    for (int r = 0; r < 16; ++r) p0[r] = fmaf(p0[r], C2, mnL); for (int r = 0; r < 16; ++r) p1[r] = fmaf(p1[r], C2, mnL);
    for (int r = 0; r < 16; ++r) p0[r] = __builtin_amdgcn_exp2f(p0[r]);
}
__device__ __forceinline__ void finishSM(f32x16& p0, f32x16& p1, float alpha, float& l_reg, bf16x8& pa0, bf16x8& pa1, bf16x8& pa2, bf16x8& pa3) {
    for (int r = 0; r < 16; ++r) p1[r] = __builtin_amdgcn_exp2f(p1[r]);
    float ps = 0; for (int r = 0; r < 16; ++r) ps += p0[r]; for (int r = 0; r < 16; ++r) ps += p1[r];
    { auto rr = __builtin_amdgcn_permlane32_swap(__float_as_uint(ps), __float_as_uint(ps), false, false);
      ps = __uint_as_float(rr[0]) + __uint_as_float(rr[1]); }
    l_reg = l_reg * alpha + ps;
#define PK4(P, B_, OUT) do { unsigned a0 = cvtpk(P[B_+0], P[B_+1]), a1 = cvtpk(P[B_+2], P[B_+3]);                          \
        unsigned b0 = cvtpk(P[B_+4], P[B_+5]), b1 = cvtpk(P[B_+6], P[B_+7]);                                             \
        auto r0 = __builtin_amdgcn_permlane32_swap(a0, b0, false, false); auto r1 = __builtin_amdgcn_permlane32_swap(a1, b1, false, false); \
        u32x4 w = {r0[0], r1[0], r0[1], r1[1]}; OUT = *reinterpret_cast<bf16x8*>(&w); } while (0)
    PK4(p0, 0, pa0); PK4(p0, 8, pa1); PK4(p1, 0, pa2); PK4(p1, 8, pa3);
#undef PK4
}
template <int KB, bool SK>
__device__ __forceinline__ void qkt(f32x16& p0, f32x16& p1, const char* K_lds, int r32, int hi, const bf16x8* qr, bool act) {
    if (SK && !act) { const float NEG = -__builtin_inff();
#pragma unroll
        for (int r = 0; r < 16; ++r) { p0[r] = NEG; p1[r] = NEG; } return; }
    p0 = f32x16{}; p1 = f32x16{};
    const char* kb[4];
#pragma unroll
    for (int dd = 0; dd < 4; ++dd) kb[dd] = K_lds + KB * SHM_K + KSWZ(r32, (dd * 16 + hi * 8) * 2);
#pragma unroll
    for (int d0 = 0; d0 < 8; ++d0) { const char* a = kb[d0 & 3] + (d0 >> 2) * 128;
        bf16x8 b0 = *reinterpret_cast<const bf16x8*>(a);
        bf16x8 b1 = *reinterpret_cast<const bf16x8*>(a + 32 * 256);
        p0 = __builtin_amdgcn_mfma_f32_32x32x16_bf16(b0, qr[d0], p0, 0, 0, 0);
        p1 = __builtin_amdgcn_mfma_f32_32x32x16_bf16(b1, qr[d0], p1, 0, 0, 0); }
}
template <int VB, bool SK>
__device__ __forceinline__ void pv_tile(f32x16* o, int vb0, bf16x8 pa0, bf16x8 pa1, bf16x8 pa2, bf16x8 pa3, bool act) {
    if (SK && !act) return;
#define TRRD(dst, off) asm volatile("ds_read_b64_tr_b16 %0, %1 offset:%2" : "=&v"(dst) : "v"(vb0), "i"(off) : "memory")
#define PV_D0(d0) do { s16x4 l0, l1, l2, l3, h0, h1, h2, h3; constexpr int b_ = VB * SHM_V + v_rd_off(d0, 0, 0);     \
        TRRD(l0, b_); TRRD(h0, b_ + 2048); TRRD(l1, b_ + 4096); TRRD(h1, b_ + 6144); TRRD(l2, b_ + 8192); TRRD(h2, b_ + 10240); TRRD(l3, b_ + 12288); TRRD(h3, b_ + 14336); \
        asm volatile("s_waitcnt lgkmcnt(0)" ::: "memory"); SBAR();                 \
        o[d0] = __builtin_amdgcn_mfma_f32_32x32x16_bf16(pa0, (bf16x8){l0[0], l0[1], l0[2], l0[3], h0[0], h0[1], h0[2], h0[3]}, o[d0], 0, 0, 0);   \
        o[d0] = __builtin_amdgcn_mfma_f32_32x32x16_bf16(pa1, (bf16x8){l1[0], l1[1], l1[2], l1[3], h1[0], h1[1], h1[2], h1[3]}, o[d0], 0, 0, 0);   \
        o[d0] = __builtin_amdgcn_mfma_f32_32x32x16_bf16(pa2, (bf16x8){l2[0], l2[1], l2[2], l2[3], h2[0], h2[1], h2[2], h2[3]}, o[d0], 0, 0, 0);   \
        o[d0] = __builtin_amdgcn_mfma_f32_32x32x16_bf16(pa3, (bf16x8){l3[0], l3[1], l3[2], l3[3], h3[0], h3[1], h3[2], h3[3]}, o[d0], 0, 0, 0); } while (0)
    PV_D0(0); PV_D0(1); PV_D0(2); PV_D0(3);
#undef PV_D0
#undef TRRD
}

template <class TIn, class TOut> struct BlockRef { const TIn* Q; const TIn* K; const TIn* V; TOut* O; int P0; };
template <class TIn> struct Seam {
    bf16x8 qr[8];
    bf16x8 st_v0, st_v1, st_k0, st_k1; f32x4 sf0, sf1, sf2, sf3;
    f32x4 tq[16];
};
__device__ __forceinline__ int swa_jlo(int P0, int W) { const int lowk = P0 - W + 1; return lowk > 0 ? lowk / KVBLK : 0; }
#define ROW(p, k0, rr) ((p) + (size_t)((k0) + (rr)) * KPITCH + sc)
#define VMW() asm volatile("s_waitcnt vmcnt(0)" ::: "memory")
#define VMWN(n) asm volatile("s_waitcnt vmcnt(%0)" :: "i"(n) : "memory")
#define SLOAD_H(Kp, Vp, k0) do { S.st_v0 = load8<TIn>(ROW(Vp, k0, sr)); S.st_v1 = load8<TIn>(ROW(Vp, k0, 32 + sr));              \
                         S.st_k0 = load8<TIn>(ROW(Kp, k0, sr)); S.st_k1 = load8<TIn>(ROW(Kp, k0, 32 + sr)); } while (0)
#define SWRITE_HK(bf) do { *(bf16x8*)(K_lds + (bf) * SHM_K + kws) = S.st_k0; *(bf16x8*)(K_lds + (bf) * SHM_K + kws + 32 * 256) = S.st_k1; } while (0)
#define SWRITE_HV(bf) do { *(bf16x8*)(V_lds + (bf) * SHM_V + vst0) = S.st_v0; *(bf16x8*)(V_lds + (bf) * SHM_V + vst1) = S.st_v1; } while (0)
#define SWRITE_H(bf) do { SWRITE_HV(bf); SWRITE_HK(bf); } while (0)
#define SLOAD_F(p, k0) do { S.sf0 = *(const f32x4*)ROW(p, k0, sr); S.sf1 = *(const f32x4*)(ROW(p, k0, sr) + 4);                \
                            S.sf2 = *(const f32x4*)ROW(p, k0, 32 + sr); S.sf3 = *(const f32x4*)(ROW(p, k0, 32 + sr) + 4); } while (0)
#define SWRITE_KF(bf) do { *(bf16x8*)(K_lds + (bf) * SHM_K + kws) = pack8(S.sf0, S.sf1); *(bf16x8*)(K_lds + (bf) * SHM_K + kws + 32 * 256) = pack8(S.sf2, S.sf3); } while (0)
#define SWRITE_VF(bf) do { *(bf16x8*)(V_lds + (bf) * SHM_V + vst0) = pack8(S.sf0, S.sf1); *(bf16x8*)(V_lds + (bf) * SHM_V + vst1) = pack8(S.sf2, S.sf3); } while (0)
template <class TIn, class TOut>
__device__ __forceinline__ void causal_swa_prime(const BlockRef<TIn, TOut>& cur, int W, char* lds, Seam<TIn>& S, const int wv) {
    constexpr bool F32 = same_t<TIn, float>::v;
    const int tid = wv * 64 + (int)__builtin_amdgcn_mbcnt_hi(~0u, __builtin_amdgcn_mbcnt_lo(~0u, 0u)), wid = wv, lane = tid & 63, r32 = lane & 31, hi = lane >> 5;
    const int sr = tid >> 4, sc = (tid & 15) * 8, kws = KSWZ(sr, sc * 2); char* K_lds = lds + 2 * SHM_V;
    const int kb0 = swa_jlo(cur.P0, W) * KVBLK;
    for (int d0 = 0; d0 < 8; ++d0) S.qr[d0] = load8<TIn>(cur.Q + (size_t)(wid * QBLK + r32) * QPITCH + d0 * 16 + hi * 8);
    if constexpr (F32) { SLOAD_F((const float*)cur.K, kb0); VMW(); SWRITE_KF(0); SBAR(); SLOAD_F((const float*)cur.V, kb0); }
    else { SLOAD_H(cur.K, cur.V, kb0); VMW(); SWRITE_HK(0); }
    __syncthreads();
}
template <class TIn, class TOut>
__device__ __forceinline__ void causal_swa_block(const BlockRef<TIn, TOut>& cur, const BlockRef<TIn, TOut>& nxt, int skv, int W, char* lds, Seam<TIn>& S, const unsigned selmask, const int wv) {
    constexpr bool F32 = same_t<TIn, float>::v;
    int tid = wv * 64 + (int)__builtin_amdgcn_mbcnt_hi(~0u, __builtin_amdgcn_mbcnt_lo(~0u, 0u)); asm volatile("" : "+v"(tid));
    const int wid = wv, lane = tid & 63, r32 = lane & 31, hi = lane >> 5;
    const int j_lo = swa_jlo(cur.P0, W);
    int j_hi = (cur.P0 + QB - 1) / KVBLK + 1; if (j_hi > skv / KVBLK) j_hi = skv / KVBLK;
    const int NT = j_hi - j_lo;
    const int kbn = swa_jlo(nxt.P0, W) * KVBLK;
    const int own = cur.P0 >> 8;
    const int qlo = cur.P0 + wid * QBLK, qm = qlo + r32 - 4 * hi;
    char* V_lds = lds; char* K_lds = lds + 2 * SHM_V;
    float* ws = (float*)(lds + 2 * SHM_V + 2 * SHM_K) + wid * 64; float* li_l = ws, * al_l = ws + 32;
    float m_reg = -1e30f, l_reg = 0; f32x16 o[4] = {};
    const int sr = tid >> 4, sc = (tid & 15) * 8, vst0 = v_st(sr, sc), vst1 = v_st(32 + sr, sc), kws = KSWZ(sr, sc * 2);
    const int vb0 = (int)(uintptr_t)V_lds + v_rd_base(lane);
    const TIn* Kh = cur.K; const TIn* Vh = cur.V;
#define RESC(a) do { if (__any((a) < 1.f)) { if (hi == 0) al_l[r32] = (a); asm volatile("s_waitcnt lgkmcnt(0)" ::: "memory");              \
                     for (int d_ = 0; d_ < 4; ++d_) for (int r = 0; r < 16; ++r) o[d_][r] *= al_l[crow(r, hi)]; } } while (0)
#define KBASE(t) ((j_lo + (t)) * KVBLK)
#define ACT(t) (KBASE(t) <= qlo + QBLK - 1 && KBASE(t) + KVBLK - 1 >= qlo - W + 1)
#define MASKT(P0_, P1_, t) do { const int kb_ = KBASE(t); if ((kb_ >> 8) == own && kb_ + KVBLK - 1 > qlo) mask_tile(P0_, P1_, qm - kb_, 0x40000000u); } while (0)
#define ROWOFF(t) (own > 3 && (KBASE(t) >> 8) != own && ((selmask >> (KBASE(t) >> 8)) & 1u) == 0u)
    constexpr int NQL = F32 ? 16 : 8;
    constexpr bool SK = WSKIP && !F32;
#define SEAM_K0() do { VMWN(NQL); if constexpr (F32) { SWRITE_KF(0); SBAR(); SLOAD_F((const float*)nxt.V, kbn); } else { SWRITE_HK(0); } SBAR(); } while (0)
    f32x16 pA0, pA1, pB0, pB1; float mnA, mnB, alA, alB; bf16x8 pa0, pa1, pa2, pa3;
    if constexpr (F32) { VMW(); SWRITE_VF(0); SBAR(); } else { SWRITE_HV(0); SBAR(); }
    if (NT > 1) { if constexpr (F32) SLOAD_F((const float*)Kh, KBASE(1)); else SLOAD_H(Kh, Vh, KBASE(1)); }
    SBAR(); qkt<0, SK>(pA0, pA1, K_lds, r32, hi, S.qr, ACT(0));
    if constexpr (F32) { if (NT > 1) { VMW(); SWRITE_KF(1); SBAR(); SLOAD_F((const float*)Vh, KBASE(1)); } }
    MASKT(pA0, pA1, 0); partialSM(pA0, pA1, m_reg, mnA, alA, ROWOFF(0));
    if (NT > 1) { VMW(); if constexpr (F32) { SWRITE_VF(1); SBAR(); if (NT > 2) SLOAD_F((const float*)Kh, KBASE(2)); } else SWRITE_H(1); }
    __syncthreads();
#define HALF_STEP(PX0, PX1, mnX, alX, PY0, PY1, alY, t, KB, VB, SB) do {                                                      \
        SBAR(); qkt<KB, SK>(PX0, PX1, K_lds, r32, hi, S.qr, ACT(t));                                             \
        finishSM(PY0, PY1, alY, l_reg, pa0, pa1, pa2, pa3); SBAR();                                                           \
        if ((t) + 1 < NT) { if constexpr (F32) { VMW(); SWRITE_KF(SB); SBAR(); SLOAD_F((const float*)Vh, KBASE((t) + 1)); }  \
                            else { SLOAD_H(Kh, Vh, KBASE((t) + 1)); } SBAR(); }                                               \
        pv_tile<VB, SK>(o, vb0, pa0, pa1, pa2, pa3, ACT((t) - 1)); MASKT(PX0, PX1, (t)); partialSM(PX0, PX1, m_reg, mnX, alX, ROWOFF(t));                                        \
        __syncthreads();                                                                                                      \
        if ((t) + 1 < NT) { VMW(); if constexpr (F32) { SWRITE_VF(SB); SBAR(); if ((t) + 2 < NT) SLOAD_F((const float*)Kh, KBASE((t) + 2)); } \
                            else { SWRITE_H(SB); } }                                                                          \
        RESC(alX); __syncthreads(); } while (0)
    for (int t = 1; t + 1 < NT; t += 2) {
        HALF_STEP(pB0, pB1, mnB, alB, pA0, pA1, alA, t, 1, 0, 0);
        HALF_STEP(pA0, pA1, mnA, alA, pB0, pB1, alB, t + 1, 0, 1, 1);
    }
    const bool even = (NT & 1) == 0;
    if (even) { SBAR(); qkt<1, SK>(pB0, pB1, K_lds, r32, hi, S.qr, ACT(NT - 1)); SBAR(); }
#define QROW(e) (nxt.Q + (size_t)(wid * QBLK + r32) * QPITCH + ((e) >> 1) * 16 + hi * 8 + ((e) & 1) * 4)
    if constexpr (F32) { SLOAD_F((const float*)nxt.K, kbn); SBAR();
#pragma unroll
        for (int e = 0; e < 8; ++e) S.tq[e] = *(const f32x4*)QROW(e); }
    else { SLOAD_H(nxt.K, nxt.V, kbn); SBAR();
#pragma unroll
        for (int d0 = 0; d0 < 8; ++d0) S.qr[d0] = load8<TIn>(nxt.Q + (size_t)(wid * QBLK + r32) * QPITCH + d0 * 16 + hi * 8); }
    SBAR();
    finishSM(pA0, pA1, alA, l_reg, pa0, pa1, pa2, pa3); SBAR();
    if constexpr (F32) {
#pragma unroll
        for (int e = 8; e < 16; ++e) S.tq[e] = *(const f32x4*)QROW(e); SBAR(); }
#undef QROW
    pv_tile<0, SK>(o, vb0, pa0, pa1, pa2, pa3, ACT(even ? NT - 2 : NT - 1));
    if (even) { MASKT(pB0, pB1, NT - 1); partialSM(pB0, pB1, m_reg, mnB, alB, ROWOFF(NT - 1)); __syncthreads(); RESC(alB);
        finishSM(pB0, pB1, alB, l_reg, pa0, pa1, pa2, pa3); SBAR(); pv_tile<1, SK>(o, vb0, pa0, pa1, pa2, pa3, ACT(NT - 1)); }
    SBAR(); SEAM_K0();
    if (hi == 0) li_l[r32] = l_reg; asm volatile("s_waitcnt lgkmcnt(0)" ::: "memory");
    float rli[16];
#pragma unroll
    for (int r = 0; r < 16; ++r) rli[r] = __builtin_amdgcn_rcpf(li_l[crow(r, hi)]);
    TOut* Ow = cur.O + (size_t)(wid * QBLK) * OPITCH;
#pragma unroll
    for (int r = 0; r < 16; ++r) { const int orow = crow(r, hi);
#pragma unroll
        for (int d0 = 0; d0 < 4; ++d0) { const float v = o[d0][r] * rli[r];
            if constexpr (same_t<TOut, float>::v) { Ow[(size_t)orow * OPITCH + d0 * 32 + r32] = v; }
            else { const float vn = __shfl_xor(v, 1);
                   if ((r32 & 1) == 0) *(unsigned*)(Ow + (size_t)orow * OPITCH + d0 * 32 + r32) = cvtpk(v, vn); } } }
    if constexpr (F32) {
#pragma unroll
        for (int d0 = 0; d0 < 8; ++d0) S.qr[d0] = pack8(S.tq[2 * d0], S.tq[2 * d0 + 1]); }
    __syncthreads();
#undef RESC
#undef KBASE
#undef ACT
#undef MASKT
#undef ROWOFF
#undef SEAM_K0
#undef HALF_STEP
}
#undef ROW
#undef VMW
#undef VMWN
#undef SLOAD_H
#undef SWRITE_HK
#undef SWRITE_HV
#undef SWRITE_H
#undef SLOAD_F
#undef SWRITE_KF
#undef SWRITE_VF
#undef KSWZ
#undef SBAR
}
namespace mb {
__device__ __forceinline__ float bfx(short s) { return __uint_as_float(((unsigned)(unsigned short)s) << 16); }
#define MOBA_INS(g, n, TIE) do { const float g_ = (g); const int n_ = (n); \
    const bool b0_ = g_ > v0 || (TIE && g_ == v0 && n_ < i0), b1_ = g_ > v1 || (TIE && g_ == v1 && n_ < i1), b2_ = g_ > v2 || (TIE && g_ == v2 && n_ < i2); \
    v2 = b1_ ? v1 : (b2_ ? g_ : v2); i2 = b1_ ? i1 : (b2_ ? n_ : i2); \
    v1 = b0_ ? v0 : (b1_ ? g_ : v1); i1 = b0_ ? i0 : (b1_ ? n_ : i1); \
    v0 = b0_ ? g_ : v0; i0 = b0_ ? n_ : i0; } while (0)
__device__ __forceinline__ unsigned moba_select(const bf16x8 (&qr)[8], const char* kmB, int own, int lane) {
    if (own <= 3) return (1u << own) - 1u;
    const int hi = lane >> 5;
    const char* kp = kmB + (lane & 15) * 272 + hi * 16;
    f32x16 g;
#pragma unroll
    for (int r = 0; r < 16; ++r) g[r] = 0.f;
#pragma unroll
    for (int d0 = 0; d0 < 8; ++d0) {
        const bf16x8 ah = *(const bf16x8*)(kp + d0 * 32), al = *(const bf16x8*)(kp + 4352 + d0 * 32);
        g = __builtin_amdgcn_mfma_f32_32x32x16_bf16(ah, qr[d0], g, 0, 0, 0);
        g = __builtin_amdgcn_mfma_f32_32x32x16_bf16(al, qr[d0], g, 0, 0, 0);
    }
    float v0 = -INFINITY, v1 = -INFINITY, v2 = -INFINITY; int i0 = 31, i1 = 31, i2 = 31;
#pragma unroll
    for (int r = 0; r < 8; ++r) { const int n = (r & 3) + 8 * (r >> 2) + 4 * hi; MOBA_INS(n < own ? g[r] : -INFINITY, n, false); }
    float pv[3]; int pi[3];
    { const float mv[3] = {v0, v1, v2}; const int mi[3] = {i0, i1, i2};
#pragma unroll
        for (int e = 0; e < 3; ++e) {
            auto rv = __builtin_amdgcn_permlane32_swap(__float_as_uint(mv[e]), __float_as_uint(mv[e]), false, false);
            auto ri = __builtin_amdgcn_permlane32_swap((unsigned)mi[e], (unsigned)mi[e], false, false);
            pv[e] = __uint_as_float(hi ? rv[0] : rv[1]); pi[e] = (int)(hi ? ri[0] : ri[1]); } }
#pragma unroll
    for (int e = 0; e < 3; ++e) MOBA_INS(pv[e], pi[e], true);
    return (1u << i0) | (1u << i1) | (1u << i2);
}
__device__ __forceinline__ BlockRef<bf16, bf16> mk_block(const bf16* Qb, const bf16* Kb, const bf16* Vb, bf16* ATT, int first, int step, int idx, int& bh_out) {
    const int item = first + (idx >> 1) * step, bh = item >> 3, x = item & 7, qb = (idx & 1) ? x : 15 - x, b = bh >> 3, h = bh & 7;
    BlockRef<bf16, bf16> r;
    r.Q = Qb + (size_t)(b * SEQ + qb * 256) * QPITCH + h * 128;
    r.K = Kb + (size_t)(b * SEQ) * KPITCH + h * 128;
    r.V = Vb + (size_t)(b * SEQ) * KPITCH + h * 128;
    r.O = ATT + (size_t)(b * SEQ + qb * 256) * OPITCH + h * 128;
    r.P0 = qb * 256; bh_out = bh; return r;
}
__device__ __forceinline__ void prompt_attention(unsigned char* ws, char* lds, int first, int step, const int wv) {
    const bf16* Qb = (const bf16*)(ws + WS_Q); const bf16* Kb = (const bf16*)(ws + WS_K); const bf16* Vb = (const bf16*)(ws + WS_V); bf16* ATT = (bf16*)(ws + WS_ATT);
    const float* kmsum = (const float*)(ws + CTL_KMP);
    char* kmB = lds + 69632;
    if (first >= 128) return;
    const int nitems = (128 - first + step - 1) / step, nb = 2 * nitems;
    Seam<bf16> S;
    int bh; BlockRef<bf16, bf16> cur = mk_block(Qb, Kb, Vb, ATT, first, step, 0, bh);
    causal_swa_prime<bf16, bf16>(cur, 0x40000000, lds, S, wv);
    for (int i = 0; i < nb; ++i) {
        int bhn = bh; const BlockRef<bf16, bf16> nxt = (i + 1 < nb) ? mk_block(Qb, Kb, Vb, ATT, first, step, i + 1, bhn) : cur;
        int tl = wv * 64 + lane_id(); asm volatile("" : "+v"(tl));
        { const int b = bh >> 3, h = bh & 7; const float* src = kmsum + ((size_t)(b * 16) * NH + h) * HD;
            const f32x4 v = *(const f32x4*)(src + (size_t)(tl >> 5) * NH * HD + (tl & 31) * 4);
            const unsigned h0 = cvtpk(v[0], v[1]), h1 = cvtpk(v[2], v[3]);
            const unsigned l0 = cvtpk(v[0] - __uint_as_float(h0 << 16), v[1] - __uint_as_float(h0 & 0xffff0000u)), l1 = cvtpk(v[2] - __uint_as_float(h1 << 16), v[3] - __uint_as_float(h1 & 0xffff0000u));
            *(uint2*)(kmB + (tl >> 5) * 272 + (tl & 31) * 8) = make_uint2(h0, h1); *(uint2*)(kmB + 4352 + (tl >> 5) * 272 + (tl & 31) * 8) = make_uint2(l0, l1); }
        __syncthreads();
        const unsigned selmask = moba_select(S.qr, kmB, cur.P0 >> 8, tl & 63);
        causal_swa_block<bf16, bf16>(cur, nxt, SEQ, 0x40000000, lds, S, selmask, wv);
        cur = nxt; bh = bhn;
    }
}
}

constexpr size_t CTL_SMP_GATES = CTL_SMP + 4096;
constexpr unsigned SMP_SPIN_CAP = 1u << 22;
typedef float f32x2v __attribute__((ext_vector_type(2)));
__device__ __forceinline__ void sample_scan_item(const Args& a, LAS unsigned char* lds, int b, int n, int tid, int wave, int lane) {
    const float* cache_k = a.in[2]; const int* pt = (const int*)a.in[4]; unsigned char* ws = a.ws;
    LAS float* red = (LAS float*)lds;
    LAS float* qL = (LAS float*)(lds + 32768);
    LAS float* kmr = (LAS float*)(lds + 49152);
    { const bf16* Qb = (const bf16*)(ws + WS_Q) + (size_t)(MP + b * DS) * 1024;
        for (int i = tid; i < DS * 1024; i += NWAVES * 64) qL[i] = bf2f(Qb[i]); }
    const int page = pt[b * NPG + 2 * n + (wave >> 2)];
    const float* base = cache_k + ((size_t)page * PAGE + (wave & 3) * 32) * 1024 + lane * 4;
    f32x4 acc[4];
#pragma unroll
    for (int c = 0; c < 4; ++c) acc[c] = (f32x4){0.f, 0.f, 0.f, 0.f};
    for (int j = 0; j < 32; j += 8) {
        f32x4 v[8][4];
#pragma unroll
        for (int jj = 0; jj < 8; ++jj)
#pragma unroll
            for (int c = 0; c < 4; ++c) v[jj][c] = __builtin_nontemporal_load((const f32x4*)(base + (size_t)(j + jj) * 1024 + c * 256));
#pragma unroll
        for (int jj = 0; jj < 8; ++jj)
#pragma unroll
            for (int c = 0; c < 4; ++c) acc[c] += v[jj][c];
    }
#pragma unroll
    for (int c = 0; c < 4; ++c) *(LAS f32x4*)(red + wave * 1024 + c * 256 + lane * 4) = acc[c];
    __syncthreads();
    { float s0 = 0.f, s1 = 0.f;
#pragma unroll
        for (int w = 0; w < 8; ++w) { s0 += red[w * 1024 + tid * 2]; s1 += red[w * 1024 + tid * 2 + 1]; }
        kmr[tid * 2] = s0 * (1.f / 256.f); kmr[tid * 2 + 1] = s1 * (1.f / 256.f); }
    __syncthreads();
    {
        const int h = wave; unsigned* gates = (unsigned*)(ws + CTL_SMP_GATES);
        const float k0 = kmr[h * 128 + lane], k1 = kmr[h * 128 + lane + 64];
#pragma unroll
        for (int t = 0; t < DS; ++t) {
            float p = qL[t * 1024 + h * 128 + lane] * k0 + qL[t * 1024 + h * 128 + lane + 64] * k1;
            p = wave_sum(p);
            if (lane == 0) __hip_atomic_store(gates + ((size_t)(b * DS + t) * NH + h) * 64 + n, __float_as_uint(p), RLX_AGENT);
        }
    }
    asm volatile("s_waitcnt vmcnt(0)" ::: "memory");
    __syncthreads();
    if (tid == 0) __hip_atomic_fetch_add((unsigned*)(ws + CTL_SMP) + 64 * b, 1u, RLX_AGENT);
}
__device__ __forceinline__ void sample_attn_item(const Args& a, LAS unsigned char* lds, int b, int t, int h, int tid, int wave, int lane) {
    const float* cache_k = a.in[2]; const float* cache_v = a.in[3]; const int* pt = (const int*)a.in[4]; unsigned char* ws = a.ws;
    LAS float* lg = (LAS float*)lds;
    LAS float* oL = (LAS float*)(lds + 4096);
    gu32* ctl = (gu32*)(ws + WS_CTL);
    const int row = MP + b * DS + t;
    if (wave == 0) {
        unsigned* cnt = (unsigned*)(ws + CTL_SMP) + 64 * b; unsigned sp = 0;
        while ((unsigned)__builtin_amdgcn_readfirstlane(__hip_atomic_load(cnt, RLX_AGENT)) < 64u) {
            __builtin_amdgcn_s_sleep(2);
            if ((++sp & 255u) == 0u) { if (__hip_atomic_load((unsigned*)(ctl + CW_TMO), RLX_AGENT)) break; if (sp > SMP_SPIN_CAP) { if (lane == 0) __hip_atomic_store((unsigned*)(ctl + CW_TMO), 1u, RLX_AGENT); break; } }
        }
        __builtin_amdgcn_fence(__ATOMIC_ACQUIRE, "agent");
    }
    asm volatile("s_waitcnt vmcnt(0)" ::: "memory");
    __syncthreads();
    float gate = __uint_as_float(__hip_atomic_load((unsigned*)(ws + CTL_SMP_GATES) + ((size_t)(b * DS + t) * NH + h) * 64 + lane, RLX_AGENT));
    int sel0, sel1, sel2;
    {
        float bv = gate;
#pragma unroll
        for (int o = 1; o < 64; o <<= 1) bv = fmaxf(bv, __shfl_xor(bv, o));
        sel0 = __ffsll((long long)__ballot(gate == bv)) - 1; if (lane == sel0) gate = -3e38f;
        bv = gate;
#pragma unroll
        for (int o = 1; o < 64; o <<= 1) bv = fmaxf(bv, __shfl_xor(bv, o));
        sel1 = __ffsll((long long)__ballot(gate == bv)) - 1; if (lane == sel1) gate = -3e38f;
        bv = gate;
#pragma unroll
        for (int o = 1; o < 64; o <<= 1) bv = fmaxf(bv, __shfl_xor(bv, o));
        sel2 = __ffsll((long long)__ballot(gate == bv)) - 1;
    }
    const int pg00 = pt[b * NPG + 2 * sel0], pg01 = pt[b * NPG + 2 * sel0 + 1], pg10 = pt[b * NPG + 2 * sel1], pg11 = pt[b * NPG + 2 * sel1 + 1], pg20 = pt[b * NPG + 2 * sel2], pg21 = pt[b * NPG + 2 * sel2 + 1];
#define SMP_PAGE(g) (((g) >> 8) == 0 ? (((g) & 128) ? pg01 : pg00) : (((g) >> 8) == 1 ? (((g) & 128) ? pg11 : pg10) : (((g) & 128) ? pg21 : pg20)))
    const int sub = lane & 15, kq = lane >> 4;
    float q[8];
    { const bf16* qp = (const bf16*)(ws + WS_Q) + (size_t)row * 1024 + h * 128 + sub * 8; const v4u qq = *(const GAS v4u*)qp;
#pragma unroll
        for (int e = 0; e < 4; ++e) { q[2 * e] = __uint_as_float(qq[e] << 16); q[2 * e + 1] = __uint_as_float(qq[e] & 0xffff0000u); } }
#pragma unroll 1
    for (int it = 0; it < 24; it += 12) {
        f32x4 ka[12], kb[12];
#pragma unroll
        for (int u = 0; u < 12; ++u) {
            const int g = wave * 96 + (it + u) * 4 + kq;
            const unsigned ko = (((unsigned)SMP_PAGE(g) * PAGE + (g & 127)) * 1024 + h * 128 + sub * 8) * 4u;
            ka[u] = __builtin_nontemporal_load((const f32x4*)((const char*)cache_k + ko)); kb[u] = __builtin_nontemporal_load((const f32x4*)((const char*)cache_k + ko + 16));
        }
#pragma unroll
        for (int u = 0; u < 12; ++u) {
            float p = (q[0] * ka[u][0] + q[1] * ka[u][1]) + (q[2] * ka[u][2] + q[3] * ka[u][3]) + (q[4] * kb[u][0] + q[5] * kb[u][1]) + (q[6] * kb[u][2] + q[7] * kb[u][3]);
            p += __shfl_xor(p, 1); p += __shfl_xor(p, 2); p += __shfl_xor(p, 4); p += __shfl_xor(p, 8);
            if (sub == 0) lg[wave * 96 + (it + u) * 4 + kq] = p * 0.08838834764831845f;
        }
    }
    if (wave == 0) {
        const bf16* kp = (const bf16*)(ws + WS_K) + (size_t)(MP + b * DS + kq) * 1024 + h * 128 + sub * 8; const v4u kk = *(const GAS v4u*)kp;
        float p = 0.f;
#pragma unroll
        for (int e = 0; e < 4; ++e) p += q[2 * e] * __uint_as_float(kk[e] << 16) + q[2 * e + 1] * __uint_as_float(kk[e] & 0xffff0000u);
        p += __shfl_xor(p, 1); p += __shfl_xor(p, 2); p += __shfl_xor(p, 4); p += __shfl_xor(p, 8);
        if (sub == 0) lg[768 + kq] = kq <= t ? p * 0.08838834764831845f : -INFINITY;
    }
    __syncthreads();
    float mx = -INFINITY;
    for (int i = lane; i < 772; i += 64) mx = fmaxf(mx, lg[i]);
#pragma unroll
    for (int o = 1; o < 64; o <<= 1) mx = fmaxf(mx, __shfl_xor(mx, o));
    float sum = 0.f;
    for (int i = lane; i < 772; i += 64) sum += __expf(lg[i] - mx);
    sum = wave_sum(sum);
    __syncthreads();
    for (int i = lane; i < 96; i += 64) lg[wave * 96 + i] = __expf(lg[wave * 96 + i] - mx);
    if (wave == 0 && lane < 4) lg[768 + lane] = __expf(lg[768 + lane] - mx);
    const int kh = lane >> 5, dl = lane & 31;
    f32x4 o4 = (f32x4){0.f, 0.f, 0.f, 0.f};
#pragma unroll 1
    for (int j0 = 0; j0 < 48; j0 += 24) {
        f32x4 vv[24];
#pragma unroll
        for (int u = 0; u < 24; ++u) {
            const int g = wave * 96 + 2 * (j0 + u) + kh;
            const unsigned vo = (((unsigned)SMP_PAGE(g) * PAGE + (g & 127)) * 1024 + h * 128 + dl * 4) * 4u;
            vv[u] = __builtin_nontemporal_load((const f32x4*)((const char*)cache_v + vo));
        }
#pragma unroll
        for (int u = 0; u < 24; ++u) o4 += vv[u] * lg[wave * 96 + 2 * (j0 + u) + kh];
    }
    if (wave == 0 && kh == 0) {
        for (int j = 0; j <= t; ++j) { const bf16* vp = (const bf16*)(ws + WS_V) + (size_t)(MP + b * DS + j) * 1024 + h * 128 + dl * 4; const unsigned long long vw = *(const GAS unsigned long long*)vp;
            const float p = lg[768 + j];
            o4 += (f32x4){__uint_as_float((unsigned)vw << 16), __uint_as_float((unsigned)vw & 0xffff0000u), __uint_as_float((unsigned)(vw >> 32) << 16), __uint_as_float((unsigned)(vw >> 32) & 0xffff0000u)} * p; }
    }
#pragma unroll
    for (int e = 0; e < 4; ++e) o4[e] += __shfl_xor(o4[e], 32);
    if (kh == 0) *(LAS f32x4*)(oL + wave * 128 + dl * 4) = o4;
    __syncthreads();
    if (tid < 128) { float s = 0.f;
#pragma unroll
        for (int w = 0; w < 8; ++w) s += oL[w * 128 + tid];
        ((bf16*)(ws + WS_ATT))[(size_t)row * DM + h * 128 + tid] = (bf16)f2bf(s / sum); }
    __syncthreads();
#undef SMP_PAGE
}
__device__ __forceinline__ void sample_path(const Args& a, LAS unsigned char* lds, int ib, int nB, int tid, int wave, int lane) {
    for (int s = ib; s < DB * 64; s += nB) sample_scan_item(a, lds, s >> 6, s & 63, tid, wave, lane);
    for (int j = ib; j < MS * NH; j += nB) sample_attn_item(a, lds, j >> 5, (j >> 3) & 3, j & 7, tid, wave, lane);
}
constexpr int N_PHASES = 10;
__global__ void __launch_bounds__(NWAVES * 64, 2) fwd_kernel(Args args) {
    extern __shared__ __attribute__((aligned(16))) unsigned char lds_raw[];
    LAS unsigned char* lds = (LAS unsigned char*)lds_raw;
    volatile LAS unsigned* MISC = (volatile LAS unsigned*)(lds + MISC_OFF);
    const int tid0 = threadIdx.x, wave = __builtin_amdgcn_readfirstlane(tid0 >> 6);
#define FRESH_TID() int tid = wave * 64 + lane_id(); asm volatile("" : "+v"(tid)); const int lane = tid & 63; (void)lane
    const int G = gridDim.x; const int bx = blockIdx.x; const int vcu = (G % 8 == 0) ? (bx % 8) * (G / 8) + bx / 8 : bx;
    unsigned char* ws = args.ws;
    gu32* ctl = (gu32*)(ws + WS_CTL);
    for (int u = tid0; u < (LDS_BYTES - LDSCTL_OFF) / 4; u += NWAVES * 64) ((LAS unsigned*)(lds + LDSCTL_OFF))[u] = 0u;
    __syncthreads();
    XcdBarrier bar = xcd_barrier_post((unsigned*)(ctl + CW_BAR) + args.li * XCD_BAR_WORDS, MISC + 8, wave);
    const int lo = args.ph_lo, hi = args.ph_hi;
#define IN(k) (lo <= (k) && (k) < hi)
#define BOTH(k) (IN(k) && IN((k) + 1))
#define GRID_BAR() xcd_barrier(bar)
    unsigned long long* SS = (unsigned long long*)(ws + CTL_SS);
    float* out = args.out;
    float* o_kp = out + (size_t)MV * DM; float* o_vp = o_kp + (size_t)MP * 1024; float* o_ks = o_vp + (size_t)MP * 1024; float* o_vs = o_ks + (size_t)MS * 1024;
    float* o_cp = o_vs + (size_t)MS * 1024; float* o_cs = o_cp + (size_t)NB * 2 * CC;
    pg8::bf16_t* XB = (pg8::bf16_t*)(ws + WS_XB);

    if (IN(0)) { FRESH_TID(); p0_prologue(args, lds, vcu, G, wave, lane);
#if PROBE_REP == 0
        for (int rep_ = 0; rep_ < 4; ++rep_) { GRID_BAR(); p0_prologue(args, lds, vcu, G, wave, lane); }
#endif
        if (BOTH(0)) GRID_BAR(); }

    if (IN(1)) {
        pg8::Gemm g{XB, (const pg8::bf16_t*)(ws + WS_WIN), MP, INW, DM, DM, DM, 31, 0, 128, 128}; pg8::StaticOrder S; S.init(MP, INW, G, bx);
        pg8::EpiInProj E{SS, (const float*)(ws + WS_COS), (const float*)(ws + WS_SIN),
                         (pg8::bf16_t*)(ws + WS_Q), (pg8::bf16_t*)(ws + WS_K), (pg8::bf16_t*)(ws + WS_V), (pg8::bf16_t*)(ws + WS_G), (pg8::bf16_t*)(ws + WS_U),
                         o_kp, o_vp, o_ks, o_vs, o_cp, o_cs, (float*)(ws + CTL_KMP)};
        pg8::skinny_phase<pg8::EpiInProj>(lds + RING_OFF, g, E, bx, G, wave);
        pg8::gemm_phase<pg8::EpiInProj, pg8::StaticOrder, true, true>(lds + RING_OFF, g, S, E, wave);
        if (PROBE_REP == 1 || PROBE_REP == 11 || PROBE_REP == 12) { for (int rep_ = 0; rep_ < 4; ++rep_) { GRID_BAR();
            if (PROBE_REP == 12) { pg8::EpiSwiGLU El{SS, (pg8::bf16_t*)(ws + WS_END)}; pg8::gemm_phase<pg8::EpiSwiGLU, pg8::StaticOrder, true, true>(lds + RING_OFF, g, S, El, wave); }
            else { pg8::gemm_phase<pg8::EpiInProj, pg8::StaticOrder, true, true>(lds + RING_OFF, g, S, E, wave); if (PROBE_REP == 1) pg8::skinny_phase<pg8::EpiInProj>(lds + RING_OFF, g, E, bx, G, wave); } } }
        if (BOTH(1)) GRID_BAR();
    }
    if (IN(2)) { FRESH_TID();
#if MK_ATTN_EXTERNAL
        conv_pass(args, vcu, G, tid);
#else
        conv_pass(args, vcu, G, tid);
        if ((vcu & 1) == 0) mb::prompt_attention(ws, (char*)lds_raw, vcu >> 1, G >> 1, wave);
        else sample_path(args, lds, vcu >> 1, G >> 1, tid, wave, lane);
#if PROBE_REP == 2
        GRID_BAR();
        if ((vcu & 1) == 0) mb::prompt_attention(ws, (char*)lds_raw, vcu >> 1, G >> 1, wave);
        else { conv_pass(args, vcu >> 1, G >> 1, tid); sample_path(args, lds, vcu >> 1, G >> 1, tid, wave, lane); }
#endif
#if PROBE_REP == 21
        for (int rep_ = 0; rep_ < 4; ++rep_) { GRID_BAR();
        if ((vcu & 1) == 0) mb::prompt_attention(ws, (char*)lds_raw, vcu >> 1, G >> 1, wave); }
#endif
#if PROBE_REP == 23
        GRID_BAR();
        if ((vcu & 1) != 0) conv_pass(args, vcu >> 1, G >> 1, tid);
#endif
#if PROBE_REP == 24
        GRID_BAR();
        if ((vcu & 1) != 0) { for (int s_ = (vcu >> 1); s_ < DB * 64; s_ += (G >> 1)) sample_scan_item(args, lds, s_ >> 6, s_ & 63, tid, wave, lane); }
#endif
#if PROBE_REP == 25
        GRID_BAR();
        if ((vcu & 1) != 0) { for (int j_ = (vcu >> 1); j_ < MS * NH; j_ += (G >> 1)) sample_attn_item(args, lds, j_ >> 5, (j_ >> 3) & 3, j_ & 7, tid, wave, lane); }
#endif
#if PROBE_REP == 22
        GRID_BAR();
        if ((vcu & 1) != 0) { conv_pass(args, vcu >> 1, G >> 1, tid); sample_path(args, lds, vcu >> 1, G >> 1, tid, wave, lane); }
#endif
#endif
        if (BOTH(2)) GRID_BAR();
    }
    if (IN(3)) {
        pg8::Gemm g{(const pg8::bf16_t*)(ws + WS_ATT), (const pg8::bf16_t*)(ws + WS_WO), MP, DM, DM, DM, DM, 31, 0, 128, 128}; pg8::StaticOrder S; S.init(MP, DM, G, bx);
        pg8::EpiResid E{XB, SS + 1 * MPAD, 0};
        pg8::skinny_phase_narrow<pg8::EpiResid>(lds + RING_OFF, g, E, bx, G, wave);
        pg8::gemm_phase<pg8::EpiResid, pg8::StaticOrder, false, true>(lds + RING_OFF, g, S, E, wave);
        if (BOTH(3)) GRID_BAR();
    }
#define FFN_PHASES(l, pb) \
    if (IN(pb)) { FRESH_TID();     \
        pg8::Gemm g{XB, (const pg8::bf16_t*)(ws + WS_WGU) + (size_t)(l) * 2 * FF * DM, MP, 2 * FF, DM, DM, DM, 31, 0, 128, 128}; pg8::StaticOrder S; S.init(MP, 2 * FF, G, bx); \
        pg8::EpiSwiGLU E{SS + ((l) == 0 ? 1 : 3) * MPAD, (pg8::bf16_t*)(ws + WS_H)}; \
        if (HALF_UNITS && G == 256) { \
            pg8::HalfOrder Hh; Hh.so = S; Hh.L = 5 * G + (bx & (G / 2 - 1)); Hh.half = bx / (G / 2);     \
            S.lim = 5 * G; \
            pg8::gemm_phase<pg8::EpiSwiGLU, pg8::StaticOrder, true, true>(lds + RING_OFF, g, S, E, wave); \
            pg8::gemm_phase_hm<pg8::EpiSwiGLU, pg8::HalfOrder>(lds + RING_OFF, g, Hh, E, wave); \
            pg8::skinny_phase<pg8::EpiSwiGLU>(lds + RING_OFF, g, E, bx, G, wave); \
        } else { \
            pg8::gemm_phase<pg8::EpiSwiGLU, pg8::StaticOrder, true, true>(lds + RING_OFF, g, S, E, wave); \
            pg8::skinny_phase<pg8::EpiSwiGLU>(lds + RING_OFF, g, E, bx >= G / 2 ? bx - G / 2 : (1 << 30), G / 2, wave);     \
            if (CONV_IN_SLOTS && bx >= G / 2) convert_weights(args, (LAS float*)(lds + RING_OFF + wave * 16384), 1 + (l), (bx - G / 2) * NWAVES + wave, (G / 2) * NWAVES, lane, (l) == 0 ? GU1_IN_P0 : 0); \
        } \
        if ((PROBE_REP == 70 && (l) == 1) || (PROBE_REP == 72 && (l) == 0) || (PROBE_REP == 71 && (l) == 1)) { for (int rep_ = 0; rep_ < 4; ++rep_) { GRID_BAR();     \
            pg8::gemm_phase<pg8::EpiSwiGLU, pg8::StaticOrder, true, true>(lds + RING_OFF, g, S, E, wave); \
            if (PROBE_REP != 71) { pg8::skinny_phase<pg8::EpiSwiGLU>(lds + RING_OFF, g, E, bx >= G / 2 ? bx - G / 2 : (1 << 30), G / 2, wave); \
                if (bx >= G / 2) convert_weights(args, (LAS float*)(lds + RING_OFF + wave * 16384), 1 + (l), (bx - G / 2) * NWAVES + wave, (G / 2) * NWAVES, lane, 0); } } } \
        if (BOTH(pb)) GRID_BAR(); \
    } \
    if (IN((pb) + 1)) {     \
        pg8::Gemm g{(const pg8::bf16_t*)(ws + WS_H), (const pg8::bf16_t*)(ws + WS_WDN) + (size_t)(l) * DM * FF, MP, DM, FF, 64, 64, 31, 0, (size_t)MPAD * 128, (size_t)DM * 128};     pg8::StaticOrder S; S.init(MP, DM, G, bx); \
        if ((l) == 0) { \
            pg8::EpiResid E{XB, SS + 2 * MPAD, 0}; \
            pg8::skinny_phase_narrow<pg8::EpiResid>(lds + RING_OFF, g, E, bx, G, wave); \
            pg8::gemm_phase<pg8::EpiResid, pg8::StaticOrder, false, true>(lds + RING_OFF, g, S, E, wave); \
        } else { \
            pg8::EpiFinal E{XB, SS + 4 * MPAD, args.in[9], out, (unsigned*)(ws + CTL_FIN), (unsigned*)(ctl + CW_TMO)}; \
            pg8::skinny_phase_narrow<pg8::EpiFinal>(lds + RING_OFF, g, E, bx, G, wave); \
            pg8::gemm_phase<pg8::EpiFinal, pg8::StaticOrder, false, true>(lds + RING_OFF, g, S, E, wave); \
        } \
        if (BOTH((pb) + 1)) GRID_BAR(); \
    }
#if PROBE_REP == 80 || PROBE_REP == 81
    if (IN(5)) {
        for (int rep_ = 0; rep_ < 8; ++rep_) { FRESH_TID();
            if (PROBE_REP == 81) convert_weights(args, (LAS float*)(lds + RING_OFF + wave * 16384), 1, bx * NWAVES + wave, G * NWAVES, lane, 0);
            else if (bx >= G / 2) convert_weights(args, (LAS float*)(lds + RING_OFF + wave * 16384), 1, (bx - G / 2) * NWAVES + wave, (G / 2) * NWAVES, lane, 0);
            GRID_BAR(); }
    }
#endif
#if PROBE_REP >= 60 && PROBE_REP <= 65
    if (IN(5)) {
        for (int rep_ = 0; rep_ < 8; ++rep_) {
            if (PROBE_REP != 62) {
                if (PROBE_REP == 64) {
                    pg8::Gemm g{(const pg8::bf16_t*)(ws + WS_H), (const pg8::bf16_t*)(ws + WS_WDN), MP, DM, FF, 64, 64, 31, 0, (size_t)MPAD * 128, (size_t)DM * 128}; pg8::StaticOrder S; S.init(MP, DM, G, bx);
                    pg8::EpiResid E{(pg8::bf16_t*)(ws + WS_END), (unsigned long long*)(ws + WS_END + (size_t)MPAD * DM * 2), PROBE_REP == 65};
                    pg8::gemm_phase<pg8::EpiResid, pg8::StaticOrder, false, true>(lds + RING_OFF, g, S, E, wave);
                    pg8::skinny_phase_narrow<pg8::EpiResid>(lds + RING_OFF, g, E, bx, G, wave);
                } else {
                    pg8::Gemm g{(const pg8::bf16_t*)(ws + WS_ATT), (const pg8::bf16_t*)(ws + WS_WO), MP, DM, DM, DM, DM, 31, 0, 128, 128}; pg8::StaticOrder S; S.init(MP, DM, G, bx);
                    if (PROBE_REP == 63) { pg8::EpiSwiGLU E{SS, (pg8::bf16_t*)(ws + WS_END)}; pg8::gemm_phase<pg8::EpiSwiGLU, pg8::StaticOrder, false, true>(lds + RING_OFF, g, S, E, wave); }
                    else { pg8::EpiResid E{(pg8::bf16_t*)(ws + WS_END), (unsigned long long*)(ws + WS_END + (size_t)MPAD * DM * 2), PROBE_REP == 65};
                        pg8::gemm_phase<pg8::EpiResid, pg8::StaticOrder, false, true>(lds + RING_OFF, g, S, E, wave);
                        if (PROBE_REP == 60) pg8::skinny_phase_narrow<pg8::EpiResid>(lds + RING_OFF, g, E, bx, G, wave); }
                }
            }
            GRID_BAR();
        }
    }
#endif
#if PROBE_REP == 52 || PROBE_REP == 53
    if (IN(5)) {
        constexpr bool BLK = PROBE_REP == 53;
        pg8::Gemm g{XB, (const pg8::bf16_t*)(ws + WS_WIN), MP, INW, DM, BLK ? 64 : DM, BLK ? 64 : DM, 31, 0, BLK ? (size_t)MPAD * 128 : 128, BLK ? (size_t)INW * 128 : 128}; pg8::StaticOrder S; S.init(MP, INW, G, bx);
        pg8::EpiSwiGLU E{SS, (pg8::bf16_t*)(ws + WS_END)};
        pg8::gemm_phase<pg8::EpiSwiGLU, pg8::StaticOrder, true, true>(lds + RING_OFF, g, S, E, wave);
        GRID_BAR();
    }
#endif
#if PROBE_REP == 50 || PROBE_REP == 51
    if (IN(5)) {
        constexpr int LD = PROBE_REP == 50 ? FF : DM;
        pg8::Gemm g{(const pg8::bf16_t*)(ws + WS_H), (const pg8::bf16_t*)(ws + WS_WDN), MP, DM, FF, LD, LD, 31, 0, 128, 128}; pg8::StaticOrder S; S.init(MP, DM, G, bx);
        pg8::EpiResid E{(pg8::bf16_t*)(ws + WS_END), (unsigned long long*)(ws + WS_END + (size_t)MPAD * DM * 2), PROBE_REP == 65};
        pg8::gemm_phase<pg8::EpiResid, pg8::StaticOrder, false, true>(lds + RING_OFF, g, S, E, wave);
        GRID_BAR();
    }
#endif
    FFN_PHASES(0, 4)
    if (IN(6)) { FRESH_TID(); pool_pass(args, vcu, G, tid); if (PROBE_REP == 6) { for (int rep_ = 0; rep_ < 8; ++rep_) { GRID_BAR(); pool_pass(args, vcu, G, tid); } } if (BOTH(6)) GRID_BAR(); }
    if (IN(7)) {
        pg8::Gemm g{(const pg8::bf16_t*)(ws + WS_D), (const pg8::bf16_t*)(ws + WS_WPL), MP, DM, 512, DM, 512, 1, 512 * 2, 128, 128}; pg8::StaticOrder S; S.init(MP, DM, G, bx);
        pg8::EpiResid E{XB, SS + 3 * MPAD, 0};
        pg8::skinny_phase_narrow<pg8::EpiResid>(lds + RING_OFF, g, E, bx, G, wave);
        pg8::gemm_phase<pg8::EpiResid, pg8::StaticOrder, false, true>(lds + RING_OFF, g, S, E, wave);
        if (BOTH(7)) GRID_BAR();
    }
    FFN_PHASES(1, 8)
#undef FFN_PHASES
#undef FRESH_TID
#undef IN
#undef BOTH
#undef GRID_BAR
}
extern "C" void kernel_launch(void* const* d_in, const int* in_sizes, int n_in, void* d_out, int out_size, void* d_ws, size_t ws_size, hipStream_t stream) {
    static int grid = 0;
    if (grid == 0) {
        if (n_in != 18 || ws_size < WS_END + (size_t)MPAD * DM * 8) { fprintf(stderr, "kernel_launch: built for 18 inputs and >= %zu bytes of workspace; got n_in %d, ws %zu; nothing launched\n", (size_t)WS_END, n_in, ws_size); grid = -1; return; }
        int dev = 0, cus = 0, per_cu = 0;
        if (hipGetDevice(&dev) != hipSuccess || hipDeviceGetAttribute(&cus, hipDeviceAttributeMultiprocessorCount, dev) != hipSuccess) { fprintf(stderr, "kernel_launch: device query failed\n"); grid = -1; return; }
        if (hipFuncSetAttribute((const void*)fwd_kernel, hipFuncAttributeMaxDynamicSharedMemorySize, LDS_BYTES) != hipSuccess) { fprintf(stderr, "kernel_launch: hipFuncSetAttribute failed\n"); grid = -1; return; }
        if (hipOccupancyMaxActiveBlocksPerMultiprocessor(&per_cu, (const void*)fwd_kernel, NWAVES * 64, LDS_BYTES) != hipSuccess || per_cu < 1)
            fprintf(stderr, "kernel_launch: note: occupancy query reports %d workgroups per CU\n", per_cu);
        (void)hipGetLastError();
        grid = cus;
    }
    if (grid < 0) return;
    if (hipMemsetAsync((char*)d_ws + WS_CTL, 0, CTL_ZERO_BYTES, stream) != hipSuccess) { fprintf(stderr, "kernel_launch: memset failed\n"); return; }
    Args a{};
    for (int i = 0; i < 18; ++i) a.in[i] = (const float*)d_in[i];
    a.out = (float*)d_out; a.ws = (unsigned char*)d_ws; a.pad = 0;
    unsigned char* ws = (unsigned char*)d_ws;
#if MK_ATTN_EXTERNAL
    a.ph_lo = 0; a.ph_hi = 2; a.li = 0;
    hipLaunchKernelGGL(fwd_kernel, dim3(grid), dim3(NWAVES * 64), LDS_BYTES, stream, a);
    na::k_kmean_sample<<<DB * 64 * 1024 / 256, 256, 0, stream>>>((const float*)d_in[2], (const int*)d_in[4], (float*)(ws + WS_KMS));
    na::k_attn_prompt<<<MP * 8 / 4, 256, 0, stream>>>((const bf16*)(ws + WS_Q), (const bf16*)(ws + WS_K), (const bf16*)(ws + WS_V), (const float*)(ws + CTL_KMP), (bf16*)(ws + WS_ATT));
    na::k_attn_sample<<<MS * 8 / 4, 256, 0, stream>>>((const bf16*)(ws + WS_Q), (const bf16*)(ws + WS_K), (const bf16*)(ws + WS_V), (const float*)(ws + WS_KMS),
                                                      (const float*)d_in[2], (const float*)d_in[3], (const int*)d_in[4], (bf16*)(ws + WS_ATT));
    a.ph_lo = 2; a.ph_hi = N_PHASES; a.li = 1;
    hipLaunchKernelGGL(fwd_kernel, dim3(grid), dim3(NWAVES * 64), LDS_BYTES, stream, a);
#else
    a.ph_lo = 0; a.ph_hi = N_PHASES; a.li = 0;
    hipLaunchKernelGGL(fwd_kernel, dim3(grid), dim3(NWAVES * 64), LDS_BYTES, stream, a);
#endif
    const hipError_t le = hipPeekAtLastError();
    if (le != hipSuccess) fprintf(stderr, "kernel_launch: launch failed: %s\n", hipGetErrorName(le));
}
```

```cpp
#include <hip/hip_runtime.h>
#include <hip/hip_bf16.h>
#include <cstdio>
#include <cstdint>
#include <cmath>
#ifndef MK_ATTN_EXTERNAL
#define MK_ATTN_EXTERNAL 0
#endif
#ifndef PROBE_REP
#define PROBE_REP -1
#endif
#ifndef CONV_IN_SLOTS
#define CONV_IN_SLOTS 1
#endif
#ifndef GU1_SLOT_END
#define GU1_SLOT_END 7168
#define DN1_SLOT_END (1 << 30)
#endif
#ifndef GU1_IN_P0
#define GU1_IN_P0 0
#endif
#ifndef HALF_UNITS
#define HALF_UNITS 0
#endif
#ifndef XB_NT_STORE
#define XB_NT_STORE 0
#endif
#ifndef GEMM_A_AUX
#define GEMM_A_AUX 0
#endif
#ifndef GEMM_B_AUX
#define GEMM_B_AUX 0
#endif
constexpr int DM = 2048, SEQ = 4096, NB = 2, DB = 8, DS = 4, PAST = 16384, PAGE = 128, NPG = PAST / PAGE;
constexpr int MP = NB * SEQ, MS = DB * DS, MV = MP + MS, MPAD = 8448;
constexpr int INW = 6144, FF = 5632, HD = 128, NH = 8, CC = 1024;
constexpr float RMS_EPS = 1e-6f;
constexpr float SS_SCALE = 1048576.f;
namespace pg8 {
#define PG8_LAS __attribute__((address_space(3)))
typedef unsigned short bf16_t;
typedef short bf16x8 __attribute__((ext_vector_type(8)));
typedef float f32x4 __attribute__((ext_vector_type(4)));
typedef unsigned u32x4 __attribute__((ext_vector_type(4)));
constexpr int BM = 256, BK = 64, HALF = 128, HTB = HALF * BK * 2  , STAGE_BYTES = 8 * HTB, NXCD = 8, WGM = 8;

__host__ __device__ __forceinline__ int lds_byte(int r, int c) { const int st = (r >> 4) * 2 + (c >> 5), rr = r & 15, cc = c & 31, ob = rr * 64 + cc * 2; return st * 1024 + (ob ^ (((ob >> 9) & 1) << 5)); }
__host__ __device__ __forceinline__ void stage_rc(int b, int& R, int& C) { const int st = b / 1024, sb = b % 1024, swz = sb ^ (((sb >> 9) & 1) << 5); R = (st >> 1) * 16 + swz / 64; C = (st & 1) * 32 + (swz % 64) / 2; }
__host__ __device__ __forceinline__ int perm32(int rho) { const int n = rho >> 4, i = rho & 15; return 8 * (i >> 2) + 4 * n + (i & 3); }

struct Unit { int pm, pn, half; };
struct Gemm { const bf16_t* A; const bf16_t* Bt; int M, N, K, lda, ldb, gshift, gstride; size_t kstepA, kstepB; };

struct StaticOrder {
    int nM, nN, nwg, G, c, lim;
    __host__ __device__ void init(int M, int N, int G_, int c_) { nM = M / BM; nN = N / BM; nwg = nM * nN; G = G_; c = c_; lim = nwg; }
    __host__ __device__ bool next(int i, Unit& u) const { const long L = (long)i * G + c; if (L >= lim) return false; map(L, u); return true; }
    __host__ __device__ void map(long L, Unit& u) const {
        int wgid = (int)L; { const int q = nwg / NXCD, r = nwg % NXCD, xcd = wgid % NXCD, off = wgid / NXCD; wgid = (xcd < r ? xcd * (q + 1) : r * (q + 1) + (xcd - r) * q) + off; }
        const int nig = WGM * nN, gid = wgid / nig, fm = gid * WGM, gsz = (nM - fm) < WGM ? (nM - fm) : WGM;
        u.pm = fm + ((wgid % nig) % gsz); u.pn = (wgid % nig) / gsz; u.half = 0;
    }
    __device__ __forceinline__ void a_ready(const Unit&) const {}
    __device__ __forceinline__ void done(const Unit&) const {}
};

__device__ __forceinline__ unsigned cvt_pk_bf16(float lo, float hi) { unsigned r; asm volatile("v_cvt_pk_bf16_f32 %0, %1, %2" : "=v"(r) : "v"(lo), "v"(hi)); return r; }
typedef unsigned u32x2 __attribute__((ext_vector_type(2)));
__device__ __forceinline__ float ss_to_rstd(unsigned long long s) { return rsqrtf((float)s * (1.0f / (SS_SCALE * (float)DM)) + RMS_EPS); }
__device__ __forceinline__ u32x4 pack8f(const f32x4 a, const f32x4 b) { u32x4 w; w.x = cvt_pk_bf16(a[0], a[1]); w.y = cvt_pk_bf16(a[2], a[3]); w.z = cvt_pk_bf16(b[0], b[1]); w.w = cvt_pk_bf16(b[2], b[3]); return w; }
__device__ __forceinline__ u32x2 pack4f(const f32x4 a) { u32x2 w; w.x = cvt_pk_bf16(a[0], a[1]); w.y = cvt_pk_bf16(a[2], a[3]); return w; }
template <bool GUARD>
__device__ __forceinline__ void load_rstd8(const unsigned long long* ss, int rbase, float (&rs)[2][4]) {
    unsigned long long s[2][4];
#pragma unroll
    for (int ai = 0; ai < 2; ++ai)
#pragma unroll
        for (int m = 0; m < 4; ++m) { const int row = rbase + ai * HALF + m * 16; s[ai][m] = (!GUARD || row < MV) ? ss[row] : 0ull; }
#pragma unroll
    for (int ai = 0; ai < 2; ++ai)
#pragma unroll
        for (int m = 0; m < 4; ++m) rs[ai][m] = ss_to_rstd(s[ai][m]);
}

struct EpiInProj {
    static constexpr bool PERM = true, AFTER_DRAIN = false, ACC_INIT = false;
    const unsigned long long* ss; const float* cosT; const float* sinT;
    bf16_t *Qb, *Kb, *Vb, *Gb, *Ub;
    float *o_kp, *o_vp, *o_ks, *o_vs, *o_cp, *o_cs; float* kmean;
    template <bool GUARD>
    __device__ __forceinline__ void run(const f32x4 (&acc)[2][2][4][2], const Unit& u, int wr, int wc, int fr, int fq) const {
        const int pn = u.pn, typ = pn >> 2, rbase = u.pm * BM + wr * 64 + fr;
        float rs[2][4]; load_rstd8<GUARD>(ss, rbase, rs);
        if (typ <= 1) {
            const int head = 2 * (pn & 3) + (wc >> 1), i0 = 32 * (wc & 1) + 8 * fq, colb = head * HD + i0;
            f32x4 cs[2][2];
#pragma unroll
            for (int bj = 0; bj < 2; ++bj) { cs[bj][0] = (f32x4){0.f, 0.f, 0.f, 0.f}; cs[bj][1] = (f32x4){0.f, 0.f, 0.f, 0.f}; }
#pragma unroll
            for (int am = 0; am < 4; ++am) {
                const int ai = am >> 1;
                f32x4 c4[2][2], s4[2][2];
#pragma unroll
                for (int mm = 0; mm < 2; ++mm) { const int m = (am & 1) * 2 + mm, row = rbase + ai * HALF + m * 16;
                    const int pidx = row < MP ? (row & (SEQ - 1)) : SEQ + ((row - MP) & (DS - 1));
#pragma unroll
                    for (int n = 0; n < 2; ++n) { c4[mm][n] = *(const f32x4*)(cosT + pidx * 64 + i0 + 4 * n); s4[mm][n] = *(const f32x4*)(sinT + pidx * 64 + i0 + 4 * n); } }
#pragma unroll
                for (int mm = 0; mm < 2; ++mm) {
                    const int m = (am & 1) * 2 + mm, row = rbase + ai * HALF + m * 16;
                    if (!GUARD || row < MV) {
                        const float rstd = rs[ai][m];
                        f32x4 o1[2], o2[2];
#pragma unroll
                        for (int n = 0; n < 2; ++n) { const f32x4 x1 = acc[ai][0][m][n] * rstd, x2 = acc[ai][1][m][n] * rstd;
                            o1[n] = x1 * c4[mm][n] - x2 * s4[mm][n]; o2[n] = x2 * c4[mm][n] + x1 * s4[mm][n]; }
                        bf16_t* dst = (typ == 0 ? Qb : Kb) + (size_t)row * 1024 + colb;
                        *(u32x4*)dst = pack8f(o1[0], o1[1]); *(u32x4*)(dst + 64) = pack8f(o2[0], o2[1]);
                        if (typ == 1) {
                            float* od = ((!GUARD || row < MP) ? o_kp + (size_t)row * 1024 : o_ks + (size_t)(row - MP) * 1024) + colb;
                            *(f32x4*)od = o1[0]; *(f32x4*)(od + 4) = o1[1]; *(f32x4*)(od + 64) = o2[0]; *(f32x4*)(od + 68) = o2[1];
                            cs[0][0] += o1[0]; cs[0][1] += o1[1]; cs[1][0] += o2[0]; cs[1][1] += o2[1];
                        }
                    }
                }
                asm volatile("" ::: "memory");
            }
            if (!GUARD && typ == 1) {
#pragma unroll
                for (int hf = 0; hf < 2; ++hf)
#pragma unroll
                    for (int n = 0; n < 2; ++n)
#pragma unroll
                        for (int e = 0; e < 4; ++e) {
                            float v = cs[hf][n][e];
                            v += __shfl_xor(v, 1); v += __shfl_xor(v, 2); v += __shfl_xor(v, 4); v += __shfl_xor(v, 8);
                            if (fr == 0) atomicAdd(kmean + ((size_t)u.pm * NH + head) * HD + 64 * hf + i0 + 4 * n + e, v);
                        }
            }
        } else if (typ <= 3) {
            const int colb = (pn & 3) * 256 + 32 * wc + 8 * fq;
#pragma unroll
            for (int ai = 0; ai < 2; ++ai)
#pragma unroll
                for (int m = 0; m < 4; ++m) {
                    const int row = rbase + ai * HALF + m * 16;
                    if (!GUARD || row < MV) {
                        const float rstd = rs[ai][m];
#pragma unroll
                        for (int bj = 0; bj < 2; ++bj) {
                            const f32x4 v0 = acc[ai][bj][m][0] * rstd, v1 = acc[ai][bj][m][1] * rstd;
                            *(u32x4*)((typ == 2 ? Vb : Gb) + (size_t)row * 1024 + colb + bj * HALF) = pack8f(v0, v1);
                            if (typ == 2) {
                                float* od = ((!GUARD || row < MP) ? o_vp + (size_t)row * 1024 : o_vs + (size_t)(row - MP) * 1024) + colb + bj * HALF;
                                *(f32x4*)od = v0; *(f32x4*)(od + 4) = v1;
                            }
                        }
                    }
                }
        } else {
            const int ch = (pn - 16) * 128 + 32 * wc + 8 * fq;
#pragma unroll
            for (int ai = 0; ai < 2; ++ai)
#pragma unroll
                for (int m = 0; m < 4; ++m) {
                    const int row = rbase + ai * HALF + m * 16;
                    if (!GUARD || row < MV) {
                        const float rstd = rs[ai][m], r2 = rstd * rstd;
                        const f32x4 u0 = acc[ai][0][m][0] * acc[ai][1][m][0] * r2, u1 = acc[ai][0][m][1] * acc[ai][1][m][1] * r2;
                        *(u32x4*)(Ub + (size_t)row * 1024 + ch) = pack8f(u0, u1);
                        if (!GUARD) { const int t = row & (SEQ - 1);
                            if (t >= SEQ - 2) { float* od = o_cp + ((size_t)(row >> 12) * 2 + (t - (SEQ - 2))) * CC + ch; *(f32x4*)od = u0; *(f32x4*)(od + 4) = u1; } }
                        else { const int t = (row - MP) & (DS - 1);
                            if (t >= DS - 2) { float* od = o_cs + ((size_t)((row - MP) >> 2) * 2 + (t - (DS - 2))) * CC + ch; *(f32x4*)od = u0; *(f32x4*)(od + 4) = u1; } }
                    }
                }
        }
    }
};

__device__ __forceinline__ int rcol(int pn, int wc, int bj, int fq) { return pn * BM + 64 * wc + 32 * bj + 8 * fq; }
__device__ __forceinline__ f32x4 bflo4(const u32x4 w) { return (f32x4){__uint_as_float(w.x << 16), __uint_as_float(w.x & 0xffff0000u), __uint_as_float(w.y << 16), __uint_as_float(w.y & 0xffff0000u)}; }
__device__ __forceinline__ f32x4 bfhi4(const u32x4 w) { return (f32x4){__uint_as_float(w.z << 16), __uint_as_float(w.z & 0xffff0000u), __uint_as_float(w.w << 16), __uint_as_float(w.w & 0xffff0000u)}; }
struct EpiResid {
    static constexpr bool PERM = true, AFTER_DRAIN = false, ACC_INIT = true;
    bf16_t* XB; unsigned long long* ss; int noat;
    __device__ __forceinline__ void init_load(u32x4 (&raw)[2][4][2], const Unit& u, int wr, int wc, int fr, int fq) const {
        const int rbase = u.pm * BM + wr * 64 + fr;
#pragma unroll
        for (int ai = 0; ai < 2; ++ai)
#pragma unroll
            for (int m = 0; m < 4; ++m)
#pragma unroll
                for (int bj = 0; bj < 2; ++bj) raw[ai][m][bj] = *(const u32x4*)(XB + (size_t)(rbase + ai * HALF + m * 16) * DM + rcol(u.pn, wc, bj, fq));
    }
    __device__ __forceinline__ void init_acc(f32x4 (&acc)[2][2][4][2], const u32x4 (&raw)[2][4][2]) const {
#pragma unroll
        for (int ai = 0; ai < 2; ++ai)
#pragma unroll
            for (int m = 0; m < 4; ++m)
#pragma unroll
                for (int bj = 0; bj < 2; ++bj) { acc[ai][bj][m][0] = bflo4(raw[ai][m][bj]); acc[ai][bj][m][1] = bfhi4(raw[ai][m][bj]); }
    }
    __device__ __forceinline__ void run_narrow(const f32x4 (&v)[2], int pn, int wc, int bj, int n, int fr, int fq) const {
        const int col0 = rcol(pn, wc, bj, fq) + 4 * n;
        u32x2 xo[2];
#pragma unroll
        for (int m = 0; m < 2; ++m) xo[m] = *(const u32x2*)(XB + (size_t)(MP + 16 * m + fr) * DM + col0);
#pragma unroll
        for (int m = 0; m < 2; ++m) {
            const int row = MP + 16 * m + fr;
            const f32x4 a0 = (f32x4){__uint_as_float(xo[m].x << 16), __uint_as_float(xo[m].x & 0xffff0000u), __uint_as_float(xo[m].y << 16), __uint_as_float(xo[m].y & 0xffff0000u)} + v[m];
            float part = (a0[0] * a0[0] + a0[1] * a0[1]) + (a0[2] * a0[2] + a0[3] * a0[3]);
            *(u32x2*)(XB + (size_t)row * DM + col0) = pack4f(a0);
            part += __shfl_xor(part, 16); part += __shfl_xor(part, 32);
            if (fq == 0) atomicAdd(ss + row, (unsigned long long)(part * SS_SCALE + 0.5f));
        }
    }
    template <bool GUARD>
    __device__ __forceinline__ void run(const f32x4 (&acc)[2][2][4][2], const Unit& u, int wr, int wc, int fr, int fq) const {
        const int rbase = u.pm * BM + wr * 64 + fr;
        u32x4 xo[2][4][2];
#pragma unroll
        for (int ai = 0; ai < 2; ++ai)
#pragma unroll
            for (int m = 0; m < 4; ++m) {
                const int row = rbase + ai * HALF + m * 16;
#pragma unroll
                for (int bj = 0; bj < 2; ++bj) xo[ai][m][bj] = (GUARD && row < MV) ? *(const u32x4*)(XB + (size_t)row * DM + rcol(u.pn, wc, bj, fq)) : (u32x4){0u, 0u, 0u, 0u};
            }
        asm volatile("" ::: "memory");
#pragma unroll
        for (int ai = 0; ai < 2; ++ai)
#pragma unroll
            for (int m = 0; m < 4; ++m) {
                const int row = rbase + ai * HALF + m * 16;
                float part = 0.f;
                if (!GUARD || row < MV) {
#pragma unroll
                    for (int bj = 0; bj < 2; ++bj) {
                        const f32x4 a0 = GUARD ? bflo4(xo[ai][m][bj]) + acc[ai][bj][m][0] : acc[ai][bj][m][0];
                        const f32x4 a1 = GUARD ? bfhi4(xo[ai][m][bj]) + acc[ai][bj][m][1] : acc[ai][bj][m][1];
                        part += (a0[0] * a0[0] + a0[1] * a0[1]) + (a0[2] * a0[2] + a0[3] * a0[3]) + (a1[0] * a1[0] + a1[1] * a1[1]) + (a1[2] * a1[2] + a1[3] * a1[3]);
                        if (XB_NT_STORE) __builtin_nontemporal_store(pack8f(a0, a1), (u32x4*)(XB + (size_t)row * DM + rcol(u.pn, wc, bj, fq))); else *(u32x4*)(XB + (size_t)row * DM + rcol(u.pn, wc, bj, fq)) = pack8f(a0, a1);
                    }
                }
                part += __shfl_xor(part, 16); part += __shfl_xor(part, 32);
                if (fq == 0 && (!GUARD || row < MV)) { if (!noat) atomicAdd(ss + row, (unsigned long long)(part * SS_SCALE + 0.5f)); else if (part < 0.f) ss[row] = 1ull; }
            }
    }
};

struct EpiSwiGLU {
    static constexpr bool PERM = true, AFTER_DRAIN = false, ACC_INIT = false;
    const unsigned long long* ss; bf16_t* H;
    template <bool GUARD>
    __device__ __forceinline__ void run_half(const f32x4 (&acc)[2][2][4][2], const Unit& u, int wr, int wc, int fr, int fq) const {
        const int rbase = u.pm * BM + u.half * HALF + wr * 64 + fr, col0 = u.pn * HALF + 32 * wc + 8 * fq;
        unsigned long long s[4];
#pragma unroll
        for (int m = 0; m < 4; ++m) s[m] = ss[rbase + m * 16];
#pragma unroll
        for (int m = 0; m < 4; ++m) {
            const int row = rbase + m * 16; const float rstd = ss_to_rstd(s[m]);
            f32x4 h[2];
#pragma unroll
            for (int n = 0; n < 2; ++n)
#pragma unroll
                for (int e = 0; e < 4; ++e) { const float g = acc[0][0][m][n][e] * rstd, up = acc[0][1][m][n][e] * rstd;
                    h[n][e] = g * up * __builtin_amdgcn_rcpf(1.0f + __expf(-g)); }
            *(u32x4*)(H + ((size_t)(col0 >> 6) * MPAD + row) * 64 + (col0 & 63)) = pack8f(h[0], h[1]);
        }
    }
    template <bool GUARD>
    __device__ __forceinline__ void run(const f32x4 (&acc)[2][2][4][2], const Unit& u, int wr, int wc, int fr, int fq) const {
        const int rbase = u.pm * BM + wr * 64 + fr, col0 = u.pn * HALF + 32 * wc + 8 * fq;
        float rs[2][4]; load_rstd8<GUARD>(ss, rbase, rs);
#pragma unroll
        for (int ai = 0; ai < 2; ++ai)
#pragma unroll
            for (int m = 0; m < 4; ++m) {
                const int row = rbase + ai * HALF + m * 16;
                if (!GUARD || row < MV) {
                    const float rstd = rs[ai][m];
                    f32x4 h[2];
#pragma unroll
                    for (int n = 0; n < 2; ++n)
#pragma unroll
                        for (int e = 0; e < 4; ++e) { const float g = acc[ai][0][m][n][e] * rstd, up = acc[ai][1][m][n][e] * rstd;
                            h[n][e] = g * up * __builtin_amdgcn_rcpf(1.0f + __expf(-g)); }
                    *(u32x4*)(H + ((size_t)(col0 >> 6) * MPAD + row) * 64 + (col0 & 63)) = pack8f(h[0], h[1]);
                }
            }
    }
};

struct EpiFinal {
    static constexpr bool PERM = true, AFTER_DRAIN = true, ACC_INIT = true;
    const bf16_t* XB; unsigned long long* ss; const float* gfin; float* out; unsigned* cnt; unsigned* tmo;
    __device__ __forceinline__ bool wait_count(unsigned* c, unsigned want, int lane) const {
        unsigned sp = 0;
        while ((unsigned)__builtin_amdgcn_readfirstlane(__hip_atomic_load(c, __ATOMIC_RELAXED, __HIP_MEMORY_SCOPE_AGENT)) < want) {
            __builtin_amdgcn_s_sleep(1);
            if ((++sp & 255u) == 0u) { if (__hip_atomic_load(tmo, __ATOMIC_RELAXED, __HIP_MEMORY_SCOPE_AGENT)) return false;
                if (sp > (1u << 22)) { if (lane == 0) __hip_atomic_store(tmo, 1u, __ATOMIC_RELAXED, __HIP_MEMORY_SCOPE_AGENT); return false; } }
        }
        return true;
    }
    __device__ __forceinline__ void init_load(u32x4 (&raw)[2][4][2], const Unit& u, int wr, int wc, int fr, int fq) const {
        const int rbase = u.pm * BM + wr * 64 + fr;
#pragma unroll
        for (int ai = 0; ai < 2; ++ai)
#pragma unroll
            for (int m = 0; m < 4; ++m)
#pragma unroll
                for (int bj = 0; bj < 2; ++bj) raw[ai][m][bj] = *(const u32x4*)(XB + (size_t)(rbase + ai * HALF + m * 16) * DM + rcol(u.pn, wc, bj, fq));
    }
    __device__ __forceinline__ void init_acc(f32x4 (&acc)[2][2][4][2], const u32x4 (&raw)[2][4][2]) const {
#pragma unroll
        for (int ai = 0; ai < 2; ++ai)
#pragma unroll
            for (int m = 0; m < 4; ++m)
#pragma unroll
                for (int bj = 0; bj < 2; ++bj) { acc[ai][bj][m][0] = bflo4(raw[ai][m][bj]); acc[ai][bj][m][1] = bfhi4(raw[ai][m][bj]); }
    }
    __device__ __forceinline__ void sumsq4(const f32x4 (&v)[2][4][2], int rbase, int fq) const {
#pragma unroll
        for (int m = 0; m < 4; ++m) {
            float part = 0.f;
#pragma unroll
            for (int bj = 0; bj < 2; ++bj) { const f32x4 a0 = v[bj][m][0], a1 = v[bj][m][1];
                part += (a0[0] * a0[0] + a0[1] * a0[1]) + (a0[2] * a0[2] + a0[3] * a0[3]) + (a1[0] * a1[0] + a1[1] * a1[1]) + (a1[2] * a1[2] + a1[3] * a1[3]); }
            part += __shfl_xor(part, 16); part += __shfl_xor(part, 32);
            if (fq == 0) atomicAdd(ss + rbase + m * 16, (unsigned long long)(part * SS_SCALE + 0.5f));
        }
    }
    template <int NM>
    __device__ __forceinline__ void write_y(const f32x4 (&v)[2][4][2], int rbase, int pn, int wc, int fq, bool bad) const {
        unsigned long long s[NM];
#pragma unroll
        for (int m = 0; m < NM; ++m) s[m] = __hip_atomic_load(ss + rbase + m * 16, __ATOMIC_RELAXED, __HIP_MEMORY_SCOPE_AGENT);
        f32x4 g[2][2];
#pragma unroll
        for (int bj = 0; bj < 2; ++bj)
#pragma unroll
            for (int n = 0; n < 2; ++n) g[bj][n] = *(const f32x4*)(gfin + rcol(pn, wc, bj, fq) + 4 * n);
        const float qnan = __builtin_nanf("");
#pragma unroll
        for (int m = 0; m < NM; ++m) {
            const float rstd = bad ? qnan : ss_to_rstd(s[m]);
            float* dst = out + (size_t)(rbase + m * 16) * DM;
#pragma unroll
            for (int bj = 0; bj < 2; ++bj)
#pragma unroll
                for (int n = 0; n < 2; ++n) *(f32x4*)(dst + rcol(pn, wc, bj, fq) + 4 * n) = v[bj][m][n] * rstd * g[bj][n];
        }
    }
    __device__ __forceinline__ void fused(f32x4 (&acc)[2][2][4][2], const Unit& u, int wr, int wc, int fr, int fq, PG8_LAS unsigned char* lds, int wid, int lane) const {
        const int rbase = u.pm * BM + wr * 64 + fr;
        sumsq4(acc[0], rbase, fq);
        sumsq4(acc[1], rbase + HALF, fq);
        asm volatile("s_waitcnt vmcnt(0)" ::: "memory");
        if (lane == 0) __hip_atomic_fetch_add(cnt + 64 * u.pm, 1u, __ATOMIC_RELAXED, __HIP_MEMORY_SCOPE_AGENT);
        PG8_LAS unsigned* flag = (PG8_LAS unsigned*)lds;
        if (wid == 0) { const bool ok = wait_count(cnt + 64 * u.pm, 64u, lane); __builtin_amdgcn_fence(__ATOMIC_ACQUIRE, "agent"); if (lane == 0) flag[0] = ok ? 0u : 1u; }
        asm volatile("s_waitcnt vmcnt(0) lgkmcnt(0)" ::: "memory"); __builtin_amdgcn_s_barrier(); asm volatile("" ::: "memory");
        const bool bad = flag[0] != 0u;
        write_y<4>(acc[0], rbase, u.pn, wc, fq, bad);
        write_y<4>(acc[1], rbase + HALF, u.pn, wc, fq, bad);
    }
    __device__ __forceinline__ void run_narrow(const f32x4 (&v)[2], int pn, int wc, int bj, int n, int fr, int fq) const {
        const int col0 = rcol(pn, wc, bj, fq) + 4 * n, lane = fq * 16 + fr;
        u32x2 xo[2]; f32x4 x[2];
#pragma unroll
        for (int m = 0; m < 2; ++m) xo[m] = *(const u32x2*)(XB + (size_t)(MP + 16 * m + fr) * DM + col0);
#pragma unroll
        for (int m = 0; m < 2; ++m) {
            x[m] = (f32x4){__uint_as_float(xo[m].x << 16), __uint_as_float(xo[m].x & 0xffff0000u), __uint_as_float(xo[m].y << 16), __uint_as_float(xo[m].y & 0xffff0000u)} + v[m];
            float part = (x[m][0] * x[m][0] + x[m][1] * x[m][1]) + (x[m][2] * x[m][2] + x[m][3] * x[m][3]);
            part += __shfl_xor(part, 16); part += __shfl_xor(part, 32);
            if (fq == 0) atomicAdd(ss + MP + 16 * m + fr, (unsigned long long)(part * SS_SCALE + 0.5f));
        }
        asm volatile("s_waitcnt vmcnt(0)" ::: "memory");
        if (lane == 0) __hip_atomic_fetch_add(cnt + 64 * (MP / BM), 1u, __ATOMIC_RELAXED, __HIP_MEMORY_SCOPE_AGENT);
        const bool ok = wait_count(cnt + 64 * (MP / BM), (unsigned)(DM / BM * 16), lane);
        __builtin_amdgcn_fence(__ATOMIC_ACQUIRE, "agent");
        asm volatile("s_waitcnt vmcnt(0)" ::: "memory");
        const f32x4 g4 = *(const f32x4*)(gfin + col0); const float qnan = __builtin_nanf("");
#pragma unroll
        for (int m = 0; m < 2; ++m) {
            const unsigned long long sv = __hip_atomic_load(ss + MP + 16 * m + fr, __ATOMIC_RELAXED, __HIP_MEMORY_SCOPE_AGENT);
            const float rstd = ok ? ss_to_rstd(sv) : qnan;
            *(f32x4*)(out + (size_t)(MP + 16 * m + fr) * DM + col0) = x[m] * rstd * g4;
        }
    }
};
template <class Epi, class Sched, bool ALIGN_EPI = false, bool SP2 = false>
__device__ __forceinline__ void gemm_phase(PG8_LAS unsigned char* lds, const Gemm g, const Sched& S, const Epi& E, const int wv  ) {
    int tid = wv * 64 + (int)__builtin_amdgcn_mbcnt_hi(~0u, __builtin_amdgcn_mbcnt_lo(~0u, 0u)); asm volatile("" : "+v"(tid));
    const int wid = wv, lane = tid & 63, wr = wid >> 2, wc = wid & 3, fr = lane & 15, fq = lane >> 4;
    static_assert(SP2 || !Epi::ACC_INIT, "accumulator initialisation from the epilogue's addend is wired into the SP2 prologue only");
    const int K = g.K, nt = K / BK;
    unsigned voffA[2], voffB[2];
#pragma unroll
    for (int i = 0; i < 2; ++i) { int R, C; stage_rc(tid * 16 + i * 8192, R, C); const int Rb = Epi::PERM ? ((R & ~31) + perm32(R & 31)) : R;
        voffA[i] = (unsigned)(R * g.lda + C) * 2u; voffB[i] = (unsigned)(Rb * g.ldb + C) * 2u; }
    const size_t kstepA = g.kstepA, kstepB = g.kstepB;
    const size_t hstepA = (size_t)HALF * g.lda * 2, hstepB = (size_t)HALF * g.ldb * 2;
    const size_t tstepA = 2 * hstepA, tstepB = 2 * hstepB;
    const unsigned ldsw = (unsigned)wid * 1024u;
    const int aoff = lds_byte(wr * 64 + fr, fq * 8), boff = lds_byte(wc * 32 + fr, fq * 8);
#define PG8_SA(b, h) (((b) * 2 + (h)) * HTB)
#define PG8_SB(b, h) ((4 + (b) * 2 + (h)) * HTB)
#define PG8_STAGE_AUX(bufoff, gbase, voff, aux) do { _Pragma("unroll") for (int _i = 0; _i < 2; ++_i) \
        __builtin_amdgcn_global_load_lds((const unsigned*)((const char*)(gbase) + (voff)[_i]), (PG8_LAS unsigned*)(lds + (bufoff) + ldsw + _i * 8192), 16, 0, aux); } while (0)
#define PG8_STAGE(bufoff, gbase, voff) PG8_STAGE_AUX(bufoff, gbase, voff, GEMM_A_AUX)
#define PG8_STAGEB(bufoff, gbase, voff) PG8_STAGE_AUX(bufoff, gbase, voff, GEMM_B_AUX)
#define PG8_LDA(dst, b, h) do { _Pragma("unroll") for (int m = 0; m < 4; ++m) _Pragma("unroll") for (int k = 0; k < 2; ++k) dst[m][k] = *(const PG8_LAS bf16x8*)(lds + PG8_SA(b, h) + aoff + m * 2048 + k * 1024); } while (0)
#define PG8_LDB(dst, b, h) do { _Pragma("unroll") for (int n = 0; n < 2; ++n) _Pragma("unroll") for (int k = 0; k < 2; ++k) dst[n][k] = *(const PG8_LAS bf16x8*)(lds + PG8_SB(b, h) + boff + n * 2048 + k * 1024); } while (0)
#define PG8_MMA(ai, bj, At, Bt) do { __builtin_amdgcn_s_setprio(1); _Pragma("unroll") for (int m = 0; m < 4; ++m) _Pragma("unroll") for (int n = 0; n < 2; ++n) _Pragma("unroll") for (int k = 0; k < 2; ++k) \
        acc[ai][bj][m][n] = __builtin_amdgcn_mfma_f32_16x16x32_bf16(Bt[n][k], At[m][k], acc[ai][bj][m][n], 0, 0, 0); __builtin_amdgcn_s_setprio(0); } while (0)
#define PG8_WAIT_V(n) asm volatile("s_waitcnt vmcnt(" #n ")" ::: "memory")
#define PG8_WAIT_L(n) asm volatile("s_waitcnt lgkmcnt(" #n ")" ::: "memory")
#define PG8_BAR __builtin_amdgcn_s_barrier()
#define PG8_SCHED __builtin_amdgcn_sched_barrier(0)
    Unit cur, nxt; int ui = 0;
    if (!S.next(0, cur)) return;
    f32x4 acc[2][2][4][2];
#pragma unroll
    for (int a = 0; a < 2; ++a)
#pragma unroll
        for (int b = 0; b < 2; ++b)
#pragma unroll
            for (int m = 0; m < 4; ++m)
#pragma unroll
                for (int n = 0; n < 2; ++n) acc[a][b][m][n] = (f32x4){0.f, 0.f, 0.f, 0.f};
    bf16x8 At[4][2], B0[2][2], B1[2][2];
    const char* cA = (const char*)g.A + (size_t)cur.pm * tstepA + (size_t)(cur.pn >> g.gshift) * g.gstride; const char* cB = (const char*)g.Bt + (size_t)cur.pn * tstepB;
    S.a_ready(cur);
    if constexpr (SP2) {
        PG8_STAGEB(PG8_SB(0, 0), cB, voffB); PG8_STAGEB(PG8_SB(0, 1), cB + hstepB, voffB); PG8_STAGE(PG8_SA(0, 0), cA, voffA); PG8_STAGE(PG8_SA(0, 1), cA + hstepA, voffA);
        if constexpr (Epi::ACC_INIT) {
            u32x4 raw[2][4][2];
            E.init_load(raw, cur, wr, wc, fr, fq);
            if (wr == 1) PG8_BAR;
            PG8_WAIT_V(18); PG8_BAR;
            PG8_STAGEB(PG8_SB(1, 0), cB + kstepB, voffB); PG8_STAGE(PG8_SA(1, 0), cA + kstepA, voffA); PG8_STAGEB(PG8_SB(1, 1), cB + hstepB + kstepB, voffB);
            PG8_WAIT_V(6); PG8_BAR;
            E.init_acc(acc, raw);
        } else {
        if (wr == 1) PG8_BAR;
        PG8_WAIT_V(2); PG8_BAR;
        PG8_STAGEB(PG8_SB(1, 0), cB + kstepB, voffB); PG8_STAGE(PG8_SA(1, 0), cA + kstepA, voffA); PG8_STAGEB(PG8_SB(1, 1), cB + hstepB + kstepB, voffB);
        PG8_WAIT_V(6); PG8_BAR;
        }
    } else {
        PG8_STAGEB(PG8_SB(0, 0), cB, voffB); PG8_STAGE(PG8_SA(0, 0), cA, voffA); PG8_STAGEB(PG8_SB(0, 1), cB + hstepB, voffB); PG8_STAGE(PG8_SA(0, 1), cA + hstepA, voffA);
        if (wr == 1) PG8_BAR;
        PG8_WAIT_V(4); PG8_BAR;
        PG8_STAGEB(PG8_SB(1, 0), cB + kstepB, voffB); PG8_STAGE(PG8_SA(1, 0), cA + kstepA, voffA); PG8_STAGEB(PG8_SB(1, 1), cB + hstepB + kstepB, voffB);
        PG8_WAIT_V(6); PG8_BAR;
    }
    for (;;) {
        const bool has_next = S.next(ui + 1, nxt);
        const char* nA = has_next ? (const char*)g.A + (size_t)nxt.pm * tstepA + (size_t)(nxt.pn >> g.gshift) * g.gstride : cA; const char* nB = has_next ? (const char*)g.Bt + (size_t)nxt.pn * tstepB : cB;
        for (int t = 0; t < nt; t += 2) {
            const bool last = (t == nt - 2);
            const char* a1 = cA + (size_t)(t + 1) * kstepA;
            const char* a2 = last ? nA : cA + (size_t)(t + 2) * kstepA; const char* b2 = last ? nB : cB + (size_t)(t + 2) * kstepB;
            const char* a3 = a2 + kstepA; const char* b3 = b2 + kstepB;
            if (last && has_next) S.a_ready(nxt);
            if constexpr (SP2) {
            PG8_LDB(B0, 0, 0); PG8_LDB(B1, 0, 1); PG8_SCHED; PG8_LDA(At, 0, 0); PG8_STAGE(PG8_SA(1, 1), a1 + hstepA, voffA);
            PG8_WAIT_V(8); PG8_WAIT_L(0); PG8_BAR; PG8_MMA(0, 0, At, B0); PG8_MMA(0, 1, At, B1); PG8_BAR; PG8_SCHED;
            PG8_LDA(At, 0, 1); PG8_STAGEB(PG8_SB(0, 0), b2, voffB); PG8_STAGEB(PG8_SB(0, 1), b2 + hstepB, voffB); PG8_STAGE(PG8_SA(0, 0), a2, voffA);
            PG8_WAIT_V(8); PG8_WAIT_L(0); PG8_BAR; PG8_MMA(1, 0, At, B0); PG8_MMA(1, 1, At, B1); PG8_BAR; PG8_SCHED;
            PG8_LDB(B0, 1, 0); PG8_LDB(B1, 1, 1); PG8_SCHED; PG8_LDA(At, 1, 0); PG8_STAGE(PG8_SA(0, 1), a2 + hstepA, voffA);
            PG8_WAIT_V(8); PG8_WAIT_L(0); PG8_BAR; PG8_MMA(0, 0, At, B0); PG8_MMA(0, 1, At, B1); PG8_BAR; PG8_SCHED;
            PG8_LDA(At, 1, 1); PG8_STAGEB(PG8_SB(1, 0), b3, voffB); PG8_STAGEB(PG8_SB(1, 1), b3 + hstepB, voffB); PG8_STAGE(PG8_SA(1, 0), a3, voffA);
            PG8_WAIT_V(8); PG8_WAIT_L(0); PG8_BAR; PG8_MMA(1, 0, At, B0); PG8_MMA(1, 1, At, B1); PG8_BAR; PG8_SCHED;
            } else {
            PG8_LDB(B0, 0, 0); PG8_SCHED; PG8_LDA(At, 0, 0); PG8_STAGE(PG8_SA(1, 1), a1 + hstepA, voffA);
            PG8_WAIT_L(8); PG8_BAR; PG8_WAIT_L(0); PG8_MMA(0, 0, At, B0); PG8_BAR; PG8_SCHED;
            PG8_LDB(B1, 0, 1); PG8_STAGEB(PG8_SB(0, 0), b2, voffB);
            PG8_BAR; PG8_WAIT_L(0); PG8_MMA(0, 1, At, B1); PG8_BAR;
            PG8_LDA(At, 0, 1); PG8_STAGE(PG8_SA(0, 0), a2, voffA);
            PG8_BAR; PG8_WAIT_L(0); PG8_MMA(1, 0, At, B0); PG8_BAR; PG8_SCHED;
            PG8_STAGEB(PG8_SB(0, 1), b2 + hstepB, voffB);
            PG8_WAIT_V(6); PG8_BAR; PG8_MMA(1, 1, At, B1); PG8_BAR;
            PG8_LDB(B0, 1, 0); PG8_SCHED; PG8_LDA(At, 1, 0); PG8_STAGE(PG8_SA(0, 1), a2 + hstepA, voffA);
            PG8_WAIT_L(8); PG8_BAR; PG8_WAIT_L(0); PG8_MMA(0, 0, At, B0); PG8_BAR; PG8_SCHED;
            PG8_LDB(B1, 1, 1); PG8_STAGEB(PG8_SB(1, 0), b3, voffB);
            PG8_BAR; PG8_WAIT_L(0); PG8_MMA(0, 1, At, B1); PG8_BAR;
            PG8_LDA(At, 1, 1); PG8_STAGE(PG8_SA(1, 0), a3, voffA);
            PG8_BAR; PG8_WAIT_L(0); PG8_MMA(1, 0, At, B0); PG8_BAR; PG8_SCHED;
            PG8_STAGEB(PG8_SB(1, 1), b3 + hstepB, voffB);
            PG8_WAIT_V(6); PG8_BAR; PG8_MMA(1, 1, At, B1); PG8_BAR;
            }
        }
        if constexpr (ALIGN_EPI) { if (wr == 0) PG8_BAR; }
        if constexpr (!Epi::AFTER_DRAIN) { E.template run<false>(acc, cur, wr, wc, fr, fq); S.done(cur); }
        if (!has_next) break;
#pragma unroll
        for (int a = 0; a < 2; ++a)
#pragma unroll
            for (int b = 0; b < 2; ++b)
#pragma unroll
                for (int m = 0; m < 4; ++m)
#pragma unroll
                    for (int n = 0; n < 2; ++n) acc[a][b][m][n] = (f32x4){0.f, 0.f, 0.f, 0.f};
        cur = nxt; cA = nA; cB = nB; ++ui;
        if constexpr (Epi::ACC_INIT) { u32x4 raw[2][4][2]; E.init_load(raw, cur, wr, wc, fr, fq); E.init_acc(acc, raw); }
        if constexpr (ALIGN_EPI) { if (wr == 1) PG8_BAR; }
    }
    PG8_WAIT_V(0);
    if constexpr (!ALIGN_EPI) { if (wr == 0) PG8_BAR; }
    PG8_BAR;
    if constexpr (Epi::AFTER_DRAIN) { E.fused(acc, cur, wr, wc, fr, fq, lds, wid, lane); S.done(cur); }
#undef PG8_SA
#undef PG8_SB
#undef PG8_STAGE
#undef PG8_STAGEB
#undef PG8_STAGE_AUX
#undef PG8_LDA
#undef PG8_LDB
#undef PG8_MMA
#undef PG8_WAIT_V
#undef PG8_WAIT_L
#undef PG8_BAR
#undef PG8_SCHED
}

struct HalfOrder {
    StaticOrder so; long L; int half;
    __device__ __forceinline__ bool next(int i, Unit& u) const { if (i > 0) return false; so.map(L, u); u.half = half; return true; }
    __device__ __forceinline__ void a_ready(const Unit&) const {}
    __device__ __forceinline__ void done(const Unit&) const {}
};
template <class Epi, class Sched>
__device__ __forceinline__ void gemm_phase_hm(PG8_LAS unsigned char* lds, const Gemm g, const Sched& S, const Epi& E, const int wv) {
    int tid = wv * 64 + (int)__builtin_amdgcn_mbcnt_hi(~0u, __builtin_amdgcn_mbcnt_lo(~0u, 0u)); asm volatile("" : "+v"(tid));
    const int wid = wv, lane = tid & 63, wr = wid >> 2, wc = wid & 3, fr = lane & 15, fq = lane >> 4;
    const int K = g.K, nt = K / BK;
    unsigned voffA[2], voffB[2];
#pragma unroll
    for (int i = 0; i < 2; ++i) { int R, C; stage_rc(tid * 16 + i * 8192, R, C); const int Rb = Epi::PERM ? ((R & ~31) + perm32(R & 31)) : R;
        voffA[i] = (unsigned)(R * g.lda + C) * 2u; voffB[i] = (unsigned)(Rb * g.ldb + C) * 2u; }
    const size_t kstepA = g.kstepA, kstepB = g.kstepB;
    const size_t hstepA = (size_t)HALF * g.lda * 2, hstepB = (size_t)HALF * g.ldb * 2;
    const size_t tstepA = 2 * hstepA, tstepB = 2 * hstepB;
    const unsigned ldsw = (unsigned)wid * 1024u;
    const int aoff = lds_byte(wr * 64 + fr, fq * 8), boff = lds_byte(wc * 32 + fr, fq * 8);
#define PG8_SA(b, h) (((b) * 2 + (h)) * HTB)
#define PG8_SB(b, h) ((4 + (b) * 2 + (h)) * HTB)
#define PG8_STAGE(bufoff, gbase, voff) do { _Pragma("unroll") for (int _i = 0; _i < 2; ++_i) \
        __builtin_amdgcn_global_load_lds((const unsigned*)((const char*)(gbase) + (voff)[_i]), (PG8_LAS unsigned*)(lds + (bufoff) + ldsw + _i * 8192), 16, 0, 0); } while (0)
#define PG8_LDA(dst, b, h) do { _Pragma("unroll") for (int m = 0; m < 4; ++m) _Pragma("unroll") for (int k = 0; k < 2; ++k) dst[m][k] = *(const PG8_LAS bf16x8*)(lds + PG8_SA(b, h) + aoff + m * 2048 + k * 1024); } while (0)
#define PG8_LDB(dst, b, h) do { _Pragma("unroll") for (int n = 0; n < 2; ++n) _Pragma("unroll") for (int k = 0; k < 2; ++k) dst[n][k] = *(const PG8_LAS bf16x8*)(lds + PG8_SB(b, h) + boff + n * 2048 + k * 1024); } while (0)
#define PG8_MMA(ai, bj, At, Bt) do { __builtin_amdgcn_s_setprio(1); _Pragma("unroll") for (int m = 0; m < 4; ++m) _Pragma("unroll") for (int n = 0; n < 2; ++n) _Pragma("unroll") for (int k = 0; k < 2; ++k) \
        acc[ai][bj][m][n] = __builtin_amdgcn_mfma_f32_16x16x32_bf16(Bt[n][k], At[m][k], acc[ai][bj][m][n], 0, 0, 0); __builtin_amdgcn_s_setprio(0); } while (0)
#define PG8_WAIT_V(n) asm volatile("s_waitcnt vmcnt(" #n ")" ::: "memory")
#define PG8_WAIT_L(n) asm volatile("s_waitcnt lgkmcnt(" #n ")" ::: "memory")
#define PG8_BAR __builtin_amdgcn_s_barrier()
#define PG8_SCHED __builtin_amdgcn_sched_barrier(0)
    Unit cur, nxt; int ui = 0;
    if (!S.next(0, cur)) return;
    f32x4 acc[2][2][4][2];
#pragma unroll
    for (int a = 0; a < 2; ++a)
#pragma unroll
        for (int b = 0; b < 2; ++b)
#pragma unroll
            for (int m = 0; m < 4; ++m)
#pragma unroll
                for (int n = 0; n < 2; ++n) acc[a][b][m][n] = (f32x4){0.f, 0.f, 0.f, 0.f};
    bf16x8 At[4][2], B0[2][2], B1[2][2];
    const char* cA = (const char*)g.A + (size_t)cur.pm * tstepA + (size_t)cur.half * hstepA + (size_t)(cur.pn >> g.gshift) * g.gstride; const char* cB = (const char*)g.Bt + (size_t)cur.pn * tstepB;
    PG8_STAGE(PG8_SB(0, 0), cB, voffB); PG8_STAGE(PG8_SB(0, 1), cB + hstepB, voffB); PG8_STAGE(PG8_SA(0, 0), cA, voffA);
    if (wr == 1) PG8_BAR;
    PG8_WAIT_V(0); PG8_BAR;
    PG8_STAGE(PG8_SB(1, 0), cB + kstepB, voffB); PG8_STAGE(PG8_SA(1, 0), cA + kstepA, voffA); PG8_STAGE(PG8_SB(1, 1), cB + hstepB + kstepB, voffB);
    PG8_WAIT_V(6); PG8_BAR;
    for (;;) {
        const bool has_next = S.next(ui + 1, nxt);
        const char* nA = has_next ? (const char*)g.A + (size_t)nxt.pm * tstepA + (size_t)nxt.half * hstepA + (size_t)(nxt.pn >> g.gshift) * g.gstride : cA; const char* nB = has_next ? (const char*)g.Bt + (size_t)nxt.pn * tstepB : cB;
        for (int t = 0; t < nt; t += 2) {
            const bool last = (t == nt - 2);
            const char* a2 = last ? nA : cA + (size_t)(t + 2) * kstepA; const char* b2 = last ? nB : cB + (size_t)(t + 2) * kstepB;
            const char* a3 = a2 + kstepA; const char* b3 = b2 + kstepB;
            PG8_LDB(B0, 0, 0); PG8_LDB(B1, 0, 1); PG8_SCHED; PG8_LDA(At, 0, 0);
            PG8_WAIT_V(6); PG8_WAIT_L(0); PG8_BAR; PG8_MMA(0, 0, At, B0); PG8_MMA(0, 1, At, B1); PG8_BAR; PG8_SCHED;
            PG8_STAGE(PG8_SB(0, 0), b2, voffB); PG8_STAGE(PG8_SB(0, 1), b2 + hstepB, voffB); PG8_STAGE(PG8_SA(0, 0), a2, voffA);
            PG8_WAIT_V(6); PG8_WAIT_L(0); PG8_BAR; PG8_BAR; PG8_SCHED;
            PG8_LDB(B0, 1, 0); PG8_LDB(B1, 1, 1); PG8_SCHED; PG8_LDA(At, 1, 0);
            PG8_WAIT_V(6); PG8_WAIT_L(0); PG8_BAR; PG8_MMA(0, 0, At, B0); PG8_MMA(0, 1, At, B1); PG8_BAR; PG8_SCHED;
            PG8_STAGE(PG8_SB(1, 0), b3, voffB); PG8_STAGE(PG8_SB(1, 1), b3 + hstepB, voffB); PG8_STAGE(PG8_SA(1, 0), a3, voffA);
            PG8_WAIT_V(6); PG8_WAIT_L(0); PG8_BAR; PG8_BAR; PG8_SCHED;
        }
        if (wr == 0) PG8_BAR;
        E.template run_half<false>(acc, cur, wr, wc, fr, fq); S.done(cur);
        if (!has_next) break;
#pragma unroll
        for (int b = 0; b < 2; ++b)
#pragma unroll
            for (int m = 0; m < 4; ++m)
#pragma unroll
                for (int n = 0; n < 2; ++n) acc[0][b][m][n] = (f32x4){0.f, 0.f, 0.f, 0.f};
        cur = nxt; cA = nA; cB = nB; ++ui;
        if (wr == 1) PG8_BAR;
    }
    PG8_WAIT_V(0);
    PG8_BAR;
#undef PG8_SA
#undef PG8_SB
#undef PG8_STAGE
#undef PG8_LDA
#undef PG8_LDB
#undef PG8_MMA
#undef PG8_WAIT_V
#undef PG8_WAIT_L
#undef PG8_BAR
#undef PG8_SCHED
}

__device__ __forceinline__ size_t skinny_koff(int k, size_t kstep) { return kstep == 128 ? (size_t)k * 2 : (size_t)(k >> 6) * kstep + (size_t)(k & 63) * 2; }
template <int NS>
__device__ __forceinline__ void skinny_steps(const char* Ab, const char* Bb, int k0, size_t kstepA, size_t kstepB, size_t a16, size_t b4, size_t b128, f32x4 (&acc)[2][2][2]) {
    bf16x8 a[NS][2], b[NS][2][2];
#pragma unroll
    for (int s = 0; s < NS; ++s) {
        const size_t ka = skinny_koff(k0 + 32 * s, kstepA), kb = skinny_koff(k0 + 32 * s, kstepB);
        a[s][0] = *(const bf16x8*)(Ab + ka); a[s][1] = *(const bf16x8*)(Ab + a16 + ka);
#pragma unroll
        for (int bj = 0; bj < 2; ++bj)
#pragma unroll
            for (int n = 0; n < 2; ++n) b[s][bj][n] = *(const bf16x8*)(Bb + bj * b128 + n * b4 + kb);
    }
#pragma unroll
    for (int s = 0; s < NS; ++s)
#pragma unroll
        for (int bj = 0; bj < 2; ++bj)
#pragma unroll
            for (int m = 0; m < 2; ++m)
#pragma unroll
                for (int n = 0; n < 2; ++n) acc[bj][m][n] = __builtin_amdgcn_mfma_f32_16x16x32_bf16(b[s][bj][n], a[s][m], acc[bj][m][n], 0, 0, 0);
}
template <class Epi>
__device__ __forceinline__ void skinny_phase(PG8_LAS unsigned char* lds, const Gemm g, const Epi& E, int first, int step, const int wv) {
    int tid = wv * 64 + (int)__builtin_amdgcn_mbcnt_hi(~0u, __builtin_amdgcn_mbcnt_lo(~0u, 0u)); asm volatile("" : "+v"(tid));
    const int wid = wv, lane = tid & 63, fr = lane & 15, fq = lane >> 4;
    const int nit = (g.N / BM) * 4, Kw = g.K / 8;
    PG8_LAS f32x4* R = (PG8_LAS f32x4*)lds;
    for (int it = first; it < nit; it += step) {
        const int pn = it >> 2, wc = it & 3;
        const int kw0 = wid * Kw;
        const char* Ab = (const char*)g.A + (size_t)(pn >> g.gshift) * g.gstride + ((size_t)(MP + fr) * g.lda + fq * 8) * 2;
        const char* Bb = (const char*)g.Bt + ((size_t)(pn * BM + 32 * wc + 8 * (fr >> 2) + (fr & 3)) * g.ldb + fq * 8) * 2;
        const size_t a16 = (size_t)16 * g.lda * 2, b4 = (size_t)4 * g.ldb * 2, b128 = (size_t)HALF * g.ldb * 2;
        f32x4 acc[2][2][2];
#pragma unroll
        for (int bj = 0; bj < 2; ++bj)
#pragma unroll
            for (int m = 0; m < 2; ++m)
#pragma unroll
                for (int n = 0; n < 2; ++n) acc[bj][m][n] = (f32x4){0.f, 0.f, 0.f, 0.f};
        int k = 0;
        for (; k + 128 <= Kw; k += 128) skinny_steps<4>(Ab, Bb, kw0 + k, g.kstepA, g.kstepB, a16, b4, b128, acc);
        for (; k + 64 <= Kw; k += 64) skinny_steps<2>(Ab, Bb, kw0 + k, g.kstepA, g.kstepB, a16, b4, b128, acc);
        for (; k < Kw; k += 32) skinny_steps<1>(Ab, Bb, kw0 + k, g.kstepA, g.kstepB, a16, b4, b128, acc);
#pragma unroll
        for (int bj = 0; bj < 2; ++bj)
#pragma unroll
            for (int m = 0; m < 2; ++m)
#pragma unroll
                for (int n = 0; n < 2; ++n) R[(wid * 8 + bj * 4 + m * 2 + n) * 64 + lane] = acc[bj][m][n];
        __syncthreads();
        if (wid == 0) {
            f32x4 accF[2][2][4][2];
#pragma unroll
            for (int ai = 0; ai < 2; ++ai)
#pragma unroll
                for (int bj = 0; bj < 2; ++bj)
#pragma unroll
                    for (int m = 0; m < 4; ++m)
#pragma unroll
                        for (int n = 0; n < 2; ++n) accF[ai][bj][m][n] = (f32x4){0.f, 0.f, 0.f, 0.f};
            f32x4 s8[8];
#pragma unroll
            for (int i = 0; i < 8; ++i) s8[i] = R[i * 64 + lane];
#pragma unroll 1
            for (int w = 1; w < 8; ++w) {
#pragma unroll
                for (int i = 0; i < 8; ++i) s8[i] += R[(w * 8 + i) * 64 + lane];
            }
#pragma unroll
            for (int bj = 0; bj < 2; ++bj)
#pragma unroll
                for (int m = 0; m < 2; ++m)
#pragma unroll
                    for (int n = 0; n < 2; ++n) accF[0][bj][m][n] = s8[bj * 4 + m * 2 + n];
            const Unit u{MP / BM, pn};
            E.template run<true>(accF, u, 0, wc, fr, fq);
        }
        __syncthreads();
    }
}

template <int NS>
__device__ __forceinline__ void narrow_steps(const char* Ab, const char* Bb, int k0, size_t kstepA, size_t kstepB, size_t a16, f32x4 (&acc)[2]) {
    bf16x8 a[NS][2], b[NS];
#pragma unroll
    for (int s = 0; s < NS; ++s) {
        const size_t ka = skinny_koff(k0 + 32 * s, kstepA), kb = skinny_koff(k0 + 32 * s, kstepB);
        a[s][0] = *(const bf16x8*)(Ab + ka); a[s][1] = *(const bf16x8*)(Ab + a16 + ka); b[s] = *(const bf16x8*)(Bb + kb);
    }
#pragma unroll
    for (int s = 0; s < NS; ++s)
#pragma unroll
        for (int m = 0; m < 2; ++m) acc[m] = __builtin_amdgcn_mfma_f32_16x16x32_bf16(b[s], a[s][m], acc[m], 0, 0, 0);
}
template <class Epi>
__device__ __forceinline__ void skinny_phase_narrow(PG8_LAS unsigned char* lds, const Gemm g, const Epi& E, int first, int step, const int wv) {
    int tid = wv * 64 + (int)__builtin_amdgcn_mbcnt_hi(~0u, __builtin_amdgcn_mbcnt_lo(~0u, 0u)); asm volatile("" : "+v"(tid));
    const int wid = wv, lane = tid & 63, fr = lane & 15, fq = lane >> 4;
    const int nit = (g.N / BM) * 16, Kw = g.K / 8;
    PG8_LAS f32x4* R = (PG8_LAS f32x4*)lds;
    for (int it = first; it < nit; it += step) {
        const int pn = it >> 4, wc = (it >> 2) & 3, bj = (it >> 1) & 1, n = it & 1;
        const int kw0 = wid * Kw;
        const char* Ab = (const char*)g.A + (size_t)(pn >> g.gshift) * g.gstride + ((size_t)(MP + fr) * g.lda + fq * 8) * 2;
        const char* Bb = (const char*)g.Bt + ((size_t)(pn * BM + bj * HALF + 32 * wc + 8 * (fr >> 2) + 4 * n + (fr & 3)) * g.ldb + fq * 8) * 2;
        const size_t a16 = (size_t)16 * g.lda * 2;
        f32x4 acc[2] = {(f32x4){0.f, 0.f, 0.f, 0.f}, (f32x4){0.f, 0.f, 0.f, 0.f}};
        int k = 0;
        for (; k + 256 <= Kw; k += 256) narrow_steps<8>(Ab, Bb, kw0 + k, g.kstepA, g.kstepB, a16, acc);
        for (; k + 128 <= Kw; k += 128) narrow_steps<4>(Ab, Bb, kw0 + k, g.kstepA, g.kstepB, a16, acc);
        for (; k + 64 <= Kw; k += 64) narrow_steps<2>(Ab, Bb, kw0 + k, g.kstepA, g.kstepB, a16, acc);
        for (; k < Kw; k += 32) narrow_steps<1>(Ab, Bb, kw0 + k, g.kstepA, g.kstepB, a16, acc);
        R[(wid * 2 + 0) * 64 + lane] = acc[0]; R[(wid * 2 + 1) * 64 + lane] = acc[1];
        __syncthreads();
        if (wid == 0) {
            f32x4 v[2] = {R[lane], R[64 + lane]};
#pragma unroll
            for (int w = 1; w < 8; ++w) { v[0] += R[(w * 2 + 0) * 64 + lane]; v[1] += R[(w * 2 + 1) * 64 + lane]; }
            E.run_narrow(v, pn, wc, bj, n, fr, fq);
        }
        __syncthreads();
    }
}
}
#define GAS __attribute__((address_space(1)))
#define LAS __attribute__((address_space(3)))
typedef unsigned short bf16;
typedef unsigned v4u __attribute__((ext_vector_type(4)));
typedef float f32x4 __attribute__((ext_vector_type(4)));
typedef short bf16x8 __attribute__((ext_vector_type(8)));
typedef GAS unsigned gu32;
typedef GAS unsigned long long gu64;
#define RLX_AGENT __ATOMIC_RELAXED, __HIP_MEMORY_SCOPE_AGENT
#define LDS_WAIT() asm volatile("s_waitcnt lgkmcnt(0)" ::: "memory")
#define VM_WAIT() asm volatile("s_waitcnt vmcnt(0)" ::: "memory")
__device__ __forceinline__ unsigned long long rt() { return __builtin_amdgcn_s_memrealtime(); }
__device__ __forceinline__ int lane_id() { return (int)__builtin_amdgcn_mbcnt_hi(~0u, __builtin_amdgcn_mbcnt_lo(~0u, 0u)); }
__device__ __forceinline__ unsigned f2bf(float f) { unsigned u = __builtin_bit_cast(unsigned, f); return (u + 0x7fffu + ((u >> 16) & 1u)) >> 16; }
__device__ __forceinline__ unsigned pk2(float lo, float hi) { return f2bf(lo) | (f2bf(hi) << 16); }

#define XB_TMO      128
#define XB_XCNT(j)  (256  + 64 * (j))
#define XB_XSUB(j)  (1280 + 64 * (j))
#define XB_XGEN(j)  (2304 + 64 * (j))
#define XB_TOP      3328
#define XB_TOPGEN   3392
#define XCD_BAR_WORDS 3456
#define XB_SPIN_CAP (1u << 18)

__device__ __forceinline__ unsigned xb_ld(unsigned* p)              { return __hip_atomic_load(p, __ATOMIC_RELAXED, __HIP_MEMORY_SCOPE_AGENT); }
__device__ __forceinline__ unsigned xb_add(unsigned* p, unsigned v) { return __hip_atomic_fetch_add(p, v, __ATOMIC_RELAXED, __HIP_MEMORY_SCOPE_AGENT); }
__device__ __forceinline__ unsigned xb_xcc_id() { return (unsigned)__builtin_amdgcn_s_getreg((3 << 11) | 20) & 0xFu; }
#define XB_SPIN(cond, bar) do { unsigned _sp = 0; while (cond) { __builtin_amdgcn_s_sleep(1); \
    if ((++_sp & 255u) == 0u) { if (xb_ld(&(bar)[XB_TMO])) break; if (_sp > XB_SPIN_CAP) { atomicAdd(&(bar)[XB_TMO], 1u); break; } } } } while (0)

struct XcdBarrier {
    unsigned* bar; unsigned x; int wv;
    volatile LAS unsigned* st;
};

__device__ __forceinline__ XcdBarrier xcd_barrier_post(unsigned* bar, volatile LAS unsigned* st, int wv) {
    XcdBarrier b; b.bar = bar; b.x = xb_xcc_id(); b.st = st; b.wv = wv;
    if (wv == 0 && lane_id() == 0) (void)xb_add(&bar[XB_XCNT(b.x)], 1u);
    return b;
}
__device__ __forceinline__ void xcd_barrier_complete(unsigned* bar, unsigned x, unsigned& nloc, unsigned& nx) {
    const unsigned G = gridDim.x * gridDim.y * gridDim.z;
    unsigned sum, cnt, mine, sp = 0u;
    for (;;) {
        sum = 0u; cnt = 0u; mine = 0u;
#pragma unroll
        for (unsigned j = 0; j < 16; ++j) { const unsigned c = xb_ld(&bar[XB_XCNT(j)]); sum += c; cnt += (c > 0u) ? 1u : 0u; mine = (j == x) ? c : mine; }
        if (sum == G) break;
        __builtin_amdgcn_s_sleep(1);
        if ((++sp & 255u) == 0u) { if (xb_ld(&bar[XB_TMO])) break; if (sp > XB_SPIN_CAP) { atomicAdd(&bar[XB_TMO], 1u); break; } }
    }
    nloc = mine > 0u ? mine : 1u; nx = cnt > 0u ? cnt : 1u;
}

__device__ __forceinline__ void xcd_barrier(const XcdBarrier& b) {
    asm volatile("s_waitcnt vmcnt(0)" ::: "memory");
    __syncthreads();
    if (b.wv == 0 && lane_id() == 0) {
        unsigned* bar = b.bar;
        __builtin_amdgcn_s_waitcnt(0);
        unsigned nloc = b.st[0], nx = b.st[1];
        if (nloc == 0u) { xcd_barrier_complete(bar, b.x, nloc, nx); b.st[0] = nloc; b.st[1] = nx; }
        const unsigned old = xb_add(&bar[XB_XSUB(b.x)], 1u);
        const unsigned gen = old / nloc;
        if (old + 1u == (gen + 1u) * nloc) {
            __builtin_amdgcn_fence(__ATOMIC_RELEASE, "agent");
            asm volatile("s_waitcnt vmcnt(0)" ::: "memory");
            const unsigned og = xb_add(&bar[XB_TOP], 1u);
            const unsigned tg = og / nx;
            if (og + 1u == (tg + 1u) * nx) xb_add(&bar[XB_TOPGEN], 1u);
            else XB_SPIN(xb_ld(&bar[XB_TOPGEN]) == tg, bar);
            __builtin_amdgcn_fence(__ATOMIC_ACQUIRE, "agent");
            xb_add(&bar[XB_XGEN(b.x)], 1u);
            asm volatile("s_waitcnt vmcnt(0)" ::: "memory");
        } else {
            XB_SPIN(xb_ld(&bar[XB_XGEN(b.x)]) == gen, bar);
            __builtin_amdgcn_fence(__ATOMIC_ACQUIRE, "agent");
            asm volatile("s_waitcnt vmcnt(0)" ::: "memory");
        }
    }
    __syncthreads();
}
constexpr size_t MiB = 1u << 20;
constexpr size_t WS_CTL = 0, CTL_ZERO_BYTES = 2 * MiB;
constexpr int CW_TMO = 0, CW_CODE = 1, CW_BAR = 1024;
constexpr size_t CTL_SS = 128 * 1024;
constexpr size_t CTL_KMP = 512 * 1024;
constexpr size_t CTL_SMP = 768 * 1024;
constexpr size_t CTL_CONVQ = 960 * 1024;
constexpr size_t CTL_FIN = 896 * 1024;
constexpr size_t WS_COS = 2 * MiB, WS_SIN = 4 * MiB;
constexpr size_t WS_WIN = 6 * MiB;
constexpr size_t WS_WO = WS_WIN + (size_t)INW * DM * 2;
constexpr size_t WS_WGU = WS_WO + (size_t)DM * DM * 2;
constexpr size_t WS_WDN = WS_WGU + (size_t)2 * 2 * FF * DM * 2;
constexpr size_t WS_WPL = WS_WDN + (size_t)2 * DM * FF * 2;
constexpr size_t WS_XB = WS_WPL + (size_t)DM * 512 * 2;
constexpr size_t WS_X = WS_XB + (size_t)MPAD * DM * 2;
constexpr size_t WS_Q = WS_X + (size_t)MPAD * DM * 4;
constexpr size_t WS_K = WS_Q + (size_t)MPAD * 1024 * 2, WS_V = WS_K + (size_t)MPAD * 1024 * 2, WS_G = WS_V + (size_t)MPAD * 1024 * 2, WS_U = WS_G + (size_t)MPAD * 1024 * 2;
constexpr size_t WS_ATT = WS_U + (size_t)MPAD * 1024 * 2;
constexpr size_t WS_H = WS_ATT + (size_t)MPAD * DM * 2;
constexpr size_t WS_D = WS_H + (size_t)MPAD * FF * 2;
constexpr size_t WS_KMS = WS_D + (size_t)MPAD * DM * 2;
constexpr size_t WS_END = WS_KMS + (size_t)DB * 64 * 1024 * 4;
static_assert(CTL_SS + 5 * MPAD * 8 <= CTL_KMP && CTL_KMP + 32 * 1024 * 4 <= CTL_SMP && (CW_BAR + 3 * 3456) * 4 <= (int)CTL_SS, "control region map");

constexpr int NWAVES = 8;
constexpr int RING_OFF = 0, RING_BYTES = 131072;
constexpr int LDSCTL_OFF = RING_BYTES, MISC_OFF = LDSCTL_OFF + 320;
constexpr int LDS_BYTES = 147456;
static_assert(MISC_OFF + 128 <= LDS_BYTES, "LDS map");
__device__ __forceinline__ float bf2f(unsigned short h) { return __uint_as_float(((unsigned)h) << 16); }
__device__ __forceinline__ float wave_sum(float v) {
#pragma unroll
    for (int o = 1; o < 64; o <<= 1) v += __shfl_xor(v, o);
    return v;
}
struct Args {
    const float* in[18]; float* out; unsigned char* ws;
    int ph_lo, ph_hi, li, pad;
};

__device__ __forceinline__ int inproj_src_col(int r) {
    const int pn = r >> 8, bj = (r >> 7) & 1, jj = r & 127;
    if (pn < 8) return (pn >> 2) * 1024 + (2 * (pn & 3) + (jj >> 6)) * 128 + 64 * bj + (jj & 63);
    if (pn < 16) return r;
    return 4096 + 1024 * bj + 128 * (pn - 16) + jj;
}
__device__ __forceinline__ int resid_src_col(int r) { const int rho = r & 255; return (r & ~255) + 64 * ((rho >> 5) & 3) + 32 * (rho >> 7) + (rho & 31); }
struct TItem { const float* W; const float* gain; const float* cscale; bf16* WT; int ldw, scol4, ldk, drow0, k0, kblk; };
__device__ __forceinline__ void titem_load(const TItem& t, int lane, f32x4 (&v)[8], float (&g)[8]) {
    const int kr = lane >> 3;
#pragma unroll
    for (int i = 0; i < 8; ++i) v[i] = __builtin_nontemporal_load((const GAS f32x4*)(t.W + (size_t)(t.k0 + 8 * i + kr) * t.ldw + t.scol4));
#pragma unroll
    for (int i = 0; i < 8; ++i) g[i] = t.gain ? t.gain[t.k0 + 8 * i + kr] : 1.0f;
}
__device__ __forceinline__ void titem_store(const TItem& t, int lane, const f32x4 (&v)[8], const float (&g)[8], LAS float* scr) {
    const int kr = lane >> 3, n4 = lane & 7;
#pragma unroll
    for (int i = 0; i < 8; ++i) { LAS float* d = scr + (8 * i + kr) * 33 + 4 * n4; d[0] = v[i].x * g[i]; d[1] = v[i].y * g[i]; d[2] = v[i].z * g[i]; d[3] = v[i].w * g[i]; }
    LDS_WAIT(); asm volatile("" ::: "memory");
    const int c = lane & 7;
#pragma unroll
    for (int j = 0; j < 4; ++j) { const int n = (lane >> 3) + 8 * j; const LAS float* s = scr + (8 * c) * 33 + n; const float cs = t.cscale ? t.cscale[resid_src_col(t.drow0 + n)] : 1.0f;
        v4u o; o.x = pk2(s[0 * 33] * cs, s[1 * 33] * cs); o.y = pk2(s[2 * 33] * cs, s[3 * 33] * cs); o.z = pk2(s[4 * 33] * cs, s[5 * 33] * cs); o.w = pk2(s[6 * 33] * cs, s[7 * 33] * cs);
        bf16* d = t.kblk ? t.WT + ((size_t)(t.k0 >> 6) * t.kblk + t.drow0 + n) * 64 + 8 * c : t.WT + (size_t)(t.drow0 + n) * t.ldk + t.k0 + 8 * c;
        *(GAS v4u*)d = o; }
    LDS_WAIT(); asm volatile("" ::: "memory");
}

__device__ __forceinline__ TItem titem_decode(const Args& a, int set, int it, int lane) {
    unsigned char* ws = a.ws;
    constexpr int I_IN = (DM / 64) * (INW / 32), I_O = (DM / 64) * (DM / 32), I_GU = (DM / 64) * (2 * FF / 32), I_DN = (FF / 64) * (DM / 32);
    TItem t; int r = it; const int l = set == 0 ? 0 : 1; const int l4 = 4 * (lane & 7);
    if (set == 0) {
        if (r < I_IN) { const int nb = r % (INW / 32), kb = r / (INW / 32);
            t.W = a.in[10]; t.gain = a.in[7]; t.cscale = nullptr; t.WT = (bf16*)(ws + WS_WIN); t.ldw = INW; t.scol4 = inproj_src_col(nb * 32 + l4); t.ldk = DM; t.drow0 = nb * 32; t.k0 = kb * 64; t.kblk = 0; return t; }
        r -= I_IN;
        if (r < I_O) { const int nb = r % (DM / 32), kb = r / (DM / 32);
            t.W = a.in[12]; t.gain = nullptr; t.cscale = nullptr; t.WT = (bf16*)(ws + WS_WO); t.ldw = DM; t.scol4 = resid_src_col(nb * 32 + l4); t.ldk = DM; t.drow0 = nb * 32; t.k0 = kb * 64; t.kblk = 0; return t; }
        r -= I_O;
    }
    if (set == 2) r += I_GU;
    if (r < I_GU) { const int nb = r % (2 * FF / 32), kb = r / (2 * FF / 32);
        const int drow = nb * 32, pn = drow >> 8, bj = (drow >> 7) & 1, jj = drow & 127;
        t.W = (bj ? a.in[16] : a.in[15]) + (size_t)l * DM * FF; t.gain = a.in[8] + l * DM; t.cscale = nullptr; t.WT = (bf16*)(ws + WS_WGU) + (size_t)l * 2 * FF * DM;
        t.ldw = FF; t.scol4 = pn * 128 + jj + l4; t.ldk = DM; t.drow0 = drow; t.k0 = kb * 64; t.kblk = 0; return t; }
    r -= I_GU;
    if (r < I_DN) { const int nb = r % (DM / 32), kb = r / (DM / 32);
        t.W = a.in[17] + (size_t)l * FF * DM; t.gain = nullptr; t.cscale = nullptr; t.WT = (bf16*)(ws + WS_WDN) + (size_t)l * DM * FF; t.ldw = DM; t.scol4 = resid_src_col(nb * 32 + l4); t.ldk = FF; t.drow0 = nb * 32; t.k0 = kb * 64; t.kblk = DM; return t; }
    r -= I_DN;
    { const int g = r / 128; r -= g * 128; const int nb = r % 16, kb = r / 16;
        t.W = a.in[13] + (size_t)g * 512 * 512; t.gain = nullptr; t.cscale = a.in[14]; t.WT = (bf16*)(ws + WS_WPL); t.ldw = 512; t.scol4 = resid_src_col(g * 512 + nb * 32 + l4) - g * 512; t.ldk = 512; t.drow0 = g * 512 + nb * 32; t.k0 = kb * 64; t.kblk = 0; return t; }
}
__device__ __forceinline__ void convert_weights(const Args& a, LAS float* scr, int set, int gw, int NGW, int lane, int lo = 0, int hi = 1 << 30) {
    constexpr int I_IN = (DM / 64) * (INW / 32), I_O = (DM / 64) * (DM / 32), I_GU = (DM / 64) * (2 * FF / 32), I_DN = (FF / 64) * (DM / 32), I_PL = 4 * (512 / 64) * (512 / 32);
    int nitems = set == 0 ? I_IN + I_O + I_GU + I_DN + I_PL : (set == 1 ? I_GU : I_DN); if (hi < nitems) nitems = hi;
    for (int base = lo + gw; base < nitems; base += 4 * NGW) {
        TItem t[4]; f32x4 v[4][8]; float g[4][8];
#pragma unroll
        for (int j = 0; j < 4; ++j) { const int it = base + j * NGW; if (it < nitems) { t[j] = titem_decode(a, set, it, lane); titem_load(t[j], lane, v[j], g[j]); } }
#pragma unroll
        for (int j = 0; j < 4; ++j) { const int it = base + j * NGW; if (it < nitems) titem_store(t[j], lane, v[j], g[j], scr); }
    }
}
__device__ __forceinline__ void convert_weights_queue(const Args& a, LAS float* scr, int set, unsigned* ctr, int lane) {
    constexpr int I_GU = (DM / 64) * (2 * FF / 32), I_DN = (FF / 64) * (DM / 32);
    const int nitems = set == 1 ? I_GU : I_DN;
    for (;;) {
        unsigned b0 = 0; if (lane == 0) b0 = __hip_atomic_fetch_add(ctr, 4u, RLX_AGENT);
        const int base = (int)__builtin_amdgcn_readfirstlane(b0);
        if (base >= nitems) break;
        TItem t[4]; f32x4 v[4][8]; float g[4][8];
#pragma unroll
        for (int j = 0; j < 4; ++j) { const int it = base + j; if (it < nitems) { t[j] = titem_decode(a, set, it, lane); titem_load(t[j], lane, v[j], g[j]); } }
#pragma unroll
        for (int j = 0; j < 4; ++j) { const int it = base + j; if (it < nitems) titem_store(t[j], lane, v[j], g[j], scr); }
    }
}
__device__ __forceinline__ void p0_prologue(const Args& a, LAS unsigned char* lds, int vcu, int G, int wave, int lane) {
    unsigned char* ws = a.ws;
    LAS float* scr = (LAS float*)(lds + RING_OFF + wave * 16384);
    const int gw = vcu * NWAVES + wave, NGW = G * NWAVES;
    convert_weights(a, scr, 0, gw, NGW, lane);
    if (!CONV_IN_SLOTS) { convert_weights(a, scr, 1, gw, NGW, lane); convert_weights(a, scr, 2, gw, NGW, lane); }
    else convert_weights(a, scr, 1, gw, NGW, lane, 0, GU1_IN_P0);
    bf16* XB = (bf16*)(ws + WS_XB); unsigned long long* SS0 = (unsigned long long*)(ws + CTL_SS);
    {
        constexpr int NRW = (MV + 2047) / 2048 + 1;
        for (int m0 = gw; m0 < MV; m0 += NRW * NGW) {
            f32x4 v[NRW][8];
#pragma unroll
            for (int r = 0; r < NRW; ++r) { const int m = m0 + r * NGW;
                if (m < MV) { const float* xrow = m < MP ? a.in[0] + (size_t)m * DM : a.in[1] + (size_t)(m - MP) * DM;
                    const GAS f32x4* xr = (const GAS f32x4*)xrow + lane;
#pragma unroll
                    for (int j = 0; j < 8; ++j) v[r][j] = __builtin_nontemporal_load(xr + 64 * j); } }
#pragma unroll
            for (int r = 0; r < NRW; ++r) { const int m = m0 + r * NGW;
                if (m < MV) { float s = 0.f;
#pragma unroll
                    for (int j = 0; j < 8; ++j) s += (v[r][j].x * v[r][j].x + v[r][j].y * v[r][j].y) + (v[r][j].z * v[r][j].z + v[r][j].w * v[r][j].w);
                    s = wave_sum(s);
                    GAS unsigned long long* o8 = (GAS unsigned long long*)(XB + (size_t)m * DM) + lane;
#pragma unroll
                    for (int j = 0; j < 8; ++j) o8[64 * j] = (unsigned long long)pk2(v[r][j].x, v[r][j].y) | ((unsigned long long)pk2(v[r][j].z, v[r][j].w) << 32);
                    if (lane == 0) SS0[m] = (unsigned long long)(s * SS_SCALE + 0.5f); } }
        }
    }
    float* cosT = (float*)(ws + WS_COS); float* sinT = (float*)(ws + WS_SIN);
    for (int i = gw * 64 + lane; i < (SEQ + DS) * 64; i += NGW * 64) {
        const int p = i >> 6, ii = i & 63; const int pos = p < SEQ ? p : PAST + (p - SEQ);
        const float inv = powf(10000.f, -(float)ii / 64.f); const float ang = (float)pos * inv;
        cosT[i] = cosf(ang); sinT[i] = sinf(ang);
    }
}

__device__ __forceinline__ void unpack8(const v4u w, float (&f)[8]) {
#pragma unroll
    for (int e = 0; e < 4; ++e) { f[2 * e] = __uint_as_float(w[e] << 16); f[2 * e + 1] = __uint_as_float(w[e] & 0xffff0000u); }
}
__device__ __forceinline__ void conv_pass(const Args& a, int vcu, int G, int tid) {
    unsigned char* ws = a.ws;
    const bf16* Ub = (const bf16*)(ws + WS_U); const bf16* Gb = (const bf16*)(ws + WS_G); bf16* ATT = (bf16*)(ws + WS_ATT);
    const float* conv_w = a.in[11]; const float* state_conv = a.in[5];
    const int nthr = G * NWAVES * 64;
    for (int it = vcu * NWAVES * 64 + tid; it < (MV / 4) * 128; it += nthr) {
        const int r0 = (it >> 7) * 4, ch = (it & 127) * 8;
        const bool smp = r0 >= MP;
        const int t0 = smp ? 0 : r0 & (SEQ - 1), b = smp ? (r0 - MP) >> 2 : r0 >> 12;
        v4u up[6], gp[4];
#pragma unroll
        for (int j = 0; j < 4; ++j) { up[j + 2] = *(const GAS v4u*)(Ub + (size_t)(r0 + j) * 1024 + ch); gp[j] = *(const GAS v4u*)(Gb + (size_t)(r0 + j) * 1024 + ch); }
        float u[6][8];
        if (t0 >= 2) { up[0] = *(const GAS v4u*)(Ub + (size_t)(r0 - 2) * 1024 + ch); up[1] = *(const GAS v4u*)(Ub + (size_t)(r0 - 1) * 1024 + ch); unpack8(up[0], u[0]); unpack8(up[1], u[1]); }
        else if (smp) { const float* s0 = state_conv + ((size_t)b * 2) * CC + ch;
#pragma unroll
            for (int e = 0; e < 8; ++e) { u[0][e] = s0[e]; u[1][e] = s0[CC + e]; } }
        else {
#pragma unroll
            for (int e = 0; e < 8; ++e) { u[0][e] = 0.f; u[1][e] = 0.f; } }
#pragma unroll
        for (int j = 2; j < 6; ++j) unpack8(up[j], u[j]);
        float w0[8], w1[8], w2[8];
#pragma unroll
        for (int e = 0; e < 8; ++e) { w0[e] = conv_w[ch + e]; w1[e] = conv_w[CC + ch + e]; w2[e] = conv_w[2 * CC + ch + e]; }
#pragma unroll
        for (int j = 0; j < 4; ++j) {
            float gb[8], y[8]; unpack8(gp[j], gb);
#pragma unroll
            for (int e = 0; e < 8; ++e) y[e] = gb[e] * (w0[e] * u[j][e] + w1[e] * u[j + 1][e] + w2[e] * u[j + 2][e]);
            v4u o; o.x = pk2(y[0], y[1]); o.y = pk2(y[2], y[3]); o.z = pk2(y[4], y[5]); o.w = pk2(y[6], y[7]);
            *(GAS v4u*)(ATT + (size_t)(r0 + j) * DM + 1024 + ch) = o;
        }
    }
}

__device__ __forceinline__ f32x4 pool_h(const bf16* XBp, const unsigned long long* ss, int row, int c, const f32x4 g) {
    const float rstd = rsqrtf((float)ss[row] * (1.0f / (SS_SCALE * (float)DM)) + RMS_EPS);
    const unsigned long long w = *(const GAS unsigned long long*)(XBp + (size_t)row * DM + c);
    const f32x4 x = (f32x4){__uint_as_float((unsigned)w << 16), __uint_as_float((unsigned)w & 0xffff0000u), __uint_as_float((unsigned)(w >> 32) << 16), __uint_as_float((unsigned)(w >> 32) & 0xffff0000u)};
    return x * rstd * g;
}
__device__ __forceinline__ f32x4 pool_unpack(unsigned long long w) {
    return (f32x4){__uint_as_float((unsigned)w << 16), __uint_as_float((unsigned)w & 0xffff0000u), __uint_as_float((unsigned)(w >> 32) << 16), __uint_as_float((unsigned)(w >> 32) & 0xffff0000u)};
}
template <int W, int NRW>
__device__ __forceinline__ void pool_rows(const bf16* XBp, const unsigned long long* ss, bf16* Dd, float* o_pp, int r0, int t0, int bb, int c, const f32x4 g) {
    constexpr int NR = W - 1 + NRW;
    unsigned long long raw[NR]; float rs[NR];
#pragma unroll
    for (int i = 0; i < NR; ++i) { const int dr = i - (W - 1); const bool ok = t0 + dr >= 0;
        raw[i] = ok ? *(const GAS unsigned long long*)(XBp + (size_t)(r0 + dr) * DM + c) : 0ull;
        rs[i] = ok ? rsqrtf((float)ss[r0 + dr] * (1.0f / (SS_SCALE * (float)DM)) + RMS_EPS) : 0.f; }
    f32x4 S = (f32x4){0.f, 0.f, 0.f, 0.f};
#pragma unroll
    for (int i = 0; i < W - 1; ++i) S += pool_unpack(raw[i]) * rs[i] * g;
#pragma unroll
    for (int j = 0; j < NRW; ++j) {
        const int t = t0 + j; const f32x4 hv = pool_unpack(raw[W - 1 + j]) * rs[W - 1 + j] * g;
        S += hv;
        const float cnt = (float)((t + 1) < W ? (t + 1) : W);
        const f32x4 d = S * (1.0f / cnt) - hv;
        *(GAS unsigned long long*)(Dd + (size_t)(r0 + j) * DM + c) = (unsigned long long)pk2(d.x, d.y) | ((unsigned long long)pk2(d.z, d.w) << 32);
        S -= pool_unpack(raw[j]) * rs[j] * g;
        if (t >= SEQ - 15) *(GAS f32x4*)(o_pp + ((size_t)bb * 15 + (t - (SEQ - 15))) * DM + c) = hv;
    }
}
template <int W>
__device__ __forceinline__ void pool_sample(const bf16* XBp, const unsigned long long* ss, bf16* Dd, const float* hist, float* o_ps, int b, int c, const f32x4 g) {
    const int r0 = MP + b * DS;
    f32x4 hs[15]; unsigned long long raw[DS]; float rs[DS];
#pragma unroll
    for (int j = 0; j < 15; ++j) hs[j] = *(const f32x4*)(hist + (size_t)j * DM);
#pragma unroll
    for (int t = 0; t < DS; ++t) { raw[t] = *(const GAS unsigned long long*)(XBp + (size_t)(r0 + t) * DM + c); rs[t] = rsqrtf((float)ss[r0 + t] * (1.0f / (SS_SCALE * (float)DM)) + RMS_EPS); }
    f32x4 h[DS];
#pragma unroll
    for (int t = 0; t < DS; ++t) h[t] = pool_unpack(raw[t]) * rs[t] * g;
    f32x4 S = (f32x4){0.f, 0.f, 0.f, 0.f};
#pragma unroll
    for (int j = 1; j <= W - 1; ++j) S += hs[15 - j];
#pragma unroll
    for (int t = 0; t < DS; ++t) {
        S += h[t];
        const f32x4 d = S * (1.0f / (float)W) - h[t];
        *(GAS unsigned long long*)(Dd + (size_t)(r0 + t) * DM + c) = (unsigned long long)pk2(d.x, d.y) | ((unsigned long long)pk2(d.z, d.w) << 32);
        const int to = t - (W - 1);
        if (to >= 0) S -= h[to >= 0 ? to : 0]; else S -= hs[15 + to >= 0 ? 15 + to : 0];
        *(GAS f32x4*)(o_ps + ((size_t)b * 15 + 11 + t) * DM + c) = h[t];
    }
#pragma unroll
    for (int j = 0; j < 11; ++j) *(GAS f32x4*)(o_ps + ((size_t)b * 15 + j) * DM + c) = hs[j + 4];
}
__device__ __forceinline__ void pool_pass(const Args& a, int vcu, int G, int tid) {
    unsigned char* ws = a.ws;
    const bf16* X = (const bf16*)(ws + WS_XB); const unsigned long long* ss = (const unsigned long long*)(ws + CTL_SS) + 2 * MPAD;
    bf16* Dd = (bf16*)(ws + WS_D);
    const float* state_pool = a.in[6]; const float* gmix = a.in[7] + DM;
    float* o_pp = a.out + (size_t)MV * DM + 2 * (size_t)MP * 1024 + 2 * (size_t)MS * 1024 + (size_t)NB * 2 * CC + (size_t)DB * 2 * CC;
    float* o_ps = o_pp + (size_t)NB * 15 * DM;
    const int c = tid * 4, grp = __builtin_amdgcn_readfirstlane(c >> 9);
    const f32x4 g = *(const f32x4*)(gmix + c);
    if (vcu >= G - DB) { const int b = vcu - (G - DB); const float* hist = state_pool + (size_t)b * 15 * DM + c;
        if (grp == 0) pool_sample<2>(X, ss, Dd, hist, o_ps, b, c, g); else if (grp == 1) pool_sample<4>(X, ss, Dd, hist, o_ps, b, c, g);
        else if (grp == 2) pool_sample<8>(X, ss, Dd, hist, o_ps, b, c, g); else pool_sample<16>(X, ss, Dd, hist, o_ps, b, c, g); }
    for (int it = vcu; it < MP / 32; it += G) {
        const int r0 = it * 32, t0 = r0 & (SEQ - 1), bb = r0 >> 12;
#pragma unroll 1
        for (int q = 0; q < 2; ++q) {
            if (grp == 0) pool_rows<2, 16>(X, ss, Dd, o_pp, r0 + 16 * q, t0 + 16 * q, bb, c, g);
            else if (grp == 1) pool_rows<4, 16>(X, ss, Dd, o_pp, r0 + 16 * q, t0 + 16 * q, bb, c, g);
            else if (grp == 2) pool_rows<8, 16>(X, ss, Dd, o_pp, r0 + 16 * q, t0 + 16 * q, bb, c, g);
            else pool_rows<16, 16>(X, ss, Dd, o_pp, r0 + 16 * q, t0 + 16 * q, bb, c, g);
        }
    }
}

__device__ __forceinline__ void final_norm(const Args& a, int vcu, int G, int wave, int lane) {
    unsigned char* ws = a.ws;
    const bf16* X = (const bf16*)(ws + WS_XB); const unsigned long long* ss = (const unsigned long long*)(ws + CTL_SS) + 4 * MPAD;
    const float* gf = a.in[9];
    const int gw = vcu * NWAVES + wave, NGW = G * NWAVES;
    f32x4 g[8];
#pragma unroll
    for (int j = 0; j < 8; ++j) g[j] = *(const f32x4*)(gf + 4 * (lane + 64 * j));
    for (int m = gw; m < MV; m += NGW) {
        const float rstd = rsqrtf((float)ss[m] * (1.0f / (SS_SCALE * (float)DM)) + RMS_EPS);
        const GAS unsigned long long* xr = (const GAS unsigned long long*)(X + (size_t)m * DM) + lane;
        GAS f32x4* yr = (GAS f32x4*)(a.out + (size_t)m * DM) + lane;
        unsigned long long w[8];
#pragma unroll
        for (int j = 0; j < 8; ++j) w[j] = xr[64 * j];
#pragma unroll
        for (int j = 0; j < 8; ++j) { const f32x4 x = (f32x4){__uint_as_float((unsigned)w[j] << 16), __uint_as_float((unsigned)w[j] & 0xffff0000u), __uint_as_float((unsigned)(w[j] >> 32) << 16), __uint_as_float((unsigned)(w[j] >> 32) & 0xffff0000u)};
            yr[64 * j] = x * rstd * g[j]; }
    }
}

namespace mb {
constexpr int D = 128, QPITCH = 1024, KPITCH = 1024, OPITCH = 2048;
constexpr float THR = 8.f;
constexpr bool WSKIP = false;
constexpr float SCALE = 0.08838834764831845f;
constexpr int NW = 8, QBLK = 32, KVBLK = 64, QB = NW * QBLK;
constexpr int SHM_V = KVBLK * D * 2, SHM_K = KVBLK * D * 2;
constexpr int ATT_LDS_BYTES = 2 * SHM_V + 2 * SHM_K + NW * 64 * 4;

using bf16 = __hip_bfloat16;
typedef short bf16x8 __attribute__((ext_vector_type(8)));
typedef short s16x4 __attribute__((ext_vector_type(4)));
typedef float f32x16 __attribute__((ext_vector_type(16)));
typedef float f32x4 __attribute__((ext_vector_type(4)));
typedef unsigned u32x4 __attribute__((ext_vector_type(4)));
template <class A, class Bt> struct same_t { static constexpr bool v = false; };
template <class A> struct same_t<A, A> { static constexpr bool v = true; };

#define KSWZ(row, colB) ((row) * 256 + ((colB) ^ (((row) & 7) << 4)))
#define SBAR() __builtin_amdgcn_sched_barrier(0)
__device__ __forceinline__ int v_st(int k, int c) { const int kk = (k & ~0xC) | ((k & 4) << 1) | ((k & 8) >> 1); return ((kk >> 3) * 4 + (c >> 5)) * 512 + ((kk & 7) * 32 + (c & 31)) * 2; }
__device__ __forceinline__ int v_rd_base(int lane) { return ((lane & 3) << 3) | (((lane >> 2) & 3) << 6) | (((lane >> 4) & 1) << 5) | (((lane >> 5) & 1) << 8); }
constexpr int v_rd_off(int d0, int ks, int half) { return d0 * 512 + ks * 4096 + half * 2048; }
__device__ __forceinline__ int crow(int r, int hi) { return (r & 3) + 8 * (r >> 2) + 4 * hi; }
__device__ __forceinline__ unsigned cvtpk(float lo, float hi) {
    unsigned r; asm volatile("v_cvt_pk_bf16_f32 %0, %1, %2" : "=v"(r) : "v"(lo), "v"(hi)); return r;
}
__device__ __forceinline__ bf16x8 pack8(f32x4 a, f32x4 b) {
    u32x4 w = {cvtpk(a[0], a[1]), cvtpk(a[2], a[3]), cvtpk(b[0], b[1]), cvtpk(b[2], b[3])};
    return *reinterpret_cast<bf16x8*>(&w);
}
template <class T> __device__ __forceinline__ bf16x8 load8(const T* p) {
    if constexpr (same_t<T, float>::v) { return pack8(*(const f32x4*)p, *(const f32x4*)(p + 4)); }
    else { return *reinterpret_cast<const bf16x8*>(p); }
}
__device__ __forceinline__ void mask_tile(f32x16& p0, f32x16& p1, int dq, unsigned W) {
    const float NEG = -__builtin_inff();
#pragma unroll
    for (int r = 0; r < 16; ++r) {
        const int c = (r & 3) + 8 * (r >> 2);
        if ((unsigned)(dq - c) >= W) p0[r] = NEG;
        if ((unsigned)(dq - c - 32) >= W) p1[r] = NEG;
    }
}
__device__ __forceinline__ void partialSM(f32x16& p0, f32x16& p1, float& m_reg, float& mn, float& alpha, const bool rowoff) {
    float pmax = p0[0]; for (int r = 1; r < 16; ++r) pmax = fmaxf(pmax, p0[r]); for (int r = 0; r < 16; ++r) pmax = fmaxf(pmax, p1[r]);
    { auto rr = __builtin_amdgcn_permlane32_swap(__float_as_uint(pmax), __float_as_uint(pmax), false, false);
      pmax = fmaxf(__uint_as_float(rr[0]), __uint_as_float(rr[1])); }
    if (rowoff) pmax = -__builtin_inff();
    constexpr float C2 = 1.4426950408889634f * SCALE;
    if (__builtin_expect(__all((pmax - m_reg) * SCALE <= THR), 1)) { mn = m_reg; alpha = 1.f; }
    else { mn = fmaxf(m_reg, pmax); alpha = __builtin_amdgcn_exp2f((m_reg - mn) * C2); m_reg = mn; }
    const float mnL = rowoff ? -__builtin_inff() : -mn * C2;
    for (int r = 0; r < 16; ++r) p0[r] = fmaf(p0[r], C2, mnL); for (int r = 0; r < 16; ++r) p1[r] = fmaf(p1[r], C2, mnL);
    for (int r = 0; r < 16; ++r) p0[r] = __builtin_amdgcn_exp2f(p0[r]);
}
__device__ __forceinline__ void finishSM(f32x16& p0, f32x16& p1, float alpha, float& l_reg, bf16x8& pa0, bf16x8& pa1, bf16x8& pa2, bf16x8& pa3) {
    for (int r = 0; r < 16; ++r) p1[r] = __builtin_amdgcn_exp2f(p1[r]);
    float ps = 0; for (int r = 0; r < 16; ++r) ps += p0[r]; for (int r = 0; r < 16; ++r) ps += p1[r];
    { auto rr = __builtin_amdgcn_permlane32_swap(__float_as_uint(ps), __float_as_uint(ps), false, false);
      ps = __uint_as_float(rr[0]) + __uint_as_float(rr[1]); }
    l_reg = l_reg * alpha + ps;
#define PK4(P, B_, OUT) do { unsigned a0 = cvtpk(P[B_+0], P[B_+1]), a1 = cvtpk(P[B_+2], P[B_+3]);                          \
        unsigned b0 = cvtpk(P[B_+4], P[B_+5]), b1 = cvtpk(P[B_+6], P[B_+7]);                                             \
        auto r0 = __builtin_amdgcn_permlane32_swap(a0, b0, false, false); auto r1 = __builtin_amdgcn_permlane32_swap(a1, b1, false, false); \
        u32x4 w = {r0[0], r1[0], r0[1], r1[1]}; OUT = *reinterpret_cast<bf16x8*>(&w); } while (0)
    PK4(p0, 0, pa0); PK4(p0, 8, pa1); PK4(p1, 0, pa2); PK4(p1, 8, pa3);
#undef PK4
}
template <int KB, bool SK>
__device__ __forceinline__ void qkt(f32x16& p0, f32x16& p1, const char* K_lds, int r32, int hi, const bf16x8* qr, bool act) {
    if (SK && !act) { const float NEG = -__builtin_inff();
#pragma unroll
        for (int r = 0; r < 16; ++r) { p0[r] = NEG; p1[r] = NEG; } return; }
    p0 = f32x16{}; p1 = f32x16{};
    const char* kb[4];
#pragma unroll
    for (int dd = 0; dd < 4; ++dd) kb[dd] = K_lds + KB * SHM_K + KSWZ(r32, (dd * 16 + hi * 8) * 2);
#pragma unroll
    for (int d0 = 0; d0 < 8; ++d0) { const char* a = kb[d0 & 3] + (d0 >> 2) * 128;
        bf16x8 b0 = *reinterpret_cast<const bf16x8*>(a);
        bf16x8 b1 = *reinterpret_cast<const bf16x8*>(a + 32 * 256);
        p0 = __builtin_amdgcn_mfma_f32_32x32x16_bf16(b0, qr[d0], p0, 0, 0, 0);
        p1 = __builtin_amdgcn_mfma_f32_32x32x16_bf16(b1, qr[d0], p1, 0, 0, 0); }
}
template <int VB, bool SK>
__device__ __forceinline__ void pv_tile(f32x16* o, int vb0, bf16x8 pa0, bf16x8 pa1, bf16x8 pa2, bf16x8 pa3, bool act) {
    if (SK && !act) return;
#define TRRD(dst, off) asm volatile("ds_read_b64_tr_b16 %0, %1 offset:%2" : "=&v"(dst) : "v"(vb0), "i"(off) : "memory")
#define PV_D0(d0) do { s16x4 l0, l1, l2, l3, h0, h1, h2, h3; constexpr int b_ = VB * SHM_V + v_rd_off(d0, 0, 0);     \
        TRRD(l0, b_); TRRD(h0, b_ + 2048); TRRD(l1, b_ + 4096); TRRD(h1, b_ + 6144); TRRD(l2, b_ + 8192); TRRD(h2, b_ + 10240); TRRD(l3, b_ + 12288); TRRD(h3, b_ + 14336); \
        asm volatile("s_waitcnt lgkmcnt(0)" ::: "memory"); SBAR();                 \
        o[d0] = __builtin_amdgcn_mfma_f32_32x32x16_bf16(pa0, (bf16x8){l0[0], l0[1], l0[2], l0[3], h0[0], h0[1], h0[2], h0[3]}, o[d0], 0, 0, 0);   \
        o[d0] = __builtin_amdgcn_mfma_f32_32x32x16_bf16(pa1, (bf16x8){l1[0], l1[1], l1[2], l1[3], h1[0], h1[1], h1[2], h1[3]}, o[d0], 0, 0, 0);   \
        o[d0] = __builtin_amdgcn_mfma_f32_32x32x16_bf16(pa2, (bf16x8){l2[0], l2[1], l2[2], l2[3], h2[0], h2[1], h2[2], h2[3]}, o[d0], 0, 0, 0);   \
        o[d0] = __builtin_amdgcn_mfma_f32_32x32x16_bf16(pa3, (bf16x8){l3[0], l3[1], l3[2], l3[3], h3[0], h3[1], h3[2], h3[3]}, o[d0], 0, 0, 0); } while (0)
    PV_D0(0); PV_D0(1); PV_D0(2); PV_D0(3);
#undef PV_D0
#undef TRRD
}

template <class TIn, class TOut> struct BlockRef { const TIn* Q; const TIn* K; const TIn* V; TOut* O; int P0; };
template <class TIn> struct Seam {
    bf16x8 qr[8];
    bf16x8 st_v0, st_v1, st_k0, st_k1; f32x4 sf0, sf1, sf2, sf3;
    f32x4 tq[16];
};
__device__ __forceinline__ int swa_jlo(int P0, int W) { const int lowk = P0 - W + 1; return lowk > 0 ? lowk / KVBLK : 0; }
#define ROW(p, k0, rr) ((p) + (size_t)((k0) + (rr)) * KPITCH + sc)
#define VMW() asm volatile("s_waitcnt vmcnt(0)" ::: "memory")
#define VMWN(n) asm volatile("s_waitcnt vmcnt(%0)" :: "i"(n) : "memory")
#define SLOAD_H(Kp, Vp, k0) do { S.st_v0 = load8<TIn>(ROW(Vp, k0, sr)); S.st_v1 = load8<TIn>(ROW(Vp, k0, 32 + sr));              \
                         S.st_k0 = load8<TIn>(ROW(Kp, k0, sr)); S.st_k1 = load8<TIn>(ROW(Kp, k0, 32 + sr)); } while (0)
#define SWRITE_HK(bf) do { *(bf16x8*)(K_lds + (bf) * SHM_K + kws) = S.st_k0; *(bf16x8*)(K_lds + (bf) * SHM_K + kws + 32 * 256) = S.st_k1; } while (0)
#define SWRITE_HV(bf) do { *(bf16x8*)(V_lds + (bf) * SHM_V + vst0) = S.st_v0; *(bf16x8*)(V_lds + (bf) * SHM_V + vst1) = S.st_v1; } while (0)
#define SWRITE_H(bf) do { SWRITE_HV(bf); SWRITE_HK(bf); } while (0)
#define SLOAD_F(p, k0) do { S.sf0 = *(const f32x4*)ROW(p, k0, sr); S.sf1 = *(const f32x4*)(ROW(p, k0, sr) + 4);                \
                            S.sf2 = *(const f32x4*)ROW(p, k0, 32 + sr); S.sf3 = *(const f32x4*)(ROW(p, k0, 32 + sr) + 4); } while (0)
#define SWRITE_KF(bf) do { *(bf16x8*)(K_lds + (bf) * SHM_K + kws) = pack8(S.sf0, S.sf1); *(bf16x8*)(K_lds + (bf) * SHM_K + kws + 32 * 256) = pack8(S.sf2, S.sf3); } while (0)
#define SWRITE_VF(bf) do { *(bf16x8*)(V_lds + (bf) * SHM_V + vst0) = pack8(S.sf0, S.sf1); *(bf16x8*)(V_lds + (bf) * SHM_V + vst1) = pack8(S.sf2, S.sf3); } while (0)
template <class TIn, class TOut>
__device__ __forceinline__ void causal_swa_prime(const BlockRef<TIn, TOut>& cur, int W, char* lds, Seam<TIn>& S, const int wv) {
    constexpr bool F32 = same_t<TIn, float>::v;
    const int tid = wv * 64 + (int)__builtin_amdgcn_mbcnt_hi(~0u, __builtin_amdgcn_mbcnt_lo(~0u, 0u)), wid = wv, lane = tid & 63, r32 = lane & 31, hi = lane >> 5;
    const int sr = tid >> 4, sc = (tid & 15) * 8, kws = KSWZ(sr, sc * 2); char* K_lds = lds + 2 * SHM_V;
    const int kb0 = swa_jlo(cur.P0, W) * KVBLK;
    for (int d0 = 0; d0 < 8; ++d0) S.qr[d0] = load8<TIn>(cur.Q + (size_t)(wid * QBLK + r32) * QPITCH + d0 * 16 + hi * 8);
    if constexpr (F32) { SLOAD_F((const float*)cur.K, kb0); VMW(); SWRITE_KF(0); SBAR(); SLOAD_F((const float*)cur.V, kb0); }
    else { SLOAD_H(cur.K, cur.V, kb0); VMW(); SWRITE_HK(0); }
    __syncthreads();
}
template <class TIn, class TOut>
__device__ __forceinline__ void causal_swa_block(const BlockRef<TIn, TOut>& cur, const BlockRef<TIn, TOut>& nxt, int skv, int W, char* lds, Seam<TIn>& S, const unsigned selmask, const int wv) {
    constexpr bool F32 = same_t<TIn, float>::v;
    int tid = wv * 64 + (int)__builtin_amdgcn_mbcnt_hi(~0u, __builtin_amdgcn_mbcnt_lo(~0u, 0u)); asm volatile("" : "+v"(tid));
    const int wid = wv, lane = tid & 63, r32 = lane & 31, hi = lane >> 5;
    const int j_lo = swa_jlo(cur.P0, W);
    int j_hi = (cur.P0 + QB - 1) / KVBLK + 1; if (j_hi > skv / KVBLK) j_hi = skv / KVBLK;
    const int NT = j_hi - j_lo;
    const int kbn = swa_jlo(nxt.P0, W) * KVBLK;
    const int own = cur.P0 >> 8;
    const int qlo = cur.P0 + wid * QBLK, qm = qlo + r32 - 4 * hi;
    char* V_lds = lds; char* K_lds = lds + 2 * SHM_V;
    float* ws = (float*)(lds + 2 * SHM_V + 2 * SHM_K) + wid * 64; float* li_l = ws, * al_l = ws + 32;
    float m_reg = -1e30f, l_reg = 0; f32x16 o[4] = {};
    const int sr = tid >> 4, sc = (tid & 15) * 8, vst0 = v_st(sr, sc), vst1 = v_st(32 + sr, sc), kws = KSWZ(sr, sc * 2);
    const int vb0 = (int)(uintptr_t)V_lds + v_rd_base(lane);
    const TIn* Kh = cur.K; const TIn* Vh = cur.V;
#define RESC(a) do { if (__any((a) < 1.f)) { if (hi == 0) al_l[r32] = (a); asm volatile("s_waitcnt lgkmcnt(0)" ::: "memory");              \
                     for (int d_ = 0; d_ < 4; ++d_) for (int r = 0; r < 16; ++r) o[d_][r] *= al_l[crow(r, hi)]; } } while (0)
#define KBASE(t) ((j_lo + (t)) * KVBLK)
#define ACT(t) (KBASE(t) <= qlo + QBLK - 1 && KBASE(t) + KVBLK - 1 >= qlo - W + 1)
#define MASKT(P0_, P1_, t) do { const int kb_ = KBASE(t); if ((kb_ >> 8) == own && kb_ + KVBLK - 1 > qlo) mask_tile(P0_, P1_, qm - kb_, 0x40000000u); } while (0)
#define ROWOFF(t) (own > 3 && (KBASE(t) >> 8) != own && ((selmask >> (KBASE(t) >> 8)) & 1u) == 0u)
    constexpr int NQL = F32 ? 16 : 8;
    constexpr bool SK = WSKIP && !F32;
#define SEAM_K0() do { VMWN(NQL); if constexpr (F32) { SWRITE_KF(0); SBAR(); SLOAD_F((const float*)nxt.V, kbn); } else { SWRITE_HK(0); } SBAR(); } while (0)
    f32x16 pA0, pA1, pB0, pB1; float mnA, mnB, alA, alB; bf16x8 pa0, pa1, pa2, pa3;
    if constexpr (F32) { VMW(); SWRITE_VF(0); SBAR(); } else { SWRITE_HV(0); SBAR(); }
    if (NT > 1) { if constexpr (F32) SLOAD_F((const float*)Kh, KBASE(1)); else SLOAD_H(Kh, Vh, KBASE(1)); }
    SBAR(); qkt<0, SK>(pA0, pA1, K_lds, r32, hi, S.qr, ACT(0));
    if constexpr (F32) { if (NT > 1) { VMW(); SWRITE_KF(1); SBAR(); SLOAD_F((const float*)Vh, KBASE(1)); } }
    MASKT(pA0, pA1, 0); partialSM(pA0, pA1, m_reg, mnA, alA, ROWOFF(0));
    if (NT > 1) { VMW(); if constexpr (F32) { SWRITE_VF(1); SBAR(); if (NT > 2) SLOAD_F((const float*)Kh, KBASE(2)); } else SWRITE_H(1); }
    __syncthreads();
#define HALF_STEP(PX0, PX1, mnX, alX, PY0, PY1, alY, t, KB, VB, SB) do {                                                      \
        SBAR(); qkt<KB, SK>(PX0, PX1, K_lds, r32, hi, S.qr, ACT(t));                                             \
        finishSM(PY0, PY1, alY, l_reg, pa0, pa1, pa2, pa3); SBAR();                                                           \
        if ((t) + 1 < NT) { if constexpr (F32) { VMW(); SWRITE_KF(SB); SBAR(); SLOAD_F((const float*)Vh, KBASE((t) + 1)); }  \
                            else { SLOAD_H(Kh, Vh, KBASE((t) + 1)); } SBAR(); }                                               \
        pv_tile<VB, SK>(o, vb0, pa0, pa1, pa2, pa3, ACT((t) - 1)); MASKT(PX0, PX1, (t)); partialSM(PX0, PX1, m_reg, mnX, alX, ROWOFF(t));                                        \
        __syncthreads();                                                                                                      \
        if ((t) + 1 < NT) { VMW(); if constexpr (F32) { SWRITE_VF(SB); SBAR(); if ((t) + 2 < NT) SLOAD_F((const float*)Kh, KBASE((t) + 2)); } \
                            else { SWRITE_H(SB); } }                                                                          \
        RESC(alX); __syncthreads(); } while (0)
    for (int t = 1; t + 1 < NT; t += 2) {
        HALF_STEP(pB0, pB1, mnB, alB, pA0, pA1, alA, t, 1, 0, 0);
        HALF_STEP(pA0, pA1, mnA, alA, pB0, pB1, alB, t + 1, 0, 1, 1);
    }
    const bool even = (NT & 1) == 0;
    if (even) { SBAR(); qkt<1, SK>(pB0, pB1, K_lds, r32, hi, S.qr, ACT(NT - 1)); SBAR(); }
#define QROW(e) (nxt.Q + (size_t)(wid * QBLK + r32) * QPITCH + ((e) >> 1) * 16 + hi * 8 + ((e) & 1) * 4)
    if constexpr (F32) { SLOAD_F((const float*)nxt.K, kbn); SBAR();
#pragma unroll
        for (int e = 0; e < 8; ++e) S.tq[e] = *(const f32x4*)QROW(e); }
    else { SLOAD_H(nxt.K, nxt.V, kbn); SBAR();
#pragma unroll
        for (int d0 = 0; d0 < 8; ++d0) S.qr[d0] = load8<TIn>(nxt.Q + (size_t)(wid * QBLK + r32) * QPITCH + d0 * 16 + hi * 8); }
    SBAR();
    finishSM(pA0, pA1, alA, l_reg, pa0, pa1, pa2, pa3); SBAR();
    if constexpr (F32) {
#pragma unroll
        for (int e = 8; e < 16; ++e) S.tq[e] = *(const f32x4*)QROW(e); SBAR(); }
#undef QROW
    pv_tile<0, SK>(o, vb0, pa0, pa1, pa2, pa3, ACT(even ? NT - 2 : NT - 1));
    if (even) { MASKT(pB0, pB1, NT - 1); partialSM(pB0, pB1, m_reg, mnB, alB, ROWOFF(NT - 1)); __syncthreads(); RESC(alB);
        finishSM(pB0, pB1, alB, l_reg, pa0, pa1, pa2, pa3); SBAR(); pv_tile<1, SK>(o, vb0, pa0, pa1, pa2, pa3, ACT(NT - 1)); }
    SBAR(); SEAM_K0();
    if (hi == 0) li_l[r32] = l_reg; asm volatile("s_waitcnt lgkmcnt(0)" ::: "memory");
    float rli[16];
#pragma unroll
    for (int r = 0; r < 16; ++r) rli[r] = __builtin_amdgcn_rcpf(li_l[crow(r, hi)]);
    TOut* Ow = cur.O + (size_t)(wid * QBLK) * OPITCH;
#pragma unroll
    for (int r = 0; r < 16; ++r) { const int orow = crow(r, hi);
#pragma unroll
        for (int d0 = 0; d0 < 4; ++d0) { const float v = o[d0][r] * rli[r];
            if constexpr (same_t<TOut, float>::v) { Ow[(size_t)orow * OPITCH + d0 * 32 + r32] = v; }
            else { const float vn = __shfl_xor(v, 1);
                   if ((r32 & 1) == 0) *(unsigned*)(Ow + (size_t)orow * OPITCH + d0 * 32 + r32) = cvtpk(v, vn); } } }
    if constexpr (F32) {
#pragma unroll
        for (int d0 = 0; d0 < 8; ++d0) S.qr[d0] = pack8(S.tq[2 * d0], S.tq[2 * d0 + 1]); }
    __syncthreads();
#undef RESC
#undef KBASE
#undef ACT
#undef MASKT
#undef ROWOFF
#undef SEAM_K0
#undef HALF_STEP
}
#undef ROW
#undef VMW
#undef VMWN
#undef SLOAD_H
#undef SWRITE_HK
#undef SWRITE_HV
#undef SWRITE_H
#undef SLOAD_F
#undef SWRITE_KF
#undef SWRITE_VF
#undef KSWZ
#undef SBAR
}
namespace mb {
__device__ __forceinline__ float bfx(short s) { return __uint_as_float(((unsigned)(unsigned short)s) << 16); }
__device__ __forceinline__ unsigned moba_select(const bf16x8 (&qr)[8], const float* kmL, int own, int hi) {
    if (own <= 3) return (1u << own) - 1u;
    float v0 = -INFINITY, v1 = -INFINITY, v2 = -INFINITY; int i0 = 0, i1 = 0, i2 = 0;
    for (int n = 0; n < own; ++n) {
        float part = 0.f;
        const float* kp = kmL + n * 128 + hi * 8;
#pragma unroll
        for (int d0 = 0; d0 < 8; ++d0) {
            const f32x4 ka = *(const f32x4*)(kp + d0 * 16), kb = *(const f32x4*)(kp + d0 * 16 + 4);
            const bf16x8 q = qr[d0];
            part += (bfx(q[0]) * ka[0] + bfx(q[1]) * ka[1]) + (bfx(q[2]) * ka[2] + bfx(q[3]) * ka[3]) + (bfx(q[4]) * kb[0] + bfx(q[5]) * kb[1]) + (bfx(q[6]) * kb[2] + bfx(q[7]) * kb[3]);
        }
        float g; { auto rr = __builtin_amdgcn_permlane32_swap(__float_as_uint(part), __float_as_uint(part), false, false); g = __uint_as_float(rr[0]) + __uint_as_float(rr[1]); }
        if (g > v0) { v2 = v1; i2 = i1; v1 = v0; i1 = i0; v0 = g; i0 = n; }
        else if (g > v1) { v2 = v1; i2 = i1; v1 = g; i1 = n; }
        else if (g > v2) { v2 = g; i2 = n; }
    }
    return (1u << i0) | (1u << i1) | (1u << i2);
}
__device__ __forceinline__ BlockRef<bf16, bf16> mk_block(const bf16* Qb, const bf16* Kb, const bf16* Vb, bf16* ATT, int first, int step, int idx, int& bh_out) {
    const int item = first + (idx >> 1) * step, bh = item >> 3, x = item & 7, qb = (idx & 1) ? x : 15 - x, b = bh >> 3, h = bh & 7;
    BlockRef<bf16, bf16> r;
    r.Q = Qb + (size_t)(b * SEQ + qb * 256) * QPITCH + h * 128;
    r.K = Kb + (size_t)(b * SEQ) * KPITCH + h * 128;
    r.V = Vb + (size_t)(b * SEQ) * KPITCH + h * 128;
    r.O = ATT + (size_t)(b * SEQ + qb * 256) * OPITCH + h * 128;
    r.P0 = qb * 256; bh_out = bh; return r;
}
__device__ __forceinline__ void prompt_attention(unsigned char* ws, char* lds, int first, int step, const int wv) {
    const bf16* Qb = (const bf16*)(ws + WS_Q); const bf16* Kb = (const bf16*)(ws + WS_K); const bf16* Vb = (const bf16*)(ws + WS_V); bf16* ATT = (bf16*)(ws + WS_ATT);
    const float* kmsum = (const float*)(ws + CTL_KMP);
    float* kmL = (float*)(lds + 69632);
    if (first >= 128) return;
    const int nitems = (128 - first + step - 1) / step, nb = 2 * nitems;
    Seam<bf16> S;
    int bh; BlockRef<bf16, bf16> cur = mk_block(Qb, Kb, Vb, ATT, first, step, 0, bh);
    causal_swa_prime<bf16, bf16>(cur, 0x40000000, lds, S, wv);
    for (int i = 0; i < nb; ++i) {
        int bhn = bh; const BlockRef<bf16, bf16> nxt = (i + 1 < nb) ? mk_block(Qb, Kb, Vb, ATT, first, step, i + 1, bhn) : cur;
        int tl = wv * 64 + lane_id(); asm volatile("" : "+v"(tl));
        { const int b = bh >> 3, h = bh & 7; const float* src = kmsum + ((size_t)(b * 16) * NH + h) * HD;
            *(f32x4*)(kmL + tl * 4) = *(const f32x4*)(src + (size_t)(tl >> 5) * NH * HD + (tl & 31) * 4); }
        __syncthreads();
        const unsigned selmask = moba_select(S.qr, kmL, cur.P0 >> 8, (tl >> 5) & 1);
        causal_swa_block<bf16, bf16>(cur, nxt, SEQ, 0x40000000, lds, S, selmask, wv);
        cur = nxt; bh = bhn;
    }
}
}

constexpr size_t CTL_SMP_GATES = CTL_SMP + 4096;
constexpr unsigned SMP_SPIN_CAP = 1u << 22;
typedef float f32x2v __attribute__((ext_vector_type(2)));
__device__ __forceinline__ void sample_scan_item(const Args& a, LAS unsigned char* lds, int b, int n, int tid, int wave, int lane) {
    const float* cache_k = a.in[2]; const int* pt = (const int*)a.in[4]; unsigned char* ws = a.ws;
    LAS float* red = (LAS float*)lds;
    LAS float* qL = (LAS float*)(lds + 32768);
    LAS float* kmr = (LAS float*)(lds + 49152);
    { const bf16* Qb = (const bf16*)(ws + WS_Q) + (size_t)(MP + b * DS) * 1024;
        for (int i = tid; i < DS * 1024; i += NWAVES * 64) qL[i] = bf2f(Qb[i]); }
    const int page = pt[b * NPG + 2 * n + (wave >> 2)];
    const float* base = cache_k + ((size_t)page * PAGE + (wave & 3) * 32) * 1024 + lane * 4;
    f32x4 acc[4];
#pragma unroll
    for (int c = 0; c < 4; ++c) acc[c] = (f32x4){0.f, 0.f, 0.f, 0.f};
    for (int j = 0; j < 32; j += 8) {
        f32x4 v[8][4];
#pragma unroll
        for (int jj = 0; jj < 8; ++jj)
#pragma unroll
            for (int c = 0; c < 4; ++c) v[jj][c] = __builtin_nontemporal_load((const f32x4*)(base + (size_t)(j + jj) * 1024 + c * 256));
#pragma unroll
        for (int jj = 0; jj < 8; ++jj)
#pragma unroll
            for (int c = 0; c < 4; ++c) acc[c] += v[jj][c];
    }
#pragma unroll
    for (int c = 0; c < 4; ++c) *(LAS f32x4*)(red + wave * 1024 + c * 256 + lane * 4) = acc[c];
    __syncthreads();
    { float s0 = 0.f, s1 = 0.f;
#pragma unroll
        for (int w = 0; w < 8; ++w) { s0 += red[w * 1024 + tid * 2]; s1 += red[w * 1024 + tid * 2 + 1]; }
        kmr[tid * 2] = s0 * (1.f / 256.f); kmr[tid * 2 + 1] = s1 * (1.f / 256.f); }
    __syncthreads();
    {
        const int h = wave; unsigned* gates = (unsigned*)(ws + CTL_SMP_GATES);
        const float k0 = kmr[h * 128 + lane], k1 = kmr[h * 128 + lane + 64];
#pragma unroll
        for (int t = 0; t < DS; ++t) {
            float p = qL[t * 1024 + h * 128 + lane] * k0 + qL[t * 1024 + h * 128 + lane + 64] * k1;
            p = wave_sum(p);
            if (lane == 0) __hip_atomic_store(gates + ((size_t)(b * DS + t) * NH + h) * 64 + n, __float_as_uint(p), RLX_AGENT);
        }
    }
    asm volatile("s_waitcnt vmcnt(0)" ::: "memory");
    __syncthreads();
    if (tid == 0) __hip_atomic_fetch_add((unsigned*)(ws + CTL_SMP) + 64 * b, 1u, RLX_AGENT);
}
__device__ __forceinline__ void sample_attn_item(const Args& a, LAS unsigned char* lds, int b, int t, int h, int tid, int wave, int lane) {
    const float* cache_k = a.in[2]; const float* cache_v = a.in[3]; const int* pt = (const int*)a.in[4]; unsigned char* ws = a.ws;
    LAS float* lg = (LAS float*)lds;
    LAS float* oL = (LAS float*)(lds + 4096);
    gu32* ctl = (gu32*)(ws + WS_CTL);
    const int row = MP + b * DS + t;
    if (wave == 0) {
        unsigned* cnt = (unsigned*)(ws + CTL_SMP) + 64 * b; unsigned sp = 0;
        while ((unsigned)__builtin_amdgcn_readfirstlane(__hip_atomic_load(cnt, RLX_AGENT)) < 64u) {
            __builtin_amdgcn_s_sleep(2);
            if ((++sp & 255u) == 0u) { if (__hip_atomic_load((unsigned*)(ctl + CW_TMO), RLX_AGENT)) break; if (sp > SMP_SPIN_CAP) { if (lane == 0) __hip_atomic_store((unsigned*)(ctl + CW_TMO), 1u, RLX_AGENT); break; } }
        }
        __builtin_amdgcn_fence(__ATOMIC_ACQUIRE, "agent");
    }
    asm volatile("s_waitcnt vmcnt(0)" ::: "memory");
    __syncthreads();
    float gate = __uint_as_float(__hip_atomic_load((unsigned*)(ws + CTL_SMP_GATES) + ((size_t)(b * DS + t) * NH + h) * 64 + lane, RLX_AGENT));
    int sel0, sel1, sel2;
    {
        float bv = gate;
#pragma unroll
        for (int o = 1; o < 64; o <<= 1) bv = fmaxf(bv, __shfl_xor(bv, o));
        sel0 = __ffsll((long long)__ballot(gate == bv)) - 1; if (lane == sel0) gate = -3e38f;
        bv = gate;
#pragma unroll
        for (int o = 1; o < 64; o <<= 1) bv = fmaxf(bv, __shfl_xor(bv, o));
        sel1 = __ffsll((long long)__ballot(gate == bv)) - 1; if (lane == sel1) gate = -3e38f;
        bv = gate;
#pragma unroll
        for (int o = 1; o < 64; o <<= 1) bv = fmaxf(bv, __shfl_xor(bv, o));
        sel2 = __ffsll((long long)__ballot(gate == bv)) - 1;
    }
    const int pg00 = pt[b * NPG + 2 * sel0], pg01 = pt[b * NPG + 2 * sel0 + 1], pg10 = pt[b * NPG + 2 * sel1], pg11 = pt[b * NPG + 2 * sel1 + 1], pg20 = pt[b * NPG + 2 * sel2], pg21 = pt[b * NPG + 2 * sel2 + 1];
#define SMP_PAGE(g) (((g) >> 8) == 0 ? (((g) & 128) ? pg01 : pg00) : (((g) >> 8) == 1 ? (((g) & 128) ? pg11 : pg10) : (((g) & 128) ? pg21 : pg20)))
    const int sub = lane & 15, kq = lane >> 4;
    float q[8];
    { const bf16* qp = (const bf16*)(ws + WS_Q) + (size_t)row * 1024 + h * 128 + sub * 8; const v4u qq = *(const GAS v4u*)qp;
#pragma unroll
        for (int e = 0; e < 4; ++e) { q[2 * e] = __uint_as_float(qq[e] << 16); q[2 * e + 1] = __uint_as_float(qq[e] & 0xffff0000u); } }
#pragma unroll 1
    for (int it = 0; it < 24; it += 12) {
        f32x4 ka[12], kb[12];
#pragma unroll
        for (int u = 0; u < 12; ++u) {
            const int g = wave * 96 + (it + u) * 4 + kq;
            const unsigned ko = (((unsigned)SMP_PAGE(g) * PAGE + (g & 127)) * 1024 + h * 128 + sub * 8) * 4u;
            ka[u] = __builtin_nontemporal_load((const f32x4*)((const char*)cache_k + ko)); kb[u] = __builtin_nontemporal_load((const f32x4*)((const char*)cache_k + ko + 16));
        }
#pragma unroll
        for (int u = 0; u < 12; ++u) {
            float p = (q[0] * ka[u][0] + q[1] * ka[u][1]) + (q[2] * ka[u][2] + q[3] * ka[u][3]) + (q[4] * kb[u][0] + q[5] * kb[u][1]) + (q[6] * kb[u][2] + q[7] * kb[u][3]);
            p += __shfl_xor(p, 1); p += __shfl_xor(p, 2); p += __shfl_xor(p, 4); p += __shfl_xor(p, 8);
            if (sub == 0) lg[wave * 96 + (it + u) * 4 + kq] = p * 0.08838834764831845f;
        }
    }
    if (wave == 0) {
        const bf16* kp = (const bf16*)(ws + WS_K) + (size_t)(MP + b * DS + kq) * 1024 + h * 128 + sub * 8; const v4u kk = *(const GAS v4u*)kp;
        float p = 0.f;
#pragma unroll
        for (int e = 0; e < 4; ++e) p += q[2 * e] * __uint_as_float(kk[e] << 16) + q[2 * e + 1] * __uint_as_float(kk[e] & 0xffff0000u);
        p += __shfl_xor(p, 1); p += __shfl_xor(p, 2); p += __shfl_xor(p, 4); p += __shfl_xor(p, 8);
        if (sub == 0) lg[768 + kq] = kq <= t ? p * 0.08838834764831845f : -INFINITY;
    }
    __syncthreads();
    float mx = -INFINITY;
    for (int i = lane; i < 772; i += 64) mx = fmaxf(mx, lg[i]);
#pragma unroll
    for (int o = 1; o < 64; o <<= 1) mx = fmaxf(mx, __shfl_xor(mx, o));
    float sum = 0.f;
    for (int i = lane; i < 772; i += 64) sum += __expf(lg[i] - mx);
    sum = wave_sum(sum);
    __syncthreads();
    for (int i = lane; i < 96; i += 64) lg[wave * 96 + i] = __expf(lg[wave * 96 + i] - mx);
    if (wave == 0 && lane < 4) lg[768 + lane] = __expf(lg[768 + lane] - mx);
    const int kh = lane >> 5, dl = lane & 31;
    f32x4 o4 = (f32x4){0.f, 0.f, 0.f, 0.f};
#pragma unroll 1
    for (int j0 = 0; j0 < 48; j0 += 24) {
        f32x4 vv[24];
#pragma unroll
        for (int u = 0; u < 24; ++u) {
            const int g = wave * 96 + 2 * (j0 + u) + kh;
            const unsigned vo = (((unsigned)SMP_PAGE(g) * PAGE + (g & 127)) * 1024 + h * 128 + dl * 4) * 4u;
            vv[u] = __builtin_nontemporal_load((const f32x4*)((const char*)cache_v + vo));
        }
#pragma unroll
        for (int u = 0; u < 24; ++u) o4 += vv[u] * lg[wave * 96 + 2 * (j0 + u) + kh];
    }
    if (wave == 0 && kh == 0) {
        for (int j = 0; j <= t; ++j) { const bf16* vp = (const bf16*)(ws + WS_V) + (size_t)(MP + b * DS + j) * 1024 + h * 128 + dl * 4; const unsigned long long vw = *(const GAS unsigned long long*)vp;
            const float p = lg[768 + j];
            o4 += (f32x4){__uint_as_float((unsigned)vw << 16), __uint_as_float((unsigned)vw & 0xffff0000u), __uint_as_float((unsigned)(vw >> 32) << 16), __uint_as_float((unsigned)(vw >> 32) & 0xffff0000u)} * p; }
    }
#pragma unroll
    for (int e = 0; e < 4; ++e) o4[e] += __shfl_xor(o4[e], 32);
    if (kh == 0) *(LAS f32x4*)(oL + wave * 128 + dl * 4) = o4;
    __syncthreads();
    if (tid < 128) { float s = 0.f;
#pragma unroll
        for (int w = 0; w < 8; ++w) s += oL[w * 128 + tid];
        ((bf16*)(ws + WS_ATT))[(size_t)row * DM + h * 128 + tid] = (bf16)f2bf(s / sum); }
    __syncthreads();
#undef SMP_PAGE
}
__device__ __forceinline__ void sample_path(const Args& a, LAS unsigned char* lds, int ib, int nB, int tid, int wave, int lane) {
    for (int s = ib; s < DB * 64; s += nB) sample_scan_item(a, lds, s >> 6, s & 63, tid, wave, lane);
    for (int j = ib; j < MS * NH; j += nB) sample_attn_item(a, lds, j >> 5, (j >> 3) & 3, j & 7, tid, wave, lane);
}
constexpr int N_PHASES = 10;
__global__ void __launch_bounds__(NWAVES * 64, 2) fwd_kernel(Args args) {
    extern __shared__ __attribute__((aligned(16))) unsigned char lds_raw[];
    LAS unsigned char* lds = (LAS unsigned char*)lds_raw;
    volatile LAS unsigned* MISC = (volatile LAS unsigned*)(lds + MISC_OFF);
    const int tid0 = threadIdx.x, wave = __builtin_amdgcn_readfirstlane(tid0 >> 6);
#define FRESH_TID() int tid = wave * 64 + lane_id(); asm volatile("" : "+v"(tid)); const int lane = tid & 63; (void)lane
    const int G = gridDim.x; const int bx = blockIdx.x; const int vcu = (G % 8 == 0) ? (bx % 8) * (G / 8) + bx / 8 : bx;
    unsigned char* ws = args.ws;
    gu32* ctl = (gu32*)(ws + WS_CTL);
    for (int u = tid0; u < (LDS_BYTES - LDSCTL_OFF) / 4; u += NWAVES * 64) ((LAS unsigned*)(lds + LDSCTL_OFF))[u] = 0u;
    __syncthreads();
    XcdBarrier bar = xcd_barrier_post((unsigned*)(ctl + CW_BAR) + args.li * XCD_BAR_WORDS, MISC + 8, wave);
    const int lo = args.ph_lo, hi = args.ph_hi;
#define IN(k) (lo <= (k) && (k) < hi)
#define BOTH(k) (IN(k) && IN((k) + 1))
#define GRID_BAR() xcd_barrier(bar)
    unsigned long long* SS = (unsigned long long*)(ws + CTL_SS);
    float* out = args.out;
    float* o_kp = out + (size_t)MV * DM; float* o_vp = o_kp + (size_t)MP * 1024; float* o_ks = o_vp + (size_t)MP * 1024; float* o_vs = o_ks + (size_t)MS * 1024;
    float* o_cp = o_vs + (size_t)MS * 1024; float* o_cs = o_cp + (size_t)NB * 2 * CC;
    pg8::bf16_t* XB = (pg8::bf16_t*)(ws + WS_XB);

    if (IN(0)) { FRESH_TID(); p0_prologue(args, lds, vcu, G, wave, lane);
#if PROBE_REP == 0
        for (int rep_ = 0; rep_ < 4; ++rep_) { GRID_BAR(); p0_prologue(args, lds, vcu, G, wave, lane); }
#endif
        if (BOTH(0)) GRID_BAR(); }

    if (IN(1)) {
        pg8::Gemm g{XB, (const pg8::bf16_t*)(ws + WS_WIN), MP, INW, DM, DM, DM, 31, 0, 128, 128}; pg8::StaticOrder S; S.init(MP, INW, G, bx);
        pg8::EpiInProj E{SS, (const float*)(ws + WS_COS), (const float*)(ws + WS_SIN),
                         (pg8::bf16_t*)(ws + WS_Q), (pg8::bf16_t*)(ws + WS_K), (pg8::bf16_t*)(ws + WS_V), (pg8::bf16_t*)(ws + WS_G), (pg8::bf16_t*)(ws + WS_U),
                         o_kp, o_vp, o_ks, o_vs, o_cp, o_cs, (float*)(ws + CTL_KMP)};
        pg8::skinny_phase<pg8::EpiInProj>(lds + RING_OFF, g, E, bx, G, wave);
        pg8::gemm_phase<pg8::EpiInProj, pg8::StaticOrder, true, true>(lds + RING_OFF, g, S, E, wave);
        if (PROBE_REP == 1 || PROBE_REP == 11 || PROBE_REP == 12) { for (int rep_ = 0; rep_ < 4; ++rep_) { GRID_BAR();
            if (PROBE_REP == 12) { pg8::EpiSwiGLU El{SS, (pg8::bf16_t*)(ws + WS_END)}; pg8::gemm_phase<pg8::EpiSwiGLU, pg8::StaticOrder, true, true>(lds + RING_OFF, g, S, El, wave); }
            else { pg8::gemm_phase<pg8::EpiInProj, pg8::StaticOrder, true, true>(lds + RING_OFF, g, S, E, wave); if (PROBE_REP == 1) pg8::skinny_phase<pg8::EpiInProj>(lds + RING_OFF, g, E, bx, G, wave); } } }
        if (BOTH(1)) GRID_BAR();
    }
    if (IN(2)) { FRESH_TID();
#if MK_ATTN_EXTERNAL
        conv_pass(args, vcu, G, tid);
#else
        conv_pass(args, vcu, G, tid);
        if ((vcu & 1) == 0) mb::prompt_attention(ws, (char*)lds_raw, vcu >> 1, G >> 1, wave);
        else sample_path(args, lds, vcu >> 1, G >> 1, tid, wave, lane);
#if PROBE_REP == 2
        GRID_BAR();
        if ((vcu & 1) == 0) mb::prompt_attention(ws, (char*)lds_raw, vcu >> 1, G >> 1, wave);
        else { conv_pass(args, vcu >> 1, G >> 1, tid); sample_path(args, lds, vcu >> 1, G >> 1, tid, wave, lane); }
#endif
#if PROBE_REP == 21
        for (int rep_ = 0; rep_ < 4; ++rep_) { GRID_BAR();
        if ((vcu & 1) == 0) mb::prompt_attention(ws, (char*)lds_raw, vcu >> 1, G >> 1, wave); }
#endif
#if PROBE_REP == 23
        GRID_BAR();
        if ((vcu & 1) != 0) conv_pass(args, vcu >> 1, G >> 1, tid);
#endif
#if PROBE_REP == 24
        GRID_BAR();
        if ((vcu & 1) != 0) { for (int s_ = (vcu >> 1); s_ < DB * 64; s_ += (G >> 1)) sample_scan_item(args, lds, s_ >> 6, s_ & 63, tid, wave, lane); }
#endif
#if PROBE_REP == 25
        GRID_BAR();
        if ((vcu & 1) != 0) { for (int j_ = (vcu >> 1); j_ < MS * NH; j_ += (G >> 1)) sample_attn_item(args, lds, j_ >> 5, (j_ >> 3) & 3, j_ & 7, tid, wave, lane); }
#endif
#if PROBE_REP == 22
        GRID_BAR();
        if ((vcu & 1) != 0) { conv_pass(args, vcu >> 1, G >> 1, tid); sample_path(args, lds, vcu >> 1, G >> 1, tid, wave, lane); }
#endif
#endif
        if (BOTH(2)) GRID_BAR();
    }
    if (IN(3)) {
        pg8::Gemm g{(const pg8::bf16_t*)(ws + WS_ATT), (const pg8::bf16_t*)(ws + WS_WO), MP, DM, DM, DM, DM, 31, 0, 128, 128}; pg8::StaticOrder S; S.init(MP, DM, G, bx);
        pg8::EpiResid E{XB, SS + 1 * MPAD, 0};
        pg8::skinny_phase_narrow<pg8::EpiResid>(lds + RING_OFF, g, E, bx, G, wave);
        pg8::gemm_phase<pg8::EpiResid, pg8::StaticOrder, false, true>(lds + RING_OFF, g, S, E, wave);
        if (BOTH(3)) GRID_BAR();
    }
#define FFN_PHASES(l, pb) \
    if (IN(pb)) { FRESH_TID();     \
        pg8::Gemm g{XB, (const pg8::bf16_t*)(ws + WS_WGU) + (size_t)(l) * 2 * FF * DM, MP, 2 * FF, DM, DM, DM, 31, 0, 128, 128}; pg8::StaticOrder S; S.init(MP, 2 * FF, G, bx); \
        pg8::EpiSwiGLU E{SS + ((l) == 0 ? 1 : 3) * MPAD, (pg8::bf16_t*)(ws + WS_H)}; \
        if (HALF_UNITS && G == 256) { \
            pg8::HalfOrder Hh; Hh.so = S; Hh.L = 5 * G + (bx & (G / 2 - 1)); Hh.half = bx / (G / 2);     \
            S.lim = 5 * G; \
            pg8::gemm_phase<pg8::EpiSwiGLU, pg8::StaticOrder, true, true>(lds + RING_OFF, g, S, E, wave); \
            pg8::gemm_phase_hm<pg8::EpiSwiGLU, pg8::HalfOrder>(lds + RING_OFF, g, Hh, E, wave); \
            pg8::skinny_phase<pg8::EpiSwiGLU>(lds + RING_OFF, g, E, bx, G, wave); \
        } else { \
            pg8::gemm_phase<pg8::EpiSwiGLU, pg8::StaticOrder, true, true>(lds + RING_OFF, g, S, E, wave); \
            pg8::skinny_phase<pg8::EpiSwiGLU>(lds + RING_OFF, g, E, bx >= G / 2 ? bx - G / 2 : (1 << 30), G / 2, wave);     \
            if (CONV_IN_SLOTS && bx >= G / 2) convert_weights(args, (LAS float*)(lds + RING_OFF + wave * 16384), 1 + (l), (bx - G / 2) * NWAVES + wave, (G / 2) * NWAVES, lane, (l) == 0 ? GU1_IN_P0 : 0, (l) == 0 ? GU1_SLOT_END : DN1_SLOT_END); \
            if (CONV_IN_SLOTS && bx < G / 2) convert_weights(args, (LAS float*)(lds + RING_OFF + wave * 16384), 1 + (l), bx * NWAVES + wave, (G / 2) * NWAVES, lane, (l) == 0 ? GU1_SLOT_END : DN1_SLOT_END);     \
        } \
        if ((PROBE_REP == 70 && (l) == 1) || (PROBE_REP == 72 && (l) == 0) || (PROBE_REP == 71 && (l) == 1)) { for (int rep_ = 0; rep_ < 4; ++rep_) { GRID_BAR();     \
            pg8::gemm_phase<pg8::EpiSwiGLU, pg8::StaticOrder, true, true>(lds + RING_OFF, g, S, E, wave); \
            if (PROBE_REP != 71) { pg8::skinny_phase<pg8::EpiSwiGLU>(lds + RING_OFF, g, E, bx >= G / 2 ? bx - G / 2 : (1 << 30), G / 2, wave); \
                if (bx >= G / 2) convert_weights(args, (LAS float*)(lds + RING_OFF + wave * 16384), 1 + (l), (bx - G / 2) * NWAVES + wave, (G / 2) * NWAVES, lane, 0, (l) == 0 ? GU1_SLOT_END : DN1_SLOT_END); \
                else convert_weights(args, (LAS float*)(lds + RING_OFF + wave * 16384), 1 + (l), bx * NWAVES + wave, (G / 2) * NWAVES, lane, (l) == 0 ? GU1_SLOT_END : DN1_SLOT_END); } } } \
        if (BOTH(pb)) GRID_BAR(); \
    } \
    if (IN((pb) + 1)) {     \
        pg8::Gemm g{(const pg8::bf16_t*)(ws + WS_H), (const pg8::bf16_t*)(ws + WS_WDN) + (size_t)(l) * DM * FF, MP, DM, FF, 64, 64, 31, 0, (size_t)MPAD * 128, (size_t)DM * 128};     pg8::StaticOrder S; S.init(MP, DM, G, bx); \
        if ((l) == 0) { \
            pg8::EpiResid E{XB, SS + 2 * MPAD, 0}; \
            pg8::skinny_phase_narrow<pg8::EpiResid>(lds + RING_OFF, g, E, bx, G, wave); \
            pg8::gemm_phase<pg8::EpiResid, pg8::StaticOrder, false, true>(lds + RING_OFF, g, S, E, wave); \
        } else { \
            pg8::EpiFinal E{XB, SS + 4 * MPAD, args.in[9], out, (unsigned*)(ws + CTL_FIN), (unsigned*)(ctl + CW_TMO)}; \
            pg8::skinny_phase_narrow<pg8::EpiFinal>(lds + RING_OFF, g, E, bx, G, wave); \
            pg8::gemm_phase<pg8::EpiFinal, pg8::StaticOrder, false, true>(lds + RING_OFF, g, S, E, wave); \
        } \
        if (BOTH((pb) + 1)) GRID_BAR(); \
    }
#if PROBE_REP == 80 || PROBE_REP == 81
    if (IN(5)) {
        for (int rep_ = 0; rep_ < 8; ++rep_) { FRESH_TID();
            if (PROBE_REP == 81) convert_weights(args, (LAS float*)(lds + RING_OFF + wave * 16384), 1, bx * NWAVES + wave, G * NWAVES, lane, 0);
            else if (bx >= G / 2) convert_weights(args, (LAS float*)(lds + RING_OFF + wave * 16384), 1, (bx - G / 2) * NWAVES + wave, (G / 2) * NWAVES, lane, 0);
            GRID_BAR(); }
    }
#endif
#if PROBE_REP >= 60 && PROBE_REP <= 65
    if (IN(5)) {
        for (int rep_ = 0; rep_ < 8; ++rep_) {
            if (PROBE_REP != 62) {
                if (PROBE_REP == 64) {
                    pg8::Gemm g{(const pg8::bf16_t*)(ws + WS_H), (const pg8::bf16_t*)(ws + WS_WDN), MP, DM, FF, 64, 64, 31, 0, (size_t)MPAD * 128, (size_t)DM * 128}; pg8::StaticOrder S; S.init(MP, DM, G, bx);
                    pg8::EpiResid E{(pg8::bf16_t*)(ws + WS_END), (unsigned long long*)(ws + WS_END + (size_t)MPAD * DM * 2), PROBE_REP == 65};
                    pg8::gemm_phase<pg8::EpiResid, pg8::StaticOrder, false, true>(lds + RING_OFF, g, S, E, wave);
                    pg8::skinny_phase_narrow<pg8::EpiResid>(lds + RING_OFF, g, E, bx, G, wave);
                } else {
                    pg8::Gemm g{(const pg8::bf16_t*)(ws + WS_ATT), (const pg8::bf16_t*)(ws + WS_WO), MP, DM, DM, DM, DM, 31, 0, 128, 128}; pg8::StaticOrder S; S.init(MP, DM, G, bx);
                    if (PROBE_REP == 63) { pg8::EpiSwiGLU E{SS, (pg8::bf16_t*)(ws + WS_END)}; pg8::gemm_phase<pg8::EpiSwiGLU, pg8::StaticOrder, false, true>(lds + RING_OFF, g, S, E, wave); }
                    else { pg8::EpiResid E{(pg8::bf16_t*)(ws + WS_END), (unsigned long long*)(ws + WS_END + (size_t)MPAD * DM * 2), PROBE_REP == 65};
                        pg8::gemm_phase<pg8::EpiResid, pg8::StaticOrder, false, true>(lds + RING_OFF, g, S, E, wave);
                        if (PROBE_REP == 60) pg8::skinny_phase_narrow<pg8::EpiResid>(lds + RING_OFF, g, E, bx, G, wave); }
                }
            }
            GRID_BAR();
        }
    }
#endif
#if PROBE_REP == 52 || PROBE_REP == 53
    if (IN(5)) {
        constexpr bool BLK = PROBE_REP == 53;
        pg8::Gemm g{XB, (const pg8::bf16_t*)(ws + WS_WIN), MP, INW, DM, BLK ? 64 : DM, BLK ? 64 : DM, 31, 0, BLK ? (size_t)MPAD * 128 : 128, BLK ? (size_t)INW * 128 : 128}; pg8::StaticOrder S; S.init(MP, INW, G, bx);
        pg8::EpiSwiGLU E{SS, (pg8::bf16_t*)(ws + WS_END)};
        pg8::gemm_phase<pg8::EpiSwiGLU, pg8::StaticOrder, true, true>(lds + RING_OFF, g, S, E, wave);
        GRID_BAR();
    }
#endif
#if PROBE_REP == 50 || PROBE_REP == 51
    if (IN(5)) {
        constexpr int LD = PROBE_REP == 50 ? FF : DM;
        pg8::Gemm g{(const pg8::bf16_t*)(ws + WS_H), (const pg8::bf16_t*)(ws + WS_WDN), MP, DM, FF, LD, LD, 31, 0, 128, 128}; pg8::StaticOrder S; S.init(MP, DM, G, bx);
        pg8::EpiResid E{(pg8::bf16_t*)(ws + WS_END), (unsigned long long*)(ws + WS_END + (size_t)MPAD * DM * 2), PROBE_REP == 65};
        pg8::gemm_phase<pg8::EpiResid, pg8::StaticOrder, false, true>(lds + RING_OFF, g, S, E, wave);
        GRID_BAR();
    }
#endif
    FFN_PHASES(0, 4)
    if (IN(6)) { FRESH_TID(); pool_pass(args, vcu, G, tid); if (PROBE_REP == 6) { for (int rep_ = 0; rep_ < 8; ++rep_) { GRID_BAR(); pool_pass(args, vcu, G, tid); } } if (BOTH(6)) GRID_BAR(); }
    if (IN(7)) {
        pg8::Gemm g{(const pg8::bf16_t*)(ws + WS_D), (const pg8::bf16_t*)(ws + WS_WPL), MP, DM, 512, DM, 512, 1, 512 * 2, 128, 128}; pg8::StaticOrder S; S.init(MP, DM, G, bx);
        pg8::EpiResid E{XB, SS + 3 * MPAD, 0};
        pg8::skinny_phase_narrow<pg8::EpiResid>(lds + RING_OFF, g, E, bx, G, wave);
        pg8::gemm_phase<pg8::EpiResid, pg8::StaticOrder, false, true>(lds + RING_OFF, g, S, E, wave);
        if (BOTH(7)) GRID_BAR();
    }
    FFN_PHASES(1, 8)
#undef FFN_PHASES
#undef FRESH_TID
#undef IN
#undef BOTH
#undef GRID_BAR
}
extern "C" void kernel_launch(void* const* d_in, const int* in_sizes, int n_in, void* d_out, int out_size, void* d_ws, size_t ws_size, hipStream_t stream) {
    static int grid = 0;
    if (grid == 0) {
        if (n_in != 18 || ws_size < WS_END + (size_t)MPAD * DM * 8) { fprintf(stderr, "kernel_launch: built for 18 inputs and >= %zu bytes of workspace; got n_in %d, ws %zu; nothing launched\n", (size_t)WS_END, n_in, ws_size); grid = -1; return; }
        int dev = 0, cus = 0, per_cu = 0;
        if (hipGetDevice(&dev) != hipSuccess || hipDeviceGetAttribute(&cus, hipDeviceAttributeMultiprocessorCount, dev) != hipSuccess) { fprintf(stderr, "kernel_launch: device query failed\n"); grid = -1; return; }
        if (hipFuncSetAttribute((const void*)fwd_kernel, hipFuncAttributeMaxDynamicSharedMemorySize, LDS_BYTES) != hipSuccess) { fprintf(stderr, "kernel_launch: hipFuncSetAttribute failed\n"); grid = -1; return; }
        if (hipOccupancyMaxActiveBlocksPerMultiprocessor(&per_cu, (const void*)fwd_kernel, NWAVES * 64, LDS_BYTES) != hipSuccess || per_cu < 1)
            fprintf(stderr, "kernel_launch: note: occupancy query reports %d workgroups per CU\n", per_cu);
        (void)hipGetLastError();
        grid = cus;
    }
    if (grid < 0) return;
    if (hipMemsetAsync((char*)d_ws + WS_CTL, 0, CTL_ZERO_BYTES, stream) != hipSuccess) { fprintf(stderr, "kernel_launch: memset failed\n"); return; }
    Args a{};
    for (int i = 0; i < 18; ++i) a.in[i] = (const float*)d_in[i];
    a.out = (float*)d_out; a.ws = (unsigned char*)d_ws; a.pad = 0;
    unsigned char* ws = (unsigned char*)d_ws;
#if MK_ATTN_EXTERNAL
    a.ph_lo = 0; a.ph_hi = 2; a.li = 0;
    hipLaunchKernelGGL(fwd_kernel, dim3(grid), dim3(NWAVES * 64), LDS_BYTES, stream, a);
    na::k_kmean_sample<<<DB * 64 * 1024 / 256, 256, 0, stream>>>((const float*)d_in[2], (const int*)d_in[4], (float*)(ws + WS_KMS));
    na::k_attn_prompt<<<MP * 8 / 4, 256, 0, stream>>>((const bf16*)(ws + WS_Q), (const bf16*)(ws + WS_K), (const bf16*)(ws + WS_V), (const float*)(ws + CTL_KMP), (bf16*)(ws + WS_ATT));
    na::k_attn_sample<<<MS * 8 / 4, 256, 0, stream>>>((const bf16*)(ws + WS_Q), (const bf16*)(ws + WS_K), (const bf16*)(ws + WS_V), (const float*)(ws + WS_KMS),
                                                      (const float*)d_in[2], (const float*)d_in[3], (const int*)d_in[4], (bf16*)(ws + WS_ATT));
    a.ph_lo = 2; a.ph_hi = N_PHASES; a.li = 1;
    hipLaunchKernelGGL(fwd_kernel, dim3(grid), dim3(NWAVES * 64), LDS_BYTES, stream, a);
#else
    a.ph_lo = 0; a.ph_hi = N_PHASES; a.li = 0;
    hipLaunchKernelGGL(fwd_kernel, dim3(grid), dim3(NWAVES * 64), LDS_BYTES, stream, a);
#endif
    const hipError_t le = hipPeekAtLastError();
    if (le != hipSuccess) fprintf(stderr, "kernel_launch: launch failed: %s\n", hipGetErrorName(le));
}
```
